# Optimizing an MI355X kernel written in HIP

```python
import jax
import jax.numpy as jnp
from jax import lax
import numpy as np

D_MODEL = 1024
BATCH = 2
SEQ = 8192
DEPTH = 4
DEC_BATCH = 128
DEC_SEQ = 1
PAST_LEN = 8192
PAGE_SIZE = 128

N_META = 16
D_FF = 2048
EPS = 1e-6
LRU_WIDTH = D_MODEL // 2
LRU_BLOCKS = 8
LRU_BW = LRU_WIDTH // LRU_BLOCKS
CONV_WIDTH = 4
LRU_C = 8.0
SWA_HEAD_DIM = 64
SWA_HEADS = D_MODEL // (2 * SWA_HEAD_DIM)
SWA_KV_HEADS = SWA_HEADS // 4
SWA_GROUP = SWA_HEADS // SWA_KV_HEADS
WINDOW = 128
RET_DK = 64
RET_DV = 128
RET_HEADS = D_MODEL // (2 * RET_DV)
RET_CHUNK = 128
ROPE_BASE = 10000.0
GN_EPS = 1e-5
N_BRANCH = 3
IN_SIZES = (LRU_WIDTH, LRU_WIDTH,
            SWA_HEADS * SWA_HEAD_DIM, SWA_KV_HEADS * SWA_HEAD_DIM, SWA_KV_HEADS * SWA_HEAD_DIM,
            RET_HEADS * RET_DK, RET_HEADS * RET_DK, RET_HEADS * RET_DV, RET_HEADS * RET_DV,
            N_BRANCH * D_MODEL)
IN_DIM = sum(IN_SIZES)
IN_SPLITS = tuple(int(c) for c in np.cumsum(IN_SIZES)[:-1])

kernel_name = 'hybrid_lru_swa_retention_step'


def rms_norm(x, g):
    x32 = x.astype(jnp.float32)
    y = x32 * lax.rsqrt(jnp.mean(x32 * x32, axis=-1, keepdims=True) + EPS)
    return (y * g.astype(jnp.float32)).astype(x.dtype)


def swiglu(x, w_gu, w_down):
    gate, up = jnp.split(x @ w_gu, 2, axis=-1)
    return (jax.nn.silu(gate) * up) @ w_down


def rope(x, pos):
    half = x.shape[-1] // 2
    inv = ROPE_BASE ** (-jnp.arange(half, dtype=jnp.float32) / half)
    ang = pos.astype(jnp.float32)[:, None] * inv[None, :]
    cos = jnp.cos(ang)[:, None, :]
    sin = jnp.sin(ang)[:, None, :]
    x1, x2 = x[..., :half], x[..., half:]
    return jnp.concatenate([x1 * cos - x2 * sin, x1 * sin + x2 * cos], axis=-1)


def causal_conv(x_ext, w, b):
    t = x_ext.shape[1] - (CONV_WIDTH - 1)
    out = b[None, None, :] + x_ext[:, 0:t] * w[0]
    for j in range(1, CONV_WIDTH):
        out = out + x_ext[:, j:j + t] * w[j]
    return out


def linear_scan(log_a, b, h0):
    def combine(e1, e2):
        la1, b1 = e1
        la2, b2 = e2
        return la1 + la2, jnp.exp(la2) * b1 + b2
    cum_la, h = lax.associative_scan(combine, (log_a, b), axis=1)
    return h + jnp.exp(cum_la) * h0[:, None, :]


def rg_lru(xc, h0, w_a, b_a, w_x, b_x, lam):
    bsz, t, _ = xc.shape
    xb = xc.reshape(bsz, t, LRU_BLOCKS, LRU_BW)
    r = jax.nn.sigmoid(jnp.einsum('btnc,ncd->btnd', xb, w_a).reshape(bsz, t, LRU_WIDTH) + b_a)
    i = jax.nn.sigmoid(jnp.einsum('btnc,ncd->btnd', xb, w_x).reshape(bsz, t, LRU_WIDTH) + b_x)
    log_a = -LRU_C * r * jax.nn.softplus(-lam)
    b = jnp.sqrt(-jnp.expm1(2.0 * log_a)) * (i * xc)
    return linear_scan(log_a, b, h0)


def sink_probs(s, mask, sinks):
    sk = sinks.astype(jnp.float32).reshape(SWA_KV_HEADS, SWA_GROUP, 1, 1)
    s = jnp.where(mask, s, -jnp.inf)
    m = jnp.maximum(jnp.max(s, axis=-1, keepdims=True), sk)
    e = jnp.exp(s - m)
    return e / (jnp.sum(e, axis=-1, keepdims=True) + jnp.exp(sk - m))


def swa_prompt(q, k, v, sinks):
    bsz, t = q.shape[:2]
    pad = (-t) % WINDOW
    nb = (t + pad) // WINDOW

    def blocks(a):
        a = jnp.pad(a, ((0, 0), (pad, 0), (0, 0), (0, 0)))
        return a.reshape((bsz, nb, WINDOW) + a.shape[2:])

    def with_prev(a):
        prev = jnp.pad(a[:, :-1], ((0, 0), (1, 0), (0, 0), (0, 0), (0, 0)))
        return jnp.concatenate([prev, a], axis=2)

    qb = blocks(q).reshape(bsz, nb, WINDOW, SWA_KV_HEADS, SWA_GROUP, SWA_HEAD_DIM)
    kb = with_prev(blocks(k))
    vb = with_prev(blocks(v))
    s = jnp.einsum('bnqhgd,bnkhd->bnhgqk', qb, kb) * SWA_HEAD_DIM ** -0.5
    qi = jnp.arange(WINDOW)[:, None] + WINDOW
    kj = jnp.arange(2 * WINDOW)[None, :]
    in_win = (qi - kj >= 0) & (qi - kj < WINDOW)
    key_idx = jnp.arange(nb)[:, None] * WINDOW - WINDOW + kj
    mask = in_win[None] & (key_idx >= pad)[:, None, :]
    p = sink_probs(s, mask[None, :, None, None], sinks)
    o = jnp.einsum('bnhgqk,bnkhd->bnqhgd', p, vb)
    return o.reshape(bsz, nb * WINDOW, SWA_HEADS * SWA_HEAD_DIM)[:, pad:]


def swa_sample(q, k, v, ck, cv, sinks):
    bsz, t = q.shape[:2]
    buf = ck.shape[1]
    kk = jnp.concatenate([ck, k], axis=1)
    vv = jnp.concatenate([cv, v], axis=1)
    qpos = PAST_LEN + jnp.arange(t)
    kpos = PAST_LEN - buf + jnp.arange(buf + t)
    diff = qpos[:, None] - kpos[None, :]
    mask = (diff >= 0) & (diff < WINDOW)
    qg = q.reshape(bsz, t, SWA_KV_HEADS, SWA_GROUP, SWA_HEAD_DIM)
    s = jnp.einsum('bqhgd,bkhd->bhgqk', qg, kk) * SWA_HEAD_DIM ** -0.5
    p = sink_probs(s, mask, sinks)
    o = jnp.einsum('bhgqk,bkhd->bqhgd', p, vv).reshape(bsz, t, SWA_HEADS * SWA_HEAD_DIM)
    return o, kk[:, -buf:], vv[:, -buf:]


def retention_log_gamma():
    return jnp.log1p(-jnp.exp2(-5.0 - jnp.arange(RET_HEADS, dtype=jnp.float32)))


def retention_chunk(state, q, k, v, log_g):
    c = q.shape[1]
    n = jnp.arange(c, dtype=jnp.float32)
    diff = n[:, None] - n[None, :]
    expo = jnp.where(diff[None] >= 0, diff[None] * log_g[:, None, None], -jnp.inf)
    scores = jnp.einsum('bihd,bjhd->bhij', q, k) * jnp.exp(expo)
    o = jnp.einsum('bhij,bjhe->bihe', scores, v)
    cross_decay = jnp.exp((n[:, None] + 1.0) * log_g[None, :])
    o = o + jnp.einsum('bihd,bhde->bihe', q, state) * cross_decay[None, :, :, None]
    k_decay = jnp.exp((c - 1.0 - n)[:, None] * log_g[None, :])
    new_state = jnp.exp(c * log_g)[None, :, None, None] * state + jnp.einsum('bjhd,bjhe,jh->bhde', k, v, k_decay)
    return new_state, o


def retention_prompt(q, k, v, log_g):
    bsz, t = q.shape[:2]
    pad = (-t) % RET_CHUNK
    nc = (t + pad) // RET_CHUNK

    def chunks(a):
        a = jnp.pad(a, ((0, 0), (pad, 0), (0, 0), (0, 0)))
        return jnp.moveaxis(a.reshape((bsz, nc, RET_CHUNK) + a.shape[2:]), 1, 0)

    def step(state, xs):
        return retention_chunk(state, xs[0], xs[1], xs[2], log_g)

    s0 = jnp.zeros((bsz, RET_HEADS, RET_DK, RET_DV), jnp.float32)
    state, o = lax.scan(step, s0, (chunks(q), chunks(k), chunks(v)))
    o = jnp.moveaxis(o, 0, 1).reshape(bsz, nc * RET_CHUNK, RET_HEADS, RET_DV)[:, pad:]
    return o, state


def group_norm(o, gain):
    bsz, t = o.shape[:2]
    mu = jnp.mean(o, axis=-1, keepdims=True)
    var = jnp.mean(jnp.square(o - mu), axis=-1, keepdims=True)
    y = (o - mu) * lax.rsqrt(var + GN_EPS)
    return y.reshape(bsz, t, RET_HEADS * RET_DV) * gain


def token_mixer(u, pos, lp, state, buf):
    f32 = jnp.float32
    bsz, t, _ = u.shape
    (xa, ya, qs, ks, vs, qr, kr, vr, gr, gates) = jnp.split((u @ lp['w_in']).astype(f32), IN_SPLITS, axis=-1)
    if state is None:
        conv_hist = jnp.zeros((bsz, CONV_WIDTH - 1, LRU_WIDTH), f32)
        h0 = jnp.zeros((bsz, LRU_WIDTH), f32)
        ck = cv = s_ret = None
    else:
        ck, cv, conv_hist, h0, s_ret = [a.astype(f32) for a in state]
    x_ext = jnp.concatenate([conv_hist, xa], axis=1)
    xc = causal_conv(x_ext, lp['conv_w'].astype(f32), lp['conv_b'].astype(f32))
    h = rg_lru(xc, h0, lp['lru_w_a'].astype(f32), lp['lru_b_a'].astype(f32),
               lp['lru_w_x'].astype(f32), lp['lru_b_x'].astype(f32), lp['lru_lambda'].astype(f32))
    o_a = h * jax.nn.gelu(ya)
    new_conv = x_ext[:, -(CONV_WIDTH - 1):]
    new_h = h[:, -1]
    q = qs.reshape(bsz, t, SWA_HEADS, SWA_HEAD_DIM)
    k = ks.reshape(bsz, t, SWA_KV_HEADS, SWA_HEAD_DIM)
    v = vs.reshape(bsz, t, SWA_KV_HEADS, SWA_HEAD_DIM)
    if state is None:
        o_b = swa_prompt(q, k, v, lp['swa_sinks'])
        new_k, new_v = k[:, -buf:], v[:, -buf:]
    else:
        o_b, new_k, new_v = swa_sample(q, k, v, ck, cv, lp['swa_sinks'])
    log_g = retention_log_gamma()
    qc = rope(qr.reshape(bsz, t, RET_HEADS, RET_DK), pos)
    kc = rope(kr.reshape(bsz, t, RET_HEADS, RET_DK), pos) * RET_DK ** -0.5
    vc = vr.reshape(bsz, t, RET_HEADS, RET_DV)
    if state is None:
        o_r, new_s = retention_prompt(qc, kc, vc, log_g)
    else:
        new_s, o_r = retention_chunk(s_ret, qc, kc, vc, log_g)
    o_c = group_norm(o_r, lp['ret_norm'].astype(f32)) * jax.nn.silu(gr)
    g_a, g_b, g_c = jnp.split(jax.nn.sigmoid(gates), N_BRANCH, axis=-1)
    merged = (g_a * (o_a @ lp['w_branch_a'].astype(f32))
              + g_b * (o_b @ lp['w_branch_b'].astype(f32))
              + g_c * (o_c @ lp['w_branch_c'].astype(f32)))
    out = (merged @ lp['w_out'].astype(f32)).astype(u.dtype)
    new_state = [a.astype(u.dtype) for a in (new_k, new_v, new_conv, new_h, new_s)]
    return out, new_state


def trunk(x, pos, cache, params, final_norm, buf):
    new = ([], [], [], [], [])
    for l in range(DEPTH):
        lp = {name: w[l] for name, w in params.items()}
        st = None if cache is None else [c[l] for c in cache]
        x = x + 0.5 * swiglu(rms_norm(x, lp['ffn1_norm']), lp['ffn1_w_gu'], lp['ffn1_w_down'])
        mo, ns = token_mixer(rms_norm(x, lp['mix_norm']), pos, lp, st, buf)
        x = x + mo
        x = x + 0.5 * swiglu(rms_norm(x, lp['ffn2_norm']), lp['ffn2_w_gu'], lp['ffn2_w_down'])
        for acc, s in zip(new, ns):
            acc.append(s)
    return rms_norm(x, final_norm), [jnp.stack(acc) for acc in new]


def setup_inputs(seed: int = 0) -> dict:
    key = jax.random.key(seed)
    ks = jax.random.split(key, 40)
    f32 = jnp.float32

    def nrm(k, shape, scale):
        return scale * jax.random.normal(k, shape, f32)

    def gain(k, shape):
        return 1.0 + 0.02 * jax.random.normal(k, shape, f32)

    buf = min(WINDOW, PAST_LEN)
    s = jax.random.uniform(ks[20], (DEPTH, LRU_WIDTH), f32, 0.9, 0.999) ** (1.0 / LRU_C)
    lam = jnp.log(s) - jnp.log1p(-s)
    hv = SWA_HEADS * SWA_HEAD_DIM
    rv = RET_HEADS * RET_DV
    return {
        'x_prompt': nrm(ks[0], (BATCH, SEQ, D_MODEL), 1.0),
        'x_sample': nrm(ks[1], (DEC_BATCH, DEC_SEQ, D_MODEL), 1.0),
        'cache_swa_k': nrm(ks[2], (DEPTH, DEC_BATCH, buf, SWA_KV_HEADS, SWA_HEAD_DIM), 1.0),
        'cache_swa_v': nrm(ks[3], (DEPTH, DEC_BATCH, buf, SWA_KV_HEADS, SWA_HEAD_DIM), 1.0),
        'state_conv': nrm(ks[4], (DEPTH, DEC_BATCH, CONV_WIDTH - 1, LRU_WIDTH), 1.0),
        'state_lru': nrm(ks[5], (DEPTH, DEC_BATCH, LRU_WIDTH), 0.5),
        'state_ret': nrm(ks[6], (DEPTH, DEC_BATCH, RET_HEADS, RET_DK, RET_DV), 1.0),
        'meta_tokens': nrm(ks[7], (N_META, D_MODEL), 1.0),
        'ffn1_norm': gain(ks[8], (DEPTH, D_MODEL)),
        'ffn1_w_gu': nrm(ks[9], (DEPTH, D_MODEL, 2 * D_FF), D_MODEL ** -0.5),
        'ffn1_w_down': nrm(ks[10], (DEPTH, D_FF, D_MODEL), D_FF ** -0.5),
        'mix_norm': gain(ks[11], (DEPTH, D_MODEL)),
        'w_in': nrm(ks[12], (DEPTH, D_MODEL, IN_DIM), D_MODEL ** -0.5),
        'conv_w': nrm(ks[13], (DEPTH, CONV_WIDTH, LRU_WIDTH), CONV_WIDTH ** -0.5),
        'conv_b': nrm(ks[14], (DEPTH, LRU_WIDTH), 0.01),
        'lru_w_a': nrm(ks[15], (DEPTH, LRU_BLOCKS, LRU_BW, LRU_BW), LRU_BW ** -0.5),
        'lru_b_a': nrm(ks[16], (DEPTH, LRU_WIDTH), 0.01),
        'lru_w_x': nrm(ks[17], (DEPTH, LRU_BLOCKS, LRU_BW, LRU_BW), LRU_BW ** -0.5),
        'lru_b_x': nrm(ks[18], (DEPTH, LRU_WIDTH), 0.01),
        'lru_lambda': lam,
        'swa_sinks': nrm(ks[21], (DEPTH, SWA_HEADS), 1.0),
        'ret_norm': gain(ks[22], (DEPTH, rv)),
        'w_branch_a': nrm(ks[23], (DEPTH, LRU_WIDTH, D_MODEL), LRU_WIDTH ** -0.5),
        'w_branch_b': nrm(ks[24], (DEPTH, hv, D_MODEL), hv ** -0.5),
        'w_branch_c': nrm(ks[25], (DEPTH, rv, D_MODEL), rv ** -0.5),
        'w_out': nrm(ks[26], (DEPTH, D_MODEL, D_MODEL), D_MODEL ** -0.5),
        'ffn2_norm': gain(ks[27], (DEPTH, D_MODEL)),
        'ffn2_w_gu': nrm(ks[28], (DEPTH, D_MODEL, 2 * D_FF), D_MODEL ** -0.5),
        'ffn2_w_down': nrm(ks[29], (DEPTH, D_FF, D_MODEL), D_FF ** -0.5),
        'final_norm': gain(ks[30], (D_MODEL,)),
    }


def reference(x_prompt, x_sample, cache_swa_k, cache_swa_v, state_conv, state_lru, state_ret,
              meta_tokens, ffn1_norm, ffn1_w_gu, ffn1_w_down, mix_norm, w_in, conv_w, conv_b,
              lru_w_a, lru_b_a, lru_w_x, lru_b_x, lru_lambda, swa_sinks, ret_norm,
              w_branch_a, w_branch_b, w_branch_c, w_out, ffn2_norm, ffn2_w_gu, ffn2_w_down, final_norm):
    params = {
        'ffn1_norm': ffn1_norm, 'ffn1_w_gu': ffn1_w_gu, 'ffn1_w_down': ffn1_w_down,
        'mix_norm': mix_norm, 'w_in': w_in, 'conv_w': conv_w, 'conv_b': conv_b,
        'lru_w_a': lru_w_a, 'lru_b_a': lru_b_a, 'lru_w_x': lru_w_x, 'lru_b_x': lru_b_x,
        'lru_lambda': lru_lambda, 'swa_sinks': swa_sinks, 'ret_norm': ret_norm,
        'w_branch_a': w_branch_a, 'w_branch_b': w_branch_b, 'w_branch_c': w_branch_c,
        'w_out': w_out, 'ffn2_norm': ffn2_norm, 'ffn2_w_gu': ffn2_w_gu, 'ffn2_w_down': ffn2_w_down,
    }
    buf = cache_swa_k.shape[2]
    bsz = x_prompt.shape[0]
    meta = jnp.broadcast_to(meta_tokens.astype(x_prompt.dtype)[None], (bsz, N_META, D_MODEL))
    xp = jnp.concatenate([meta, x_prompt], axis=1)
    pos_p = jnp.arange(xp.shape[1])
    pos_s = PAST_LEN + jnp.arange(x_sample.shape[1])
    yp, sp = trunk(xp, pos_p, None, params, final_norm, buf)
    ys, ss = trunk(x_sample, pos_s, [cache_swa_k, cache_swa_v, state_conv, state_lru, state_ret],
                   params, final_norm, buf)
    return (yp[:, N_META:], ys, sp[0], sp[1], sp[2], sp[3], sp[4], ss[0], ss[1], ss[2], ss[3], ss[4])
```

```cpp
#include <hip/hip_runtime.h>
#include <hip/hip_cooperative_groups.h>
#include <cstdio>
#include <cstdint>
#include <cmath>
namespace cg = cooperative_groups;

namespace pg8 {
#define PG8_LAS __attribute__((address_space(3)))
typedef unsigned short bf16_t;
typedef short bf16x8 __attribute__((ext_vector_type(8)));
typedef float f32x4 __attribute__((ext_vector_type(4)));
typedef unsigned u32x4 __attribute__((ext_vector_type(4)));
constexpr int BM = 256, BK = 64, HALF = 128, HTB = HALF * BK * 2  , STAGE_BYTES = 8 * HTB, NXCD = 8, WGM = 8;

__host__ __device__ __forceinline__ int lds_byte(int r, int c) { const int st = (r >> 4) * 2 + (c >> 5), rr = r & 15, cc = c & 31, ob = rr * 64 + cc * 2; return st * 1024 + (ob ^ (((ob >> 9) & 1) << 5)); }
__host__ __device__ __forceinline__ void stage_rc(int b, int& R, int& C) { const int st = b / 1024, sb = b % 1024, swz = sb ^ (((sb >> 9) & 1) << 5); R = (st >> 1) * 16 + swz / 64; C = (st & 1) * 32 + (swz % 64) / 2; }
__host__ __device__ __forceinline__ int perm32(int rho) { const int n = rho >> 4, i = rho & 15; return 8 * (i >> 2) + 4 * n + (i & 3); }

struct Unit { int pm, pn; };
struct Gemm { const bf16_t* A; const bf16_t* Bt; int M, N, K; int agdiv; size_t agstride; };

struct StaticOrder {
    int nM, nN, nwg, G, c;
    __host__ __device__ void init(int M, int N, int G_, int c_) { nM = M / BM; nN = N / BM; nwg = nM * nN; G = G_; c = c_; }
    __host__ __device__ bool next(int i, Unit& u) const {
        const long L = (long)i * G + c; if (L >= nwg) return false;
        int wgid = (int)L; { const int q = nwg / NXCD, r = nwg % NXCD, xcd = wgid % NXCD, off = wgid / NXCD; wgid = (xcd < r ? xcd * (q + 1) : r * (q + 1) + (xcd - r) * q) + off; }
        const int nig = WGM * nN, gid = wgid / nig, fm = gid * WGM, gsz = (nM - fm) < WGM ? (nM - fm) : WGM;
        u.pm = fm + ((wgid % nig) % gsz); u.pn = (wgid % nig) / gsz; return true;
    }
    __device__ __forceinline__ void a_ready(const Unit&) const {}
    __device__ __forceinline__ void done(const Unit&) const {}
};

__device__ __forceinline__ unsigned cvt_pk_bf16(float lo, float hi) { unsigned r; asm volatile("v_cvt_pk_bf16_f32 %0, %1, %2" : "=v"(r) : "v"(lo), "v"(hi)); return r; }
typedef unsigned u32x2 __attribute__((ext_vector_type(2)));
__device__ __forceinline__ float fsigmoid(float x) { return __builtin_amdgcn_rcpf(1.0f + __expf(-x)); }
__device__ __forceinline__ float fsilu(float x) { return x * fsigmoid(x); }
__device__ __forceinline__ float bflo(unsigned w) { return __uint_as_float(w << 16); }
__device__ __forceinline__ float bfhi(unsigned w) { return __uint_as_float(w & 0xffff0000u); }

__device__ __forceinline__ float row_ss(const float* ss, int row) {
    const f32x4* p = (const f32x4*)(ss + (size_t)row * 16); const f32x4 a = p[0], b = p[1], c = p[2], d = p[3];
    return (((a[0] + a[1]) + (a[2] + a[3])) + ((b[0] + b[1]) + (b[2] + b[3]))) + (((c[0] + c[1]) + (c[2] + c[3])) + ((d[0] + d[1]) + (d[2] + d[3])));
}
struct EpiSwiGLU {
    static constexpr bool PERM = true, AFTER_DRAIN = false, HAS_MID = false;
    bf16_t* H; const float* ss;
    __device__ __forceinline__ void operator()(const f32x4 (&acc)[2][2][4][2], const Unit& u, int wr, int wc, int fr, int fq) const {
        const int row0 = u.pm * BM + wr * 64 + fr, col0 = u.pn * 128 + wc * 32 + 8 * fq;
#pragma unroll
        for (int ai = 0; ai < 2; ++ai)
#pragma unroll
            for (int m = 0; m < 4; ++m) {
                const int row = row0 + ai * HALF + m * 16;
                const float rs = ss[row];
                const f32x4 g0 = acc[ai][0][m][0] * rs, g1 = acc[ai][0][m][1] * rs, u0 = acc[ai][1][m][0] * rs, u1 = acc[ai][1][m][1] * rs;
                u32x4 w;
                w.x = cvt_pk_bf16(fsilu(g0[0]) * u0[0], fsilu(g0[1]) * u0[1]); w.y = cvt_pk_bf16(fsilu(g0[2]) * u0[2], fsilu(g0[3]) * u0[3]);
                w.z = cvt_pk_bf16(fsilu(g1[0]) * u1[0], fsilu(g1[1]) * u1[1]); w.w = cvt_pk_bf16(fsilu(g1[2]) * u1[2], fsilu(g1[3]) * u1[3]);
                *(u32x4*)(H + (size_t)row * 2048 + col0) = w;
            }
    }
};
struct EpiResid {
    static constexpr bool PERM = false, AFTER_DRAIN = false, HAS_MID = false;
    float* X; bf16_t* XB; float* ssn; float scale;
    __device__ __forceinline__ void operator()(const f32x4 (&acc)[2][2][4][2], const Unit& u, int wr, int wc, int fr, int fq) const {
        const int row0 = u.pm * BM + wr * 64 + fr, col0 = u.pn * BM + wc * 32 + 4 * fq;
#pragma unroll
        for (int ai = 0; ai < 2; ++ai)
#pragma unroll
            for (int m = 0; m < 4; ++m) {
                const int row = row0 + ai * HALF + m * 16; float sq = 0.f;
#pragma unroll
                for (int bj = 0; bj < 2; ++bj)
#pragma unroll
                    for (int n = 0; n < 2; ++n) {
                        const size_t off = (size_t)row * 1024 + col0 + bj * HALF + n * 16;
                        f32x4 x = *(const f32x4*)(X + off); x = x + acc[ai][bj][m][n] * scale; *(f32x4*)(X + off) = x;
                        u32x2 w; w.x = cvt_pk_bf16(x[0], x[1]); w.y = cvt_pk_bf16(x[2], x[3]); *(u32x2*)(XB + off) = w;
                        sq += (x[0] * x[0] + x[1] * x[1]) + (x[2] * x[2] + x[3] * x[3]);
                    }
                sq += __shfl_xor(sq, 16); sq += __shfl_xor(sq, 32);
                if (fq == 0) ssn[(size_t)row * 16 + u.pn * 4 + wc] = sq;
            }
    }
};
struct EpiProj {
    static constexpr bool PERM = true, AFTER_DRAIN = false, HAS_MID = false;
    bf16_t* PA; bf16_t* GT; const float* ss;
    __device__ __forceinline__ void operator()(const f32x4 (&acc)[2][2][4][2], const Unit& u, int wr, int wc, int fr, int fq) const {
        const int row0 = u.pm * BM + wr * 64 + fr; const bool gate = u.pn >= 13;
        const int col0 = (gate ? (u.pn - 13) : u.pn) * BM + wc * 32 + 8 * fq;
        bf16_t* base = gate ? GT : PA; const int ld = gate ? 3072 : 3328;
#pragma unroll
        for (int ai = 0; ai < 2; ++ai)
#pragma unroll
            for (int m = 0; m < 4; ++m) {
                const int row = row0 + ai * HALF + m * 16;
                const float rs = ss[row];
#pragma unroll
                for (int bj = 0; bj < 2; ++bj) {
                    f32x4 v0 = acc[ai][bj][m][0] * rs, v1 = acc[ai][bj][m][1] * rs;
                    if (gate) {
#pragma unroll
                        for (int k = 0; k < 4; ++k) { v0[k] = fsigmoid(v0[k]); v1[k] = fsigmoid(v1[k]); }
                    }
                    u32x4 w; w.x = cvt_pk_bf16(v0[0], v0[1]); w.y = cvt_pk_bf16(v0[2], v0[3]); w.z = cvt_pk_bf16(v1[0], v1[1]); w.w = cvt_pk_bf16(v1[2], v1[3]);
                    *(u32x4*)(base + (size_t)row * ld + col0 + bj * HALF) = w;
                }
            }
    }
};
struct EpiBranch {
    static constexpr bool PERM = true, AFTER_DRAIN = false, HAS_MID = true;
    bf16_t* MB; const bf16_t* GT;
    __device__ __forceinline__ void mid(f32x4 (&acc)[2][2][4][2], const Unit& u, int seg, int wr, int wc, int fr, int fq) const {
        int fr_ = fr; asm volatile("" : "+v"(fr_));
        const int row0 = u.pm * BM + wr * 64 + fr_, col0 = u.pn * BM + wc * 32 + 8 * fq;
#pragma unroll
        for (int ai = 0; ai < 2; ++ai)
#pragma unroll
            for (int m = 0; m < 4; ++m) {
                const int row = row0 + ai * HALF + m * 16;
#pragma unroll
                for (int bj = 0; bj < 2; ++bj) {
                    const bf16_t* gp = GT + (size_t)row * 3072 + (seg - 1) * 1024 + col0 + bj * HALF;
                    const u32x4 g0 = *(const u32x4*)gp, g1 = *(const u32x4*)(gp + 1024);
                    f32x4 r0, r1;
                    r0[0] = bflo(g0.x) * __builtin_amdgcn_rcpf(fmaxf(bflo(g1.x), 1e-30f)); r0[1] = bfhi(g0.x) * __builtin_amdgcn_rcpf(fmaxf(bfhi(g1.x), 1e-30f));
                    r0[2] = bflo(g0.y) * __builtin_amdgcn_rcpf(fmaxf(bflo(g1.y), 1e-30f)); r0[3] = bfhi(g0.y) * __builtin_amdgcn_rcpf(fmaxf(bfhi(g1.y), 1e-30f));
                    r1[0] = bflo(g0.z) * __builtin_amdgcn_rcpf(fmaxf(bflo(g1.z), 1e-30f)); r1[1] = bfhi(g0.z) * __builtin_amdgcn_rcpf(fmaxf(bfhi(g1.z), 1e-30f));
                    r1[2] = bflo(g0.w) * __builtin_amdgcn_rcpf(fmaxf(bflo(g1.w), 1e-30f)); r1[3] = bfhi(g0.w) * __builtin_amdgcn_rcpf(fmaxf(bfhi(g1.w), 1e-30f));
                    acc[ai][bj][m][0] = acc[ai][bj][m][0] * r0; acc[ai][bj][m][1] = acc[ai][bj][m][1] * r1;
                }
                if (m == 3) asm volatile("" ::: "memory");
            }
    }
    __device__ __forceinline__ void operator()(const f32x4 (&acc)[2][2][4][2], const Unit& u, int wr, int wc, int fr, int fq) const {
        const int row0 = u.pm * BM + wr * 64 + fr, col0 = u.pn * BM + wc * 32 + 8 * fq;
#pragma unroll
        for (int ai = 0; ai < 2; ++ai)
#pragma unroll
            for (int m = 0; m < 4; ++m) {
                const int row = row0 + ai * HALF + m * 16;
#pragma unroll
                for (int bj = 0; bj < 2; ++bj) {
                    const u32x4 gt = *(const u32x4*)(GT + (size_t)row * 3072 + 2048 + col0 + bj * HALF);
                    const f32x4 v0 = acc[ai][bj][m][0], v1 = acc[ai][bj][m][1];
                    u32x4 w;
                    w.x = cvt_pk_bf16(v0[0] * bflo(gt.x), v0[1] * bfhi(gt.x)); w.y = cvt_pk_bf16(v0[2] * bflo(gt.y), v0[3] * bfhi(gt.y));
                    w.z = cvt_pk_bf16(v1[0] * bflo(gt.z), v1[1] * bfhi(gt.z)); w.w = cvt_pk_bf16(v1[2] * bflo(gt.w), v1[3] * bfhi(gt.w));
                    *(u32x4*)(MB + (size_t)row * 1024 + col0 + bj * HALF) = w;
                }
            }
    }
};


template <class Epi, class Sched, bool ALIGN_EPI = false, bool SP2 = false>
__device__ __forceinline__ void gemm_phase(PG8_LAS unsigned char* lds, const Gemm g, const Sched& S, const Epi& E) {
    int tid_ = threadIdx.x; asm volatile("" : "+v"(tid_));
    const int tid = tid_, wid = __builtin_amdgcn_readfirstlane(tid >> 6), lane = tid & 63, wr = wid >> 2, wc = wid & 3, fr = lane & 15, fq = lane >> 4;
    const int K = g.K, nt = K / BK;
    unsigned voffA[2], voffB[2];
#pragma unroll
    for (int i = 0; i < 2; ++i) { int R, C; stage_rc(tid * 16 + i * 8192, R, C); const int Rb = Epi::PERM ? ((R & ~31) + perm32(R & 31)) : R;
        voffA[i] = (unsigned)(R * K + C) * 2u; voffB[i] = (unsigned)(Rb * K + C) * 2u; }
    const size_t kstep = (size_t)(BK * 2);
    const size_t hstep = (size_t)HALF * K * 2;
    const size_t tstep = 2 * hstep;
    const unsigned ldsw = (unsigned)wid * 1024u;
    const int aoff = lds_byte(wr * 64 + fr, fq * 8), boff = lds_byte(wc * 32 + fr, fq * 8);
#define PG8_SA(b, h) (((b) * 2 + (h)) * HTB)
#define PG8_SB(b, h) ((4 + (b) * 2 + (h)) * HTB)
#define PG8_STAGE(bufoff, gbase, voff) do { _Pragma("unroll") for (int _i = 0; _i < 2; ++_i) \
        __builtin_amdgcn_global_load_lds((const unsigned*)((const char*)(gbase) + (voff)[_i]), (PG8_LAS unsigned*)(lds + (bufoff) + ldsw + _i * 8192), 16, 0, 0); } while (0)
#define PG8_LDA(dst, b, h) do { _Pragma("unroll") for (int m = 0; m < 4; ++m) _Pragma("unroll") for (int k = 0; k < 2; ++k) dst[m][k] = *(const PG8_LAS bf16x8*)(lds + PG8_SA(b, h) + aoff + m * 2048 + k * 1024); } while (0)
#define PG8_LDB(dst, b, h) do { _Pragma("unroll") for (int n = 0; n < 2; ++n) _Pragma("unroll") for (int k = 0; k < 2; ++k) dst[n][k] = *(const PG8_LAS bf16x8*)(lds + PG8_SB(b, h) + boff + n * 2048 + k * 1024); } while (0)
#define PG8_MMA(ai, bj, At, Bt) do { __builtin_amdgcn_s_setprio(1); _Pragma("unroll") for (int m = 0; m < 4; ++m) _Pragma("unroll") for (int n = 0; n < 2; ++n) _Pragma("unroll") for (int k = 0; k < 2; ++k) \
        acc[ai][bj][m][n] = __builtin_amdgcn_mfma_f32_16x16x32_bf16(Bt[n][k], At[m][k], acc[ai][bj][m][n], 0, 0, 0); __builtin_amdgcn_s_setprio(0); } while (0)
#define PG8_WAIT_V(n) asm volatile("s_waitcnt vmcnt(" #n ")" ::: "memory")
#define PG8_WAIT_L(n) asm volatile("s_waitcnt lgkmcnt(" #n ")" ::: "memory")
#define PG8_BAR __builtin_amdgcn_s_barrier()
#define PG8_SCHED __builtin_amdgcn_sched_barrier(0)
    Unit cur, nxt; int ui = 0;
    if (!S.next(0, cur)) return;
    f32x4 acc[2][2][4][2];
#pragma unroll
    for (int a = 0; a < 2; ++a)
#pragma unroll
        for (int b = 0; b < 2; ++b)
#pragma unroll
            for (int m = 0; m < 4; ++m)
#pragma unroll
                for (int n = 0; n < 2; ++n) acc[a][b][m][n] = (f32x4){0.f, 0.f, 0.f, 0.f};
    bf16x8 At[4][2], B0[2][2], B1[2][2];
    const char* cA = (const char*)g.A + (size_t)cur.pm * tstep + (size_t)(cur.pn / g.agdiv) * g.agstride; const char* cB = (const char*)g.Bt + (size_t)cur.pn * tstep;
    S.a_ready(cur);
    if constexpr (SP2) {
        PG8_STAGE(PG8_SB(0, 0), cB, voffB); PG8_STAGE(PG8_SB(0, 1), cB + hstep, voffB); PG8_STAGE(PG8_SA(0, 0), cA, voffA); PG8_STAGE(PG8_SA(0, 1), cA + hstep, voffA);
        if (wr == 1) PG8_BAR;
        PG8_WAIT_V(2); PG8_BAR;
        PG8_STAGE(PG8_SB(1, 0), cB + kstep, voffB); PG8_STAGE(PG8_SA(1, 0), cA + kstep, voffA); PG8_STAGE(PG8_SB(1, 1), cB + hstep + kstep, voffB);
        PG8_WAIT_V(6); PG8_BAR;
    } else {
        PG8_STAGE(PG8_SB(0, 0), cB, voffB); PG8_STAGE(PG8_SA(0, 0), cA, voffA); PG8_STAGE(PG8_SB(0, 1), cB + hstep, voffB); PG8_STAGE(PG8_SA(0, 1), cA + hstep, voffA);
        if (wr == 1) PG8_BAR;
        PG8_WAIT_V(4); PG8_BAR;
        PG8_STAGE(PG8_SB(1, 0), cB + kstep, voffB); PG8_STAGE(PG8_SA(1, 0), cA + kstep, voffA); PG8_STAGE(PG8_SB(1, 1), cB + hstep + kstep, voffB);
        PG8_WAIT_V(6); PG8_BAR;
    }
    for (;;) {
        const bool has_next = S.next(ui + 1, nxt);
        const char* nA = has_next ? (const char*)g.A + (size_t)nxt.pm * tstep + (size_t)(nxt.pn / g.agdiv) * g.agstride : cA; const char* nB = has_next ? (const char*)g.Bt + (size_t)nxt.pn * tstep : cB;
        for (int t = 0; t < nt; t += 2) {
            if constexpr (Epi::HAS_MID) { if (t == 8 || t == 16) E.mid(acc, cur, t >> 3, wr, wc, fr, fq); }
            const bool last = (t == nt - 2);
            const char* a1 = cA + (size_t)(t + 1) * kstep;
            const char* a2 = last ? nA : cA + (size_t)(t + 2) * kstep; const char* b2 = last ? nB : cB + (size_t)(t + 2) * kstep;
            const char* a3 = a2 + kstep; const char* b3 = b2 + kstep;
            if (last && has_next) S.a_ready(nxt);
            if constexpr (SP2) {
            PG8_LDB(B0, 0, 0); PG8_LDB(B1, 0, 1); PG8_SCHED; PG8_LDA(At, 0, 0); PG8_STAGE(PG8_SA(1, 1), a1 + hstep, voffA);
            PG8_WAIT_V(8); PG8_WAIT_L(0); PG8_BAR; PG8_MMA(0, 0, At, B0); PG8_MMA(0, 1, At, B1); PG8_BAR; PG8_SCHED;
            PG8_LDA(At, 0, 1); PG8_STAGE(PG8_SB(0, 0), b2, voffB); PG8_STAGE(PG8_SB(0, 1), b2 + hstep, voffB); PG8_STAGE(PG8_SA(0, 0), a2, voffA);
            PG8_WAIT_V(8); PG8_WAIT_L(0); PG8_BAR; PG8_MMA(1, 0, At, B0); PG8_MMA(1, 1, At, B1); PG8_BAR; PG8_SCHED;
            PG8_LDB(B0, 1, 0); PG8_LDB(B1, 1, 1); PG8_SCHED; PG8_LDA(At, 1, 0); PG8_STAGE(PG8_SA(0, 1), a2 + hstep, voffA);
            PG8_WAIT_V(8); PG8_WAIT_L(0); PG8_BAR; PG8_MMA(0, 0, At, B0); PG8_MMA(0, 1, At, B1); PG8_BAR; PG8_SCHED;
            PG8_LDA(At, 1, 1); PG8_STAGE(PG8_SB(1, 0), b3, voffB); PG8_STAGE(PG8_SB(1, 1), b3 + hstep, voffB); PG8_STAGE(PG8_SA(1, 0), a3, voffA);
            PG8_WAIT_V(8); PG8_WAIT_L(0); PG8_BAR; PG8_MMA(1, 0, At, B0); PG8_MMA(1, 1, At, B1); PG8_BAR; PG8_SCHED;
            } else {
            PG8_LDB(B0, 0, 0); PG8_SCHED; PG8_LDA(At, 0, 0); PG8_STAGE(PG8_SA(1, 1), a1 + hstep, voffA);
            PG8_WAIT_L(8); PG8_BAR; PG8_WAIT_L(0); PG8_MMA(0, 0, At, B0); PG8_BAR; PG8_SCHED;
            PG8_LDB(B1, 0, 1); PG8_STAGE(PG8_SB(0, 0), b2, voffB);
            PG8_BAR; PG8_WAIT_L(0); PG8_MMA(0, 1, At, B1); PG8_BAR;
            PG8_LDA(At, 0, 1); PG8_STAGE(PG8_SA(0, 0), a2, voffA);
            PG8_BAR; PG8_WAIT_L(0); PG8_MMA(1, 0, At, B0); PG8_BAR; PG8_SCHED;
            PG8_STAGE(PG8_SB(0, 1), b2 + hstep, voffB);
            PG8_WAIT_V(6); PG8_BAR; PG8_MMA(1, 1, At, B1); PG8_BAR;
            PG8_LDB(B0, 1, 0); PG8_SCHED; PG8_LDA(At, 1, 0); PG8_STAGE(PG8_SA(0, 1), a2 + hstep, voffA);
            PG8_WAIT_L(8); PG8_BAR; PG8_WAIT_L(0); PG8_MMA(0, 0, At, B0); PG8_BAR; PG8_SCHED;
            PG8_LDB(B1, 1, 1); PG8_STAGE(PG8_SB(1, 0), b3, voffB);
            PG8_BAR; PG8_WAIT_L(0); PG8_MMA(0, 1, At, B1); PG8_BAR;
            PG8_LDA(At, 1, 1); PG8_STAGE(PG8_SA(1, 0), a3, voffA);
            PG8_BAR; PG8_WAIT_L(0); PG8_MMA(1, 0, At, B0); PG8_BAR; PG8_SCHED;
            PG8_STAGE(PG8_SB(1, 1), b3 + hstep, voffB);
            PG8_WAIT_V(6); PG8_BAR; PG8_MMA(1, 1, At, B1); PG8_BAR;
            }
        }
        if constexpr (ALIGN_EPI) { if (wr == 0) PG8_BAR; }
        if constexpr (!Epi::AFTER_DRAIN) { E(acc, cur, wr, wc, fr, fq); S.done(cur); }
        if (!has_next) break;
#pragma unroll
        for (int a = 0; a < 2; ++a)
#pragma unroll
            for (int b = 0; b < 2; ++b)
#pragma unroll
                for (int m = 0; m < 4; ++m)
#pragma unroll
                    for (int n = 0; n < 2; ++n) acc[a][b][m][n] = (f32x4){0.f, 0.f, 0.f, 0.f};
        cur = nxt; cA = nA; cB = nB; ++ui;
        if constexpr (ALIGN_EPI) { if (wr == 1) PG8_BAR; }
    }
    PG8_WAIT_V(0);
    if constexpr (!ALIGN_EPI) { if (wr == 0) PG8_BAR; }
    PG8_BAR;
    if constexpr (Epi::AFTER_DRAIN) { E.fused(acc, cur, wr, wc, fr, fq, lds, wid, lane); S.done(cur); }
#undef PG8_SA
#undef PG8_SB
#undef PG8_STAGE
#undef PG8_LDA
#undef PG8_LDB
#undef PG8_MMA
#undef PG8_WAIT_V
#undef PG8_WAIT_L
#undef PG8_BAR
#undef PG8_SCHED
}
}

#define LAS __attribute__((address_space(3)))
typedef unsigned short bf16_t;
typedef short bf16x8 __attribute__((ext_vector_type(8)));
typedef short s16x4 __attribute__((ext_vector_type(4)));
typedef float f32x4 __attribute__((ext_vector_type(4)));
typedef unsigned u32x4 __attribute__((ext_vector_type(4)));
typedef unsigned u32x2 __attribute__((ext_vector_type(2)));
using pg8::cvt_pk_bf16; using pg8::fsigmoid; using pg8::fsilu; using pg8::bflo; using pg8::bfhi;

constexpr int DM = 1024, FF = 2048, NIN = 6400, DEPTH = 4;
constexpr int MP = 16896;
constexpr int BROWS = 8320;
constexpr int PADR = 112, TPB = 8208, NT = 65;
constexpr int SROW0 = 16640;
constexpr int MREAL = 16768;
constexpr int PAW = 3328, GTW = 3072;
constexpr int C_XA = 0, C_YA = 512, C_QS = 1024, C_KS = 1536, C_VS = 1664, C_QR = 1792, C_KR = 2048, C_VR = 2304, C_GR = 2816;
constexpr int NTHR = 512;
constexpr int OBS = 1536;
constexpr int LDS_BYTES = 131072 + 256;

constexpr size_t MiB = 1u << 20;
constexpr size_t WS_BAR = 0;
constexpr size_t WS_LSUM = 1 * MiB;
constexpr size_t WS_LCAR = WS_LSUM + 1 * MiB;
constexpr size_t WS_W0 = 3 * MiB;
constexpr size_t WSZ = 46 * MiB;
constexpr size_t W_GU1 = 0, W_D1 = 8 * MiB, W_IN = 12 * MiB, W_BR = 25 * MiB, W_OUT = 28 * MiB, W_GU2 = 34 * MiB, W_D2 = 42 * MiB;
constexpr size_t WS_X = WS_W0 + 2 * WSZ;
constexpr size_t WS_XB = WS_X + 66 * MiB;
constexpr size_t WS_PA = WS_XB + 33 * MiB;
constexpr size_t WS_GT = WS_PA + 108 * MiB;
constexpr size_t WS_OB = WS_GT + 99 * MiB;
constexpr size_t WS_U = WS_OB + 50 * MiB;
constexpr size_t WS_ST = WS_U + 17 * MiB;
constexpr size_t WS_SS16 = WS_ST + 9 * MiB;
constexpr size_t WS_BG = WS_SS16 + 14 * MiB;
constexpr size_t WS_RS = WS_BG + 33 * MiB;
constexpr size_t WS_END = WS_RS + 1 * MiB;

constexpr int O_YP = 0, O_YS = 16777216, O_PK = 16908288, O_PV = 17039360, O_PC = 17170432, O_PL = 17182720, O_PR = 17186816,
              O_SK = 17448960, O_SV = 25837568, O_SC = 34226176, O_SL = 35012608, O_SR = 35274752;

enum { I_XP = 0, I_XS, I_CK, I_CV, I_SCONV, I_SLRU, I_SRET, I_META, I_F1N, I_F1GU, I_F1D, I_MIXN, I_WIN, I_CONVW, I_CONVB, I_LWA, I_LBA, I_LWX, I_LBX, I_LAM,
       I_SINK, I_RETN, I_WBA, I_WBB, I_WBC, I_WOUT, I_F2N, I_F2GU, I_F2D, I_FINN };

struct Args { const float* in[30]; float* out; unsigned char* ws; int ph_lo, ph_hi; };
typedef const __attribute__((address_space(4))) Args CArgs;

__device__ __forceinline__ float bf2f(bf16_t v) { return __uint_as_float((unsigned)v << 16); }
__device__ __forceinline__ bf16_t f2bf(float f) { return (bf16_t)(cvt_pk_bf16(f, 0.f) & 0xffffu); }
__device__ __forceinline__ float gelu_tanh(float x) { const float t = 0.7978845608028654f * (x + 0.044715f * x * x * x); const float e = __expf(2.0f * t); const float th = 1.0f - 2.0f * __builtin_amdgcn_rcpf(e + 1.0f); return 0.5f * x * (1.0f + th); }
__device__ __forceinline__ void sincos_rev(float ang, float& s, float& c) {
    const double rv = (double)ang * 0.15915494309189535; const float fr = (float)(rv - __builtin_rint(rv));
    s = __builtin_amdgcn_sinf(fr); c = __builtin_amdgcn_cosf(fr);
}
__device__ __forceinline__ float rope_inv(int i) { return exp2f(-(float)i * (13.287712379549449f / 32.0f)); }
__device__ __forceinline__ float log2_gamma(int h) { return log2f(1.0f - exp2f(-5.0f - (float)h)); }
__device__ __forceinline__ int tid_opaque() { int t = threadIdx.x; asm volatile("" : "+v"(t)); return t; }
#define LDSW() asm volatile("s_waitcnt lgkmcnt(0)" ::: "memory")

__device__ __forceinline__ void cvt_item(const float* W, int K, int N, bf16_t* WT, int ldk, int rep, const float* g, int mode, LAS float* scr, int item, int lane) {
    const int nblk = N / 32, kb = item / nblk, nb = item % nblk, k0 = 64 * kb, n0 = 32 * nb;
    float wv[32];
#pragma unroll
    for (int i = 0; i < 32; ++i) { const int kk = 2 * i + (lane >> 5); wv[i] = W[(size_t)(k0 + kk) * N + n0 + (lane & 31)]; }
#pragma unroll
    for (int i = 0; i < 32; ++i) { const int kk = 2 * i + (lane >> 5); float w = wv[i]; if (g) w *= g[k0 + kk]; scr[kk * 33 + (lane & 31)] = w; }
    LDSW();
    const int c = lane & 7;
#pragma unroll
    for (int j = 0; j < 4; ++j) {
        const int n = (lane >> 3) + 8 * j; const LAS float* s = scr + (8 * c) * 33 + n;
        u32x4 o; o.x = cvt_pk_bf16(s[0 * 33], s[1 * 33]); o.y = cvt_pk_bf16(s[2 * 33], s[3 * 33]); o.z = cvt_pk_bf16(s[4 * 33], s[5 * 33]); o.w = cvt_pk_bf16(s[6 * 33], s[7 * 33]);
        const int nn = n0 + n; const int drow = mode ? (256 * ((nn & 2047) >> 7) + 128 * (nn >> 11) + (nn & 127)) : nn;
        for (int r = 0; r < rep; ++r) *(u32x4*)(WT + (size_t)drow * ldk + r * K + k0 + 8 * c) = o;
    }
    LDSW();
}
__device__ __forceinline__ void convert_layer(CArgs* a, int l, unsigned char* wbuf, LAS unsigned char* lds, int gw, int ngw, int wave, int lane) {
    LAS float* scr = (LAS float*)(lds + wave * 8448);
    constexpr int I_GU = 16 * 128, I_D = 32 * 32, I_W = 16 * 200, I_B = 8 * 32, I_O = 16 * 32;
    constexpr int NITEMS = 2 * I_GU + 2 * I_D + I_W + 3 * I_B + I_O;
    for (int it = gw; it < NITEMS; it += ngw) {
        int r = it;
        if (r < I_GU) { cvt_item(a->in[I_F1GU] + (size_t)l * DM * 4096, DM, 4096, (bf16_t*)(wbuf + W_GU1), DM, 1, a->in[I_F1N] + l * DM, 1, scr, r, lane); continue; } r -= I_GU;
        if (r < I_GU) { cvt_item(a->in[I_F2GU] + (size_t)l * DM * 4096, DM, 4096, (bf16_t*)(wbuf + W_GU2), DM, 1, a->in[I_F2N] + l * DM, 1, scr, r, lane); continue; } r -= I_GU;
        if (r < I_D) { cvt_item(a->in[I_F1D] + (size_t)l * FF * DM, FF, DM, (bf16_t*)(wbuf + W_D1), FF, 1, nullptr, 0, scr, r, lane); continue; } r -= I_D;
        if (r < I_D) { cvt_item(a->in[I_F2D] + (size_t)l * FF * DM, FF, DM, (bf16_t*)(wbuf + W_D2), FF, 1, nullptr, 0, scr, r, lane); continue; } r -= I_D;
        if (r < I_W) { cvt_item(a->in[I_WIN] + (size_t)l * DM * NIN, DM, NIN, (bf16_t*)(wbuf + W_IN), DM, 1, a->in[I_MIXN] + l * DM, 0, scr, r, lane); continue; } r -= I_W;
        if (r < 3 * I_B) { const int br = r / I_B; cvt_item((br == 0 ? a->in[I_WBA] : (br == 1 ? a->in[I_WBB] : a->in[I_WBC])) + (size_t)l * 512 * DM, 512, DM, (bf16_t*)(wbuf + W_BR) + br * 512, OBS, 1, nullptr, 0, scr, r % I_B, lane); continue; } r -= 3 * I_B;
        cvt_item(a->in[I_WOUT] + (size_t)l * DM * DM, DM, DM, (bf16_t*)(wbuf + W_OUT), DM, 1, nullptr, 0, scr, r, lane);
    }
}

__device__ __forceinline__ float wave_sum(float v) {
#pragma unroll
    for (int o = 1; o < 64; o <<= 1) v += __shfl_xor(v, o);
    return v;
}
__device__ __forceinline__ void init_rows(CArgs* a, float* X, bf16_t* XB, float* SS, float* RS0, bf16_t* OB, int gw, int ngw, int lane) {
    for (int r = gw; r < MP; r += ngw) {
        const float* src = nullptr;
        if (r < 2 * BROWS) { const int b = r / BROWS, pr = r % BROWS; if (pr >= PADR) { const int t = pr - PADR; src = (t < 16) ? a->in[I_META] + (size_t)t * DM : a->in[I_XP] + ((size_t)b * 8192 + (t - 16)) * DM; } }
        else if (r < MREAL) src = a->in[I_XS] + (size_t)(r - SROW0) * DM;
        float sq = 0.f;
#pragma unroll
        for (int j = 0; j < 4; ++j) {
            f32x4 v = (f32x4){0.f, 0.f, 0.f, 0.f};
            if (src) v = *((const f32x4*)src + lane + 64 * j);
            *((f32x4*)(X + (size_t)r * DM) + lane + 64 * j) = v;
            u32x2 w; w.x = cvt_pk_bf16(v[0], v[1]); w.y = cvt_pk_bf16(v[2], v[3]); *((u32x2*)(XB + (size_t)r * DM) + lane + 64 * j) = w;
            sq += (v[0] * v[0] + v[1] * v[1]) + (v[2] * v[2] + v[3] * v[3]);
        }
        sq = wave_sum(sq);
        if (lane < 16) SS[(size_t)r * 16 + lane] = (lane == 0) ? sq : 0.f;
        if (lane == 0) RS0[r] = __builtin_amdgcn_rsqf(sq * (1.0f / 1024.0f) + 1e-6f);
        if (r >= MREAL) {
#pragma unroll
            for (int br = 0; br < 3; ++br) *((u32x4*)(OB + (size_t)r * OBS + br * 512) + lane) = (u32x4){0u, 0u, 0u, 0u};
        }
    }
}

__device__ __forceinline__ void lru1_item(CArgs* a, int l, int tt, int chblk, const bf16_t* PA, bf16_t* OB0, float* LSUM, float* AG, float* BG, LAS unsigned char* lds) {
    LAS float* xa_s = (LAS float*)lds;
    LAS float* xc_s = xa_s + 131 * 64;
    LAS bf16_t* wt_s = (LAS bf16_t*)(xc_s + 128 * 64);
    LAS float* seg_s = (LAS float*)(wt_s + 128 * 72);
    const int tid = tid_opaque(), lane = tid & 63, w = tid >> 6, fr = lane & 15, fq = lane >> 4;
    const int ch0 = chblk * 64, ch = ch0 + lane;
    const bool sample = (tt == 130);
    const int b = tt / NT, n = tt % NT;
    const int row0 = sample ? SROW0 : b * BROWS + n * 128;
    {
        const float* wa = a->in[I_LWA] + ((size_t)l * 8 + chblk) * 4096; const float* wx = a->in[I_LWX] + ((size_t)l * 8 + chblk) * 4096;
        float wv[16];
#pragma unroll
        for (int k = 0; k < 16; ++k) { const int i = tid + k * NTHR; wv[k] = (i < 4096) ? wa[i] : wx[i - 4096]; }
#pragma unroll
        for (int k = 0; k < 16; ++k) { const int i = tid + k * NTHR; const int m = i >> 12, c = (i >> 6) & 63, d = i & 63; wt_s[(m * 64 + d) * 72 + c] = f2bf(wv[k]); }
    }
    const float cw0 = a->in[I_CONVW][(l * 4 + 0) * 512 + ch], cw1 = a->in[I_CONVW][(l * 4 + 1) * 512 + ch], cw2 = a->in[I_CONVW][(l * 4 + 2) * 512 + ch], cw3 = a->in[I_CONVW][(l * 4 + 3) * 512 + ch];
    const float cb = a->in[I_CONVB][l * 512 + ch];
    if (!sample) {
        float xv[17];
#pragma unroll
        for (int k = 0; k < 17; ++k) {
            const int rr = w + 8 * k; const int grow = row0 - 3 + rr; xv[k] = 0.f;
            if (rr < 131 && !(n == 0 && rr < 3)) xv[k] = bf2f(PA[(size_t)grow * PAW + C_XA + ch]);
        }
#pragma unroll
        for (int k = 0; k < 17; ++k) { const int rr = w + 8 * k; if (rr < 131) xa_s[rr * 64 + lane] = xv[k]; }
        __syncthreads();
#pragma unroll 4
        for (int r = w; r < 128; r += 8) xc_s[r * 64 + lane] = cb + cw0 * xa_s[r * 64 + lane] + cw1 * xa_s[(r + 1) * 64 + lane] + cw2 * xa_s[(r + 2) * 64 + lane] + cw3 * xa_s[(r + 3) * 64 + lane];
        if (n == NT - 1 && w < 3) a->out[O_PC + ((l * 2 + b) * 3 + w) * 512 + ch] = xa_s[(128 + w) * 64 + lane];
    } else {
#pragma unroll
        for (int k = 0; k < 16; ++k) { const int r = w + 8 * k;
            const float* sc = a->in[I_SCONV] + ((size_t)(l * 128 + r) * 3) * 512 + ch; const float s0 = sc[0], s1 = sc[512], s2 = sc[1024];
            const float xa = bf2f(PA[(size_t)(SROW0 + r) * PAW + C_XA + ch]);
            xc_s[r * 64 + lane] = cb + cw0 * s0 + cw1 * s1 + cw2 * s2 + cw3 * xa;
            float* oc = a->out + O_SC + ((size_t)(l * 128 + r) * 3) * 512 + ch; oc[0] = s1; oc[512] = s2; oc[1024] = xa;
        }
    }
    __syncthreads();
    f32x4 acc[8];
    {
        bf16x8 af[2];
#pragma unroll
        for (int ks = 0; ks < 2; ++ks) {
            const f32x4 x0 = *(const LAS f32x4*)(xc_s + (16 * w + fr) * 64 + 32 * ks + 8 * fq), x1 = *(const LAS f32x4*)(xc_s + (16 * w + fr) * 64 + 32 * ks + 8 * fq + 4);
            u32x4 p; p.x = cvt_pk_bf16(x0[0], x0[1]); p.y = cvt_pk_bf16(x0[2], x0[3]); p.z = cvt_pk_bf16(x1[0], x1[1]); p.w = cvt_pk_bf16(x1[2], x1[3]); af[ks] = __builtin_bit_cast(bf16x8, p);
        }
#pragma unroll
        for (int t = 0; t < 8; ++t) {
            acc[t] = (f32x4){0.f, 0.f, 0.f, 0.f};
#pragma unroll
            for (int ks = 0; ks < 2; ++ks) { const bf16x8 bfr = *(const LAS bf16x8*)(wt_s + (t * 16 + fr) * 72 + 32 * ks + 8 * fq); acc[t] = __builtin_amdgcn_mfma_f32_16x16x32_bf16(af[ks], bfr, acc[t], 0, 0, 0); }
        }
    }
    LAS float* a_s = xa_s;
#pragma unroll
    for (int dt = 0; dt < 4; ++dt) {
        const int d = 16 * dt + fr, cch = ch0 + d;
        const float ba = a->in[I_LBA][l * 512 + cch], bx = a->in[I_LBX][l * 512 + cch];
        const float sp = log1pf(__expf(-a->in[I_LAM][l * 512 + cch]));
#pragma unroll
        for (int i = 0; i < 4; ++i) {
            const int r = 16 * w + 4 * fq + i;
            const float rg = fsigmoid(acc[dt][i] + ba), ig = fsigmoid(acc[4 + dt][i] + bx);
            const float la = -8.0f * rg * sp; float av = __expf(la);
            const float t2 = 2.0f * la;
            const float om = (t2 > -0.0625f) ? -t2 * (1.0f + t2 * (0.5f + t2 * (0.16666667f + t2 * (0.041666667f + t2 * 0.0083333333f)))) : 1.0f - av * av;
            float bv = __builtin_amdgcn_sqrtf(om) * (ig * xc_s[r * 64 + d]);
            if (!sample && n == 0 && r < PADR) { av = 1.0f; bv = 0.0f; }
            a_s[r * 64 + d] = av; xc_s[r * 64 + d] = bv;
        }
    }
    __syncthreads();
    if (sample) {
#pragma unroll
        for (int i = 0; i < 16; ++i) {
            const int r = w * 16 + i;
            const float hs = a_s[r * 64 + lane] * a->in[I_SLRU][(size_t)(l * 128 + r) * 512 + ch] + xc_s[r * 64 + lane];
            a->out[O_SL + (size_t)(l * 128 + r) * 512 + ch] = hs;
            const float ya = bf2f(PA[(size_t)(SROW0 + r) * PAW + C_YA + ch]);
            OB0[(size_t)(SROW0 + r) * OBS + ch] = f2bf(hs * gelu_tanh(ya));
        }
        __syncthreads();
        return;
    }
    float P = 1.0f, h = 0.0f;
#pragma unroll 4
    for (int i = 0; i < 16; ++i) {
        const int r = w * 16 + i; const float av = a_s[r * 64 + lane], bv = xc_s[r * 64 + lane];
        AG[(size_t)(row0 + r) * 512 + ch] = av; BG[(size_t)(row0 + r) * 512 + ch] = bv;
        h = av * h + bv; P *= av;
    }
    seg_s[(w * 64 + lane) * 2] = P; seg_s[(w * 64 + lane) * 2 + 1] = h;
    __syncthreads();
    if (w == 0) {
        float Pt = 1.0f, ht = 0.0f;
#pragma unroll
        for (int q = 0; q < 8; ++q) { const float p = seg_s[(q * 64 + lane) * 2], hh = seg_s[(q * 64 + lane) * 2 + 1]; ht = p * ht + hh; Pt *= p; }
        LSUM[((size_t)tt * 512 + ch) * 2] = Pt; LSUM[((size_t)tt * 512 + ch) * 2 + 1] = ht;
    }
    __syncthreads();
}
__device__ __forceinline__ void lru2_item(int tt, int chblk, const bf16_t* PA, bf16_t* OB0, const float* LCAR, const float* AG, const float* BG, LAS unsigned char* lds) {
    LAS float* seg_s = (LAS float*)lds;
    const int tid = tid_opaque(), lane = tid & 63, w = tid >> 6; const int ch = chblk * 64 + lane;
    const int b = tt / NT, n = tt % NT, row0 = b * BROWS + n * 128 + w * 16;
    float av[16], bv[16], yv[16];
#pragma unroll
    for (int i = 0; i < 16; ++i) { av[i] = AG[(size_t)(row0 + i) * 512 + ch]; bv[i] = BG[(size_t)(row0 + i) * 512 + ch]; yv[i] = bf2f(PA[(size_t)(row0 + i) * PAW + C_YA + ch]); }
    float hc = LCAR[(size_t)tt * 512 + ch];
    float P = 1.0f, h = 0.0f;
#pragma unroll
    for (int i = 0; i < 16; ++i) { h = av[i] * h + bv[i]; P *= av[i]; }
    seg_s[(w * 64 + lane) * 2] = P; seg_s[(w * 64 + lane) * 2 + 1] = h;
    __syncthreads();
    for (int q = 0; q < w; ++q) { const float p = seg_s[(q * 64 + lane) * 2], hh = seg_s[(q * 64 + lane) * 2 + 1]; hc = p * hc + hh; }
#pragma unroll
    for (int i = 0; i < 16; ++i) { hc = av[i] * hc + bv[i]; OB0[(size_t)(row0 + i) * OBS + ch] = f2bf(hc * gelu_tanh(yv[i])); }
    __syncthreads();
}

__device__ __forceinline__ void swa_item(CArgs* a, int l, int item, const bf16_t* PA, bf16_t* OB1, LAS unsigned char* lds) {
    const int kvh = item & 1, bn = item >> 1, b = bn / NT, n = bn % NT, row0 = b * BROWS + n * 128;
    LAS bf16_t* Ks = (LAS bf16_t*)lds;
    LAS bf16_t* Vt = Ks + 256 * 72;
    const int tid = tid_opaque(), lane = tid & 63, w = tid >> 6, fr = lane & 15, fq = lane >> 4;
    const int g = w >> 1, h = kvh * 4 + g;
    const float sink = a->in[I_SINK][l * 8 + h];
    bf16x8 qfa[4][2];
#pragma unroll
    for (int qb = 0; qb < 4; ++qb) { const int row = row0 + (w & 1) * 64 + qb * 16 + fr; qfa[qb][0] = *(const bf16x8*)(PA + (size_t)row * PAW + C_QS + h * 64 + fq * 8); qfa[qb][1] = *(const bf16x8*)(PA + (size_t)row * PAW + C_QS + h * 64 + 32 + fq * 8); }
    {
        const int key = tid >> 1, hf = tid & 1; const int grow = row0 - 128 + key; const bool valid = (n > 0) || (key >= 128);
        u32x4 kk[4], vv[4];
#pragma unroll
        for (int j = 0; j < 4; ++j) { kk[j] = (u32x4){0u, 0u, 0u, 0u}; vv[j] = (u32x4){0u, 0u, 0u, 0u}; }
        if (valid) {
            const u32x4* kp = (const u32x4*)(PA + (size_t)grow * PAW + C_KS + kvh * 64 + hf * 32); const u32x4* vp = (const u32x4*)(PA + (size_t)grow * PAW + C_VS + kvh * 64 + hf * 32);
#pragma unroll
            for (int j = 0; j < 4; ++j) { kk[j] = kp[j]; vv[j] = vp[j]; }
        }
#pragma unroll
        for (int j = 0; j < 4; ++j) *(LAS u32x4*)(Ks + key * 72 + hf * 32 + j * 8) = kk[j];
#pragma unroll
        for (int j = 0; j < 4; ++j) {
            const unsigned ws4[4] = {vv[j].x, vv[j].y, vv[j].z, vv[j].w};
#pragma unroll
            for (int q = 0; q < 4; ++q) { const int d = hf * 32 + j * 8 + q * 2; Vt[d * 280 + key] = (bf16_t)(ws4[q] & 0xffffu); Vt[(d + 1) * 280 + key] = (bf16_t)(ws4[q] >> 16); }
        }
        if (tid < 64) {
#pragma unroll
            for (int e = 256; e < 280; ++e) Vt[tid * 280 + e] = 0;
        }
        if (n == NT - 1 && key >= 128) {
            float* ok = a->out + O_PK + ((size_t)(l * 2 + b) * 128 + (key - 128)) * 128 + kvh * 64 + hf * 32; float* ov = a->out + O_PV + ((size_t)(l * 2 + b) * 128 + (key - 128)) * 128 + kvh * 64 + hf * 32;
#pragma unroll
            for (int j = 0; j < 4; ++j) {
                *(f32x4*)(ok + j * 8) = (f32x4){bflo(kk[j].x), bfhi(kk[j].x), bflo(kk[j].y), bfhi(kk[j].y)}; *(f32x4*)(ok + j * 8 + 4) = (f32x4){bflo(kk[j].z), bfhi(kk[j].z), bflo(kk[j].w), bfhi(kk[j].w)};
                *(f32x4*)(ov + j * 8) = (f32x4){bflo(vv[j].x), bfhi(vv[j].x), bflo(vv[j].y), bfhi(vv[j].y)}; *(f32x4*)(ov + j * 8 + 4) = (f32x4){bflo(vv[j].z), bfhi(vv[j].z), bflo(vv[j].w), bfhi(vv[j].w)};
            }
        }
    }
    __syncthreads();
#pragma unroll
    for (int qb = 0; qb < 4; ++qb) {
        const int r0 = (w & 1) * 64 + qb * 16, jt0 = r0 >> 4, r = r0 + fr, row = row0 + r;
        const bf16x8 qf[2] = {qfa[qb][0], qfa[qb][1]};
        f32x4 sacc[10];
#pragma unroll
        for (int t = 0; t < 9; ++t) {
            sacc[t] = (f32x4){0.f, 0.f, 0.f, 0.f};
#pragma unroll
            for (int ks = 0; ks < 2; ++ks) { const bf16x8 kf = *(const LAS bf16x8*)(Ks + ((jt0 + t) * 16 + fr) * 72 + ks * 32 + fq * 8); sacc[t] = __builtin_amdgcn_mfma_f32_16x16x32_bf16(kf, qf[ks], sacc[t], 0, 0, 0); }
        }
        sacc[9] = (f32x4){0.f, 0.f, 0.f, 0.f};
        float mx = -INFINITY;
#pragma unroll
        for (int t = 0; t < 9; ++t)
#pragma unroll
            for (int i = 0; i < 4; ++i) {
                const int kj = (jt0 + t) * 16 + 4 * fq + i;
                const bool valid = (kj > r) && (kj <= r + 128) && (n * 128 - 128 + kj >= PADR);
                const float s = valid ? sacc[t][i] * 0.125f : -INFINITY; sacc[t][i] = s; mx = fmaxf(mx, s);
            }
        mx = fmaxf(mx, __shfl_xor(mx, 16)); mx = fmaxf(mx, __shfl_xor(mx, 32));
        const float mm = fmaxf(mx, sink);
        float sum = 0.f;
#pragma unroll
        for (int t = 0; t < 9; ++t)
#pragma unroll
            for (int i = 0; i < 4; ++i) { const float e = __expf(sacc[t][i] - mm); sacc[t][i] = e; sum += e; }
        sum += __shfl_xor(sum, 16); sum += __shfl_xor(sum, 32);
        const float inv = 1.0f / (sum + __expf(sink - mm));
        f32x4 oacc[4];
#pragma unroll
        for (int dt = 0; dt < 4; ++dt) oacc[dt] = (f32x4){0.f, 0.f, 0.f, 0.f};
#pragma unroll
        for (int p = 0; p < 5; ++p) {
            const f32x4 ea = sacc[2 * p] * inv, eb = sacc[2 * p + 1] * inv;
            u32x4 pw; pw.x = cvt_pk_bf16(ea[0], ea[1]); pw.y = cvt_pk_bf16(ea[2], ea[3]); pw.z = cvt_pk_bf16(eb[0], eb[1]); pw.w = cvt_pk_bf16(eb[2], eb[3]);
            const bf16x8 pb = __builtin_bit_cast(bf16x8, pw);
            const int ja = jt0 + 2 * p;
#pragma unroll
            for (int dt = 0; dt < 4; ++dt) {
                const u32x2 va = *(const LAS u32x2*)(Vt + (dt * 16 + fr) * 280 + ja * 16 + 4 * fq), vb = *(const LAS u32x2*)(Vt + (dt * 16 + fr) * 280 + (ja + 1) * 16 + 4 * fq);
                const u32x4 vw = (u32x4){va.x, va.y, vb.x, vb.y};
                oacc[dt] = __builtin_amdgcn_mfma_f32_16x16x32_bf16(__builtin_bit_cast(bf16x8, vw), pb, oacc[dt], 0, 0, 0);
            }
        }
#pragma unroll
        for (int dt = 0; dt < 4; ++dt) { u32x2 o; o.x = cvt_pk_bf16(oacc[dt][0], oacc[dt][1]); o.y = cvt_pk_bf16(oacc[dt][2], oacc[dt][3]); *(u32x2*)(OB1 + (size_t)row * OBS + h * 64 + dt * 16 + 4 * fq) = o; }
    }
    __syncthreads();
}

__device__ __forceinline__ void ret_u_item(int item, const bf16_t* PA, float* U, LAS unsigned char* lds) {
    const int hh = item & 3, bc = item >> 2, b = bc / NT, c = bc % NT, row0 = b * BROWS + c * 128;
    LAS bf16_t* Kt = (LAS bf16_t*)lds;
    LAS bf16_t* Vt = Kt + 64 * 136;
    const int tid = tid_opaque(), lane = tid & 63, w = tid >> 6, fr = lane & 15, fq = lane >> 4; const float l2g = log2_gamma(hh);
    {
        const int j = tid >> 2, q = tid & 3; const bf16_t* rowp = PA + (size_t)(row0 + j) * PAW;
        const u32x4* vp = (const u32x4*)(rowp + C_VR + hh * 128 + q * 32);
        u32x4 vv[4];
#pragma unroll
        for (int t = 0; t < 4; ++t) vv[t] = vp[t];
        const u32x4 k1 = *(const u32x4*)(rowp + C_KR + hh * 64 + q * 8), k2 = *(const u32x4*)(rowp + C_KR + hh * 64 + 32 + q * 8);
#pragma unroll
        for (int t = 0; t < 4; ++t) {
            const unsigned ws4[4] = {vv[t].x, vv[t].y, vv[t].z, vv[t].w};
#pragma unroll
            for (int k = 0; k < 4; ++k) { const int e = q * 32 + t * 8 + k * 2; Vt[e * 136 + j] = (bf16_t)(ws4[k] & 0xffffu); Vt[(e + 1) * 136 + j] = (bf16_t)(ws4[k] >> 16); }
        }
        const unsigned w1[4] = {k1.x, k1.y, k1.z, k1.w}, w2[4] = {k2.x, k2.y, k2.z, k2.w};
        const int pos = c * 128 + j - PADR; const float dec = exp2f((float)(127 - j) * l2g) * 0.125f;
#pragma unroll
        for (int k = 0; k < 4; ++k) {
            float sa, ca, sb, cb; sincos_rev((float)pos * rope_inv(q * 8 + 2 * k), sa, ca); sincos_rev((float)pos * rope_inv(q * 8 + 2 * k + 1), sb, cb);
            const float x1a = bflo(w1[k]), x1b = bfhi(w1[k]), x2a = bflo(w2[k]), x2b = bfhi(w2[k]);
            const int d = q * 8 + 2 * k;
            Kt[d * 136 + j] = f2bf((x1a * ca - x2a * sa) * dec); Kt[(d + 32) * 136 + j] = f2bf((x1a * sa + x2a * ca) * dec);
            Kt[(d + 1) * 136 + j] = f2bf((x1b * cb - x2b * sb) * dec); Kt[(d + 33) * 136 + j] = f2bf((x1b * sb + x2b * cb) * dec);
        }
    }
    __syncthreads();
    const int dt = w >> 1;
    f32x4 acc[4];
#pragma unroll
    for (int t = 0; t < 4; ++t) acc[t] = (f32x4){0.f, 0.f, 0.f, 0.f};
#pragma unroll
    for (int ks = 0; ks < 4; ++ks) {
        const bf16x8 kf = *(const LAS bf16x8*)(Kt + (dt * 16 + fr) * 136 + 32 * ks + 8 * fq);
#pragma unroll
        for (int t = 0; t < 4; ++t) { const bf16x8 vf = *(const LAS bf16x8*)(Vt + ((4 * (w & 1) + t) * 16 + fr) * 136 + 32 * ks + 8 * fq); acc[t] = __builtin_amdgcn_mfma_f32_16x16x32_bf16(vf, kf, acc[t], 0, 0, 0); }
    }
#pragma unroll
    for (int t = 0; t < 4; ++t)
#pragma unroll
        for (int i = 0; i < 4; ++i) U[(size_t)item * 8192 + ((4 * (w & 1) + t) * 16 + 4 * fq + i) * 64 + dt * 16 + fr] = acc[t][i];
    __syncthreads();
}
__device__ __forceinline__ void ret_out_item(CArgs* a, int l, int item, const bf16_t* PA, const bf16_t* ST, bf16_t* OB2, LAS unsigned char* lds) {
    const int hh = item & 3, bc = item >> 2, b = bc / NT, c = bc % NT, row0 = b * BROWS + c * 128;
    LAS bf16_t* Kr = (LAS bf16_t*)lds;
    LAS bf16_t* Vt = Kr + 128 * 72;
    const int tid = tid_opaque(), lane = tid & 63, w = tid >> 6, fr = lane & 15, fq = lane >> 4; const float l2g = log2_gamma(hh);
    {
        const int j = tid >> 2, q = tid & 3; const bf16_t* rowp = PA + (size_t)(row0 + j) * PAW;
        const u32x4* vp = (const u32x4*)(rowp + C_VR + hh * 128 + q * 32);
        u32x4 vv[4];
#pragma unroll
        for (int t = 0; t < 4; ++t) vv[t] = vp[t];
        const u32x4 k1 = *(const u32x4*)(rowp + C_KR + hh * 64 + q * 8), k2 = *(const u32x4*)(rowp + C_KR + hh * 64 + 32 + q * 8);
#pragma unroll
        for (int t = 0; t < 4; ++t) {
            const unsigned ws4[4] = {vv[t].x, vv[t].y, vv[t].z, vv[t].w};
#pragma unroll
            for (int k = 0; k < 4; ++k) { const int e = q * 32 + t * 8 + k * 2; Vt[e * 136 + j] = (bf16_t)(ws4[k] & 0xffffu); Vt[(e + 1) * 136 + j] = (bf16_t)(ws4[k] >> 16); }
        }
        const unsigned w1[4] = {k1.x, k1.y, k1.z, k1.w}, w2[4] = {k2.x, k2.y, k2.z, k2.w};
        const int pos = c * 128 + j - PADR; unsigned o1[4], o2[4];
#pragma unroll
        for (int k = 0; k < 4; ++k) {
            float sa, ca, sb, cb; sincos_rev((float)pos * rope_inv(q * 8 + 2 * k), sa, ca); sincos_rev((float)pos * rope_inv(q * 8 + 2 * k + 1), sb, cb);
            const float x1a = bflo(w1[k]), x1b = bfhi(w1[k]), x2a = bflo(w2[k]), x2b = bfhi(w2[k]);
            o1[k] = cvt_pk_bf16((x1a * ca - x2a * sa) * 0.125f, (x1b * cb - x2b * sb) * 0.125f); o2[k] = cvt_pk_bf16((x1a * sa + x2a * ca) * 0.125f, (x1b * sb + x2b * cb) * 0.125f);
        }
        *(LAS u32x4*)(Kr + j * 72 + q * 8) = (u32x4){o1[0], o1[1], o1[2], o1[3]}; *(LAS u32x4*)(Kr + j * 72 + 32 + q * 8) = (u32x4){o2[0], o2[1], o2[2], o2[3]};
    }
    __syncthreads();
    const int il = 16 * w + fr, row = row0 + il, pos = c * 128 + il - PADR;
    bf16x8 qf[2], qs[2];
    {
        const u32x4 q1 = *(const u32x4*)(PA + (size_t)row * PAW + C_QR + hh * 64 + fq * 8), q2 = *(const u32x4*)(PA + (size_t)row * PAW + C_QR + hh * 64 + 32 + fq * 8);
        const unsigned w1[4] = {q1.x, q1.y, q1.z, q1.w}, w2[4] = {q2.x, q2.y, q2.z, q2.w};
        const float dsc = exp2f((float)(il + 1) * l2g);
        u32x4 o1, o2, s1, s2; unsigned r1[4], r2[4], t1[4], t2[4];
#pragma unroll
        for (int k = 0; k < 4; ++k) {
            float sa, ca, sb, cb; sincos_rev((float)pos * rope_inv(fq * 8 + 2 * k), sa, ca); sincos_rev((float)pos * rope_inv(fq * 8 + 2 * k + 1), sb, cb);
            const float x1a = bflo(w1[k]), x1b = bfhi(w1[k]), x2a = bflo(w2[k]), x2b = bfhi(w2[k]);
            const float y1a = x1a * ca - x2a * sa, y2a = x1a * sa + x2a * ca, y1b = x1b * cb - x2b * sb, y2b = x1b * sb + x2b * cb;
            r1[k] = cvt_pk_bf16(y1a, y1b); r2[k] = cvt_pk_bf16(y2a, y2b); t1[k] = cvt_pk_bf16(y1a * dsc, y1b * dsc); t2[k] = cvt_pk_bf16(y2a * dsc, y2b * dsc);
        }
        o1 = (u32x4){r1[0], r1[1], r1[2], r1[3]}; o2 = (u32x4){r2[0], r2[1], r2[2], r2[3]}; s1 = (u32x4){t1[0], t1[1], t1[2], t1[3]}; s2 = (u32x4){t2[0], t2[1], t2[2], t2[3]};
        qf[0] = __builtin_bit_cast(bf16x8, o1); qf[1] = __builtin_bit_cast(bf16x8, o2); qs[0] = __builtin_bit_cast(bf16x8, s1); qs[1] = __builtin_bit_cast(bf16x8, s2);
    }
    f32x4 sacc[8];
#pragma unroll
    for (int jt = 0; jt < 8; ++jt) {
        sacc[jt] = (f32x4){0.f, 0.f, 0.f, 0.f};
        if (jt <= w) {
#pragma unroll
            for (int ks = 0; ks < 2; ++ks) { const bf16x8 kf = *(const LAS bf16x8*)(Kr + (jt * 16 + fr) * 72 + ks * 32 + fq * 8); sacc[jt] = __builtin_amdgcn_mfma_f32_16x16x32_bf16(kf, qf[ks], sacc[jt], 0, 0, 0); }
        }
#pragma unroll
        for (int i = 0; i < 4; ++i) { const int dl = il - (jt * 16 + 4 * fq + i); sacc[jt][i] = (dl >= 0) ? sacc[jt][i] * exp2f((float)dl * l2g) : 0.f; }
    }
    f32x4 oacc[8];
#pragma unroll
    for (int et = 0; et < 8; ++et) oacc[et] = (f32x4){0.f, 0.f, 0.f, 0.f};
#pragma unroll
    for (int p = 0; p < 4; ++p) {
        if (2 * p <= w) {
            u32x4 pw; pw.x = cvt_pk_bf16(sacc[2 * p][0], sacc[2 * p][1]); pw.y = cvt_pk_bf16(sacc[2 * p][2], sacc[2 * p][3]); pw.z = cvt_pk_bf16(sacc[2 * p + 1][0], sacc[2 * p + 1][1]); pw.w = cvt_pk_bf16(sacc[2 * p + 1][2], sacc[2 * p + 1][3]);
            const bf16x8 pb = __builtin_bit_cast(bf16x8, pw);
#pragma unroll
            for (int et = 0; et < 8; ++et) {
                const u32x2 va = *(const LAS u32x2*)(Vt + (et * 16 + fr) * 136 + 32 * p + 4 * fq), vb = *(const LAS u32x2*)(Vt + (et * 16 + fr) * 136 + 32 * p + 16 + 4 * fq);
                const u32x4 vw = (u32x4){va.x, va.y, vb.x, vb.y};
                oacc[et] = __builtin_amdgcn_mfma_f32_16x16x32_bf16(__builtin_bit_cast(bf16x8, vw), pb, oacc[et], 0, 0, 0);
            }
        }
    }
    {
        const bf16_t* sb = ST + (size_t)item * 8192;
#pragma unroll
        for (int et = 0; et < 8; ++et)
#pragma unroll
            for (int ks = 0; ks < 2; ++ks) { const bf16x8 sf = *(const bf16x8*)(sb + (et * 16 + fr) * 64 + ks * 32 + fq * 8); oacc[et] = __builtin_amdgcn_mfma_f32_16x16x32_bf16(sf, qs[ks], oacc[et], 0, 0, 0); }
    }
    float sm = 0.f;
#pragma unroll
    for (int et = 0; et < 8; ++et) sm += (oacc[et][0] + oacc[et][1]) + (oacc[et][2] + oacc[et][3]);
    sm += __shfl_xor(sm, 16); sm += __shfl_xor(sm, 32);
    const float mu = sm * (1.0f / 128.0f); float vr = 0.f;
#pragma unroll
    for (int et = 0; et < 8; ++et) { const f32x4 d = oacc[et] - mu; vr += (d[0] * d[0] + d[1] * d[1]) + (d[2] * d[2] + d[3] * d[3]); }
    vr += __shfl_xor(vr, 16); vr += __shfl_xor(vr, 32);
    const float rstd = 1.0f / sqrtf(vr * (1.0f / 128.0f) + 1e-5f);
#pragma unroll
    for (int et = 0; et < 8; ++et) {
        const int e = et * 16 + 4 * fq; const f32x4 gn = *(const f32x4*)(a->in[I_RETN] + l * 512 + hh * 128 + e);
        const u32x2 gr = *(const u32x2*)(PA + (size_t)row * PAW + C_GR + hh * 128 + e);
        const f32x4 y = (oacc[et] - mu) * rstd * gn;
        u32x2 o; o.x = cvt_pk_bf16(y[0] * fsilu(bflo(gr.x)), y[1] * fsilu(bfhi(gr.x))); o.y = cvt_pk_bf16(y[2] * fsilu(bflo(gr.y)), y[3] * fsilu(bfhi(gr.y)));
        *(u32x2*)(OB2 + (size_t)row * OBS + hh * 128 + e) = o;
    }
    __syncthreads();
}


enum { TM_SWIGLU = 0, TM_RESID = 1, TM_PROJ = 2, TM_BRANCH = 3 };
constexpr int TROW0 = 16384;
struct TailArgs { const bf16_t* A; const bf16_t* Bt; int K, N; bf16_t* O1; bf16_t* O2; float* X; const float* ss; float* ssn; const bf16_t* GT; float scale; };
template <int MODE> __device__ __forceinline__ void tail_gemm(const TailArgs& t, int u0, int G, LAS unsigned char* lds) {
    const int tid = tid_opaque(), lane = tid & 63, w = __builtin_amdgcn_readfirstlane(tid >> 6), fr = lane & 15, fq = lane >> 4;
    LAS float* part = (LAS float*)lds;
    const int K = t.K, nu = 8 * (t.N / 64);
    int ks0, nks;
    if (MODE == TM_BRANCH) { if (w < 6) { const int q = w % 3; ks0 = 16 * (w / 3) + (q == 0 ? 0 : (q == 1 ? 6 : 11)); nks = (q == 0) ? 6 : 5; } else { ks0 = 32 + 8 * (w - 6); nks = 8; } }
    else { nks = K / 256; ks0 = w * nks; }
    bf16x8 af[4][3], bfr[4][4];
#define TG_LOAD(uu, s0) do { const int rowb_ = TROW0 + 48 * ((uu) & 7), cgp_ = (uu) >> 3; \
        _Pragma("unroll") for (int sI = 0; sI < 4; ++sI) { if ((s0) + sI < nks) { const int kk = (ks0 + (s0) + sI) * 32 + 8 * fq; \
            _Pragma("unroll") for (int rt = 0; rt < 3; ++rt) af[sI][rt] = *(const bf16x8*)(t.A + (size_t)(rowb_ + 16 * rt + fr) * K + kk); \
            _Pragma("unroll") for (int ct = 0; ct < 4; ++ct) { const int brow = (MODE == TM_SWIGLU) ? 256 * (cgp_ >> 2) + (ct >> 1) * 128 + 32 * (cgp_ & 3) + 16 * (ct & 1) : 64 * cgp_ + 16 * ct; \
                bfr[sI][ct] = *(const bf16x8*)(t.Bt + (size_t)(brow + fr) * K + kk); } } } } while (0)
#define TG_MMA(s0) do { _Pragma("unroll") for (int sI = 0; sI < 4; ++sI) { if ((s0) + sI < nks) { _Pragma("unroll") for (int rt = 0; rt < 3; ++rt) _Pragma("unroll") for (int ct = 0; ct < 4; ++ct) \
            acc[rt][ct] = __builtin_amdgcn_mfma_f32_16x16x32_bf16(af[sI][rt], bfr[sI][ct], acc[rt][ct], 0, 0, 0); } } } while (0)
#pragma unroll 1
    for (int u = u0; u < nu; u += G) {
        const int rg = u & 7, cgp = u >> 3, rowb0 = TROW0 + 48 * rg;
        f32x4 acc[3][4];
#pragma unroll
        for (int rt = 0; rt < 3; ++rt)
#pragma unroll
            for (int ct = 0; ct < 4; ++ct) acc[rt][ct] = (f32x4){0.f, 0.f, 0.f, 0.f};
#pragma unroll 1
        for (int s0 = 0; s0 < nks; s0 += 4) { TG_LOAD(u, s0); TG_MMA(s0); }
#pragma unroll
        for (int rt = 0; rt < 3; ++rt)
#pragma unroll
            for (int ct = 0; ct < 4; ++ct) *(LAS f32x4*)(part + ((w * 12 + rt * 4 + ct) * 64 + lane) * 4) = acc[rt][ct];
        __syncthreads();
        if (w < 3) {
            const int rowb = rowb0 + 16 * w;
            f32x4 sum[4], tot[4];
#pragma unroll
            for (int ct = 0; ct < 4; ++ct) {
                f32x4 p[8];
#pragma unroll
                for (int q = 0; q < 8; ++q) p[q] = *(const LAS f32x4*)(part + ((q * 12 + w * 4 + ct) * 64 + lane) * 4);
                if (MODE == TM_BRANCH) {
                    const f32x4 pa = (p[0] + p[1]) + p[2], pb = (p[3] + p[4]) + p[5], pc = p[6] + p[7];
#pragma unroll
                    for (int i = 0; i < 4; ++i) { const bf16_t* gp = t.GT + (size_t)(rowb + 4 * fq + i) * 3072 + 64 * cgp + 16 * ct + fr; tot[ct][i] = pa[i] * bf2f(gp[0]) + pb[i] * bf2f(gp[1024]) + pc[i] * bf2f(gp[2048]); }
                } else sum[ct] = ((p[0] + p[1]) + (p[2] + p[3])) + ((p[4] + p[5]) + (p[6] + p[7]));
            }
            (void)sum; (void)tot;
            if (MODE == TM_SWIGLU) {
#pragma unroll
                for (int i = 0; i < 4; ++i) {
                    const int row = rowb + 4 * fq + i; const float rs = t.ss[row];
#pragma unroll
                    for (int c2 = 0; c2 < 2; ++c2) t.O1[(size_t)row * 2048 + 128 * (cgp >> 2) + 32 * (cgp & 3) + 16 * c2 + fr] = f2bf(fsilu(sum[c2][i] * rs) * (sum[2 + c2][i] * rs));
                }
            } else if (MODE == TM_RESID) {
#pragma unroll
                for (int i = 0; i < 4; ++i) {
                    const int row = rowb + 4 * fq + i; float sq = 0.f;
#pragma unroll
                    for (int ct = 0; ct < 4; ++ct) {
                        const size_t off = (size_t)row * 1024 + 64 * cgp + 16 * ct + fr;
                        const float x = t.X[off] + sum[ct][i] * t.scale; t.X[off] = x; t.O1[off] = f2bf(x); sq += x * x;
                    }
                    sq += __shfl_xor(sq, 1); sq += __shfl_xor(sq, 2); sq += __shfl_xor(sq, 4); sq += __shfl_xor(sq, 8);
                    if (fr == 0) t.ssn[(size_t)row * 16 + cgp] = sq;
                }
            } else if (MODE == TM_PROJ) {
                const bool gate = 64 * cgp >= PAW;
#pragma unroll
                for (int i = 0; i < 4; ++i) {
                    const int row = rowb + 4 * fq + i; const float rs = t.ss[row];
#pragma unroll
                    for (int ct = 0; ct < 4; ++ct) {
                        const int col = 64 * cgp + 16 * ct + fr; const float v = sum[ct][i] * rs;
                        if (gate) t.O2[(size_t)row * GTW + (col - PAW)] = f2bf(fsigmoid(v)); else t.O1[(size_t)row * PAW + col] = f2bf(v);
                    }
                }
            } else {
#pragma unroll
                for (int i = 0; i < 4; ++i)
#pragma unroll
                    for (int ct = 0; ct < 4; ++ct) t.O1[(size_t)(rowb + 4 * fq + i) * 1024 + 64 * cgp + 16 * ct + fr] = f2bf(tot[ct][i]);
            }
        }
        __syncthreads();
    }
#undef TG_LOAD
#undef TG_MMA
}

__device__ __forceinline__ void carry_item(CArgs* a, int l, int it, const float* LSUM, float* LCAR, const float* U, bf16_t* ST) {
    const int tid = tid_opaque();
    if (it < 2) {
        const int b = it, ch = tid; float h = 0.f;
#pragma unroll 1
        for (int n0 = 0; n0 < NT; n0 += 13) {
            float p[13], q[13];
#pragma unroll
            for (int k = 0; k < 13; ++k) { const size_t o = (size_t)(b * NT + n0 + k) * 512 + ch; p[k] = LSUM[o * 2]; q[k] = LSUM[o * 2 + 1]; }
#pragma unroll
            for (int k = 0; k < 13; ++k) { LCAR[(size_t)(b * NT + n0 + k) * 512 + ch] = h; h = p[k] * h + q[k]; }
        }
        a->out[O_PL + (l * 2 + b) * 512 + ch] = h;
    } else {
        const int eid = (it - 2) * 512 + tid; const int b = eid >> 15, hh = (eid >> 13) & 3, de = eid & 8191, e = de >> 6, d = de & 63;
        const float g128 = exp2f(128.0f * log2_gamma(hh)); float s = 0.f;
#pragma unroll 1
        for (int c0 = 0; c0 < NT; c0 += 13) {
            float u[13];
#pragma unroll
            for (int k = 0; k < 13; ++k) u[k] = U[(size_t)((b * NT + c0 + k) * 4 + hh) * 8192 + de];
#pragma unroll
            for (int k = 0; k < 13; ++k) { ST[(size_t)((b * NT + c0 + k) * 4 + hh) * 8192 + de] = f2bf(s); s = g128 * s + u[k]; }
        }
        a->out[O_PR + ((size_t)(l * 2 + b) * 4 + hh) * 8192 + d * 128 + e] = s;
    }
}

__device__ __forceinline__ void sample_item(CArgs* a, int l, int j, const bf16_t* PA, bf16_t* OB1, bf16_t* OB2, LAS unsigned char* lds) {
    const int tid = tid_opaque(), lane = tid & 63, w = tid >> 6; const int row = SROW0 + j;
    LAS float* q_s = (LAS float*)lds;
    LAS float* p_s = q_s + 512;
    LAS float* rq_s = p_s + 8 * 132;
    LAS float* rk_s = rq_s + 256;
    LAS float* red_s = rk_s + 256;
    const float* ck = a->in[I_CK] + (size_t)(l * 128 + j) * 16384; const float* cv = a->in[I_CV] + (size_t)(l * 128 + j) * 16384;
    const bf16_t* pr = PA + (size_t)row * PAW;
    q_s[tid] = bf2f(pr[C_QS + tid]);
    if (tid < 128) {
        const int hh = tid >> 5, i = tid & 31; float s, co; sincos_rev(8192.0f * rope_inv(i), s, co);
        const float q1 = bf2f(pr[C_QR + hh * 64 + i]), q2 = bf2f(pr[C_QR + hh * 64 + i + 32]), k1 = bf2f(pr[C_KR + hh * 64 + i]), k2 = bf2f(pr[C_KR + hh * 64 + i + 32]);
        rq_s[hh * 64 + i] = q1 * co - q2 * s; rq_s[hh * 64 + i + 32] = q1 * s + q2 * co;
        rk_s[hh * 64 + i] = (k1 * co - k2 * s) * 0.125f; rk_s[hh * 64 + i + 32] = (k1 * s + k2 * co) * 0.125f;
    }
    {
        float* ok = a->out + O_SK + (size_t)(l * 128 + j) * 16384; float* ov = a->out + O_SV + (size_t)(l * 128 + j) * 16384;
        f32x4 ckv[8], cvv[8];
#pragma unroll
        for (int k = 0; k < 8; ++k) { const int i = tid + k * NTHR; if (i < 127 * 32) { ckv[k] = *((const f32x4*)ck + 32 + i); cvv[k] = *((const f32x4*)cv + 32 + i); } }
#pragma unroll
        for (int k = 0; k < 8; ++k) { const int i = tid + k * NTHR; if (i < 127 * 32) { *((f32x4*)ok + i) = ckv[k]; *((f32x4*)ov + i) = cvv[k]; } }
        if (tid < 128) { ok[127 * 128 + tid] = bf2f(pr[C_KS + tid]); ov[127 * 128 + tid] = bf2f(pr[C_VS + tid]); }
    }
    __syncthreads();
    {
        const int h = w, kvh = h >> 2; const float sink = a->in[I_SINK][l * 8 + h];
        float sc[3]; sc[2] = -INFINITY;
#pragma unroll
        for (int t = 0; t < 2; ++t) {
            const int s = lane + 64 * t; const f32x4* kp = (const f32x4*)(ck + (size_t)s * 128 + kvh * 64); float d = 0.f;
#pragma unroll
            for (int q = 0; q < 16; ++q) { const f32x4 k = kp[q]; const f32x4 qq = *(const LAS f32x4*)(q_s + h * 64 + q * 4); d += (k[0] * qq[0] + k[1] * qq[1]) + (k[2] * qq[2] + k[3] * qq[3]); }
            sc[t] = (s == 0) ? -INFINITY : d * 0.125f;
        }
        {
            sc[2] = wave_sum(bf2f(pr[C_KS + kvh * 64 + lane]) * q_s[h * 64 + lane]) * 0.125f;
        }
        float mx = fmaxf(fmaxf(sc[0], sc[1]), sc[2]);
#pragma unroll
        for (int o = 1; o < 64; o <<= 1) mx = fmaxf(mx, __shfl_xor(mx, o));
        const float mm = fmaxf(mx, sink);
        const float e0 = __expf(sc[0] - mm), e1 = __expf(sc[1] - mm), e2 = __expf(sc[2] - mm);
        const float sum = wave_sum(e0 + e1) + e2; const float inv = 1.0f / (sum + __expf(sink - mm));
        p_s[h * 132 + lane] = e0 * inv; p_s[h * 132 + 64 + lane] = e1 * inv; if (lane == 0) p_s[h * 132 + 128] = e2 * inv;
        LDSW();
        float o = p_s[h * 132 + 128] * bf2f(pr[C_VS + kvh * 64 + lane]);
#pragma unroll 32
        for (int s = 0; s < 128; ++s) o += p_s[h * 132 + s] * cv[(size_t)s * 128 + kvh * 64 + lane];
        OB1[(size_t)row * OBS + h * 64 + lane] = f2bf(o);
    }
    {
        const int hh = tid >> 7, e = tid & 127; const float gam = 1.0f - exp2f(-5.0f - (float)hh);
        const float* S = a->in[I_SRET] + ((size_t)(l * 128 + j) * 4 + hh) * 8192; float* So = a->out + O_SR + ((size_t)(l * 128 + j) * 4 + hh) * 8192;
        const float v = bf2f(pr[C_VR + hh * 128 + e]); float acc = 0.f, qk = 0.f;
#pragma unroll 32
        for (int d = 0; d < 64; ++d) { const float s = S[d * 128 + e]; const float q = rq_s[hh * 64 + d], k = rk_s[hh * 64 + d]; acc += q * s; qk += q * k; So[d * 128 + e] = gam * s + k * v; }
        const float o = qk * v + gam * acc;
        float sm = wave_sum(o); if (lane == 0) red_s[w * 2] = sm;
        __syncthreads();
        const float mu = (red_s[(w & ~1) * 2] + red_s[(w | 1) * 2]) * (1.0f / 128.0f); const float dv = o - mu;
        float vs = wave_sum(dv * dv); if (lane == 0) red_s[w * 2 + 1] = vs;
        __syncthreads();
        const float var = (red_s[(w & ~1) * 2 + 1] + red_s[(w | 1) * 2 + 1]) * (1.0f / 128.0f);
        const float y = dv * (1.0f / sqrtf(var + 1e-5f)) * a->in[I_RETN][l * 512 + hh * 128 + e] * fsilu(bf2f(pr[C_GR + hh * 128 + e]));
        OB2[(size_t)row * OBS + hh * 128 + e] = f2bf(y);
    }
    __syncthreads();
}

#define GAS __attribute__((address_space(1)))
#define XB_TMO      128
#define XB_XCNT(j)  (256  + 64 * (j))
#define XB_XSUB(j)  (1280 + 64 * (j))
#define XB_XGEN(j)  (2304 + 64 * (j))
#define XB_TOP      3328
#define XB_TOPGEN   3392
#define XCD_BAR_WORDS 3456
#define XB_SPIN_CAP (1u << 18)

__device__ __forceinline__ unsigned xb_ld(unsigned* p)              { return __hip_atomic_load(p, __ATOMIC_RELAXED, __HIP_MEMORY_SCOPE_AGENT); }
__device__ __forceinline__ unsigned xb_add(unsigned* p, unsigned v) { return __hip_atomic_fetch_add(p, v, __ATOMIC_RELAXED, __HIP_MEMORY_SCOPE_AGENT); }
__device__ __forceinline__ unsigned xb_xcc_id() { return (unsigned)__builtin_amdgcn_s_getreg((3 << 11) | 20) & 0xFu; }
#define XB_SPIN(cond, bar) do { unsigned _sp = 0; while (cond) { __builtin_amdgcn_s_sleep(1); \
    if ((++_sp & 255u) == 0u) { if (xb_ld(&(bar)[XB_TMO])) break; if (_sp > XB_SPIN_CAP) { atomicAdd(&(bar)[XB_TMO], 1u); break; } } } } while (0)

struct XcdBarrier {
    unsigned* bar; unsigned x;
    volatile LAS unsigned* st;
};

__device__ __forceinline__ XcdBarrier xcd_barrier_post(unsigned* bar, volatile LAS unsigned* st) {
    XcdBarrier b; b.bar = bar; b.x = xb_xcc_id(); b.st = st;
    if (threadIdx.x == 0) (void)xb_add(&bar[XB_XCNT(b.x)], 1u);
    return b;
}
__device__ __forceinline__ void xcd_barrier_complete(unsigned* bar, unsigned x, unsigned& nloc, unsigned& nx) {
    const unsigned G = gridDim.x * gridDim.y * gridDim.z;
    unsigned sum, cnt, mine, sp = 0u;
    for (;;) {
        sum = 0u; cnt = 0u; mine = 0u;
#pragma unroll
        for (unsigned j = 0; j < 16; ++j) { const unsigned c = xb_ld(&bar[XB_XCNT(j)]); sum += c; cnt += (c > 0u) ? 1u : 0u; mine = (j == x) ? c : mine; }
        if (sum == G) break;
        __builtin_amdgcn_s_sleep(1);
        if ((++sp & 255u) == 0u) { if (xb_ld(&bar[XB_TMO])) break; if (sp > XB_SPIN_CAP) { atomicAdd(&bar[XB_TMO], 1u); break; } }
    }
    nloc = mine > 0u ? mine : 1u; nx = cnt > 0u ? cnt : 1u;
}

__device__ __forceinline__ void xcd_barrier(const XcdBarrier& b) {
    asm volatile("s_waitcnt vmcnt(0)" ::: "memory");
    __syncthreads();
    if (threadIdx.x == 0) {
        unsigned* bar = b.bar;
        __builtin_amdgcn_s_waitcnt(0);
        unsigned nloc = b.st[0], nx = b.st[1];
        if (nloc == 0u) { xcd_barrier_complete(bar, b.x, nloc, nx); b.st[0] = nloc; b.st[1] = nx; }
        const unsigned old = xb_add(&bar[XB_XSUB(b.x)], 1u);
        const unsigned gen = old / nloc;
        if (old + 1u == (gen + 1u) * nloc) {
            __builtin_amdgcn_fence(__ATOMIC_RELEASE, "agent");
            asm volatile("s_waitcnt vmcnt(0)" ::: "memory");
            const unsigned og = xb_add(&bar[XB_TOP], 1u);
            const unsigned tg = og / nx;
            if (og + 1u == (tg + 1u) * nx) xb_add(&bar[XB_TOPGEN], 1u);
            else XB_SPIN(xb_ld(&bar[XB_TOPGEN]) == tg, bar);
            __builtin_amdgcn_fence(__ATOMIC_ACQUIRE, "agent");
            xb_add(&bar[XB_XGEN(b.x)], 1u);
            asm volatile("s_waitcnt vmcnt(0)" ::: "memory");
        } else {
            XB_SPIN(xb_ld(&bar[XB_XGEN(b.x)]) == gen, bar);
            __builtin_amdgcn_fence(__ATOMIC_ACQUIRE, "agent");
            asm volatile("s_waitcnt vmcnt(0)" ::: "memory");
        }
    }
    __syncthreads();
}


template <class Sched> __device__ __forceinline__ void rs_prestep(const Sched& S, const float* ss, float* rs) {
    const int tid = tid_opaque();
    int pmv[8];
#pragma unroll
    for (int i = 0; i < 8; ++i) { pg8::Unit u; pmv[i] = S.next(i, u) ? u.pm : -1; }
    const int r0 = (tid < 256) ? tid : TROW0 + (tid - 256);
    float v[9];
#pragma unroll
    for (int i = 0; i < 8; ++i) { v[i] = 0.f; if (tid < 256 && pmv[i] >= 0) v[i] = pg8::row_ss(ss, pmv[i] * 256 + tid); }
    v[8] = 0.f; if (tid >= 256) v[8] = pg8::row_ss(ss, r0);
    float v9 = 0.f; if (tid < 128) v9 = pg8::row_ss(ss, TROW0 + 256 + tid);
#pragma unroll
    for (int i = 0; i < 8; ++i) if (tid < 256 && pmv[i] >= 0) rs[pmv[i] * 256 + tid] = __builtin_amdgcn_rsqf(v[i] * (1.0f / 1024.0f) + 1e-6f);
    if (tid >= 256) rs[r0] = __builtin_amdgcn_rsqf(v[8] * (1.0f / 1024.0f) + 1e-6f);
    if (tid < 128) rs[TROW0 + 256 + tid] = __builtin_amdgcn_rsqf(v9 * (1.0f / 1024.0f) + 1e-6f);
    asm volatile("s_waitcnt vmcnt(0)" ::: "memory");
    __syncthreads();
}

#define R_GU 1
#define R_WIN 1
#define R_MIX1 1
#define R_CARRY 1
#define R_MIX2 1
#define R_XSYNC 0
__global__ void __launch_bounds__(NTHR, 2) mk_fwd(Args a_unused) {
    extern __shared__ __attribute__((aligned(16))) unsigned char lds_raw[];
    LAS unsigned char* lds = (LAS unsigned char*)lds_raw;
    cg::grid_group grid = cg::this_grid();
    CArgs* kp0 = (CArgs*)__builtin_amdgcn_kernarg_segment_ptr();
    if (threadIdx.x < 64) ((LAS unsigned*)(lds + 131072))[threadIdx.x] = 0u;
    __syncthreads();
    XcdBarrier xbar; xbar.bar = (unsigned*)(kp0->ws + WS_BAR); xbar.x = 0; xbar.st = (volatile LAS unsigned*)(lds + 131072);
    const int lo = kp0->ph_lo, hi = kp0->ph_hi; int ph = 0;
#define PH_PTRS int tid = threadIdx.x; asm volatile("" : "+v"(tid)); const int lane = tid & 63, wave = __builtin_amdgcn_readfirstlane(tid >> 6); \
    int bid_ = blockIdx.x; asm volatile("" : "+s"(bid_)); const int G = gridDim.x, bid = bid_, gw = bid * 8 + wave, ngw = G * 8; (void)lane; (void)gw; (void)ngw; CArgs* a = kp0; asm volatile("" : "+s"(a)); unsigned char* ws = a->ws; \
    float* SS = (float*)(ws + WS_SS16); float* LSUM = (float*)(ws + WS_LSUM); float* LCAR = (float*)(ws + WS_LCAR); \
    float* X = (float*)(ws + WS_X); bf16_t* XB = (bf16_t*)(ws + WS_XB); bf16_t* PA = (bf16_t*)(ws + WS_PA); bf16_t* HB = PA; bf16_t* MB = (bf16_t*)(ws + WS_PA); \
    bf16_t* GT = (bf16_t*)(ws + WS_GT); bf16_t* OB = (bf16_t*)(ws + WS_OB); float* U = (float*)(ws + WS_U); float* AG = (float*)(ws + WS_XB); float* BG = (float*)(ws + WS_BG); (void)AG; (void)BG; bf16_t* ST = (bf16_t*)(ws + WS_ST); \
    unsigned char* wb = ws + WS_W0 + (size_t)(l & 1) * WSZ; \
    float* RS = (float*)(ws + WS_RS); const float* rs0 = RS + (size_t)(3 * l) * MP; float* rs1 = RS + (size_t)(3 * l + 1) * MP; float* rs2 = RS + (size_t)(3 * l + 2) * MP; float* rs3 = RS + (size_t)(3 * l + 3) * MP; (void)rs0; (void)rs1; (void)rs2; (void)rs3; \
    const float* ss0 = SS + (size_t)(3 * l) * MP * 16; float* ss1 = SS + (size_t)(3 * l + 1) * MP * 16; float* ss2 = SS + (size_t)(3 * l + 2) * MP * 16; float* ss3 = SS + (size_t)(3 * l + 3) * MP * 16; \
    (void)SS; (void)LSUM; (void)LCAR; (void)X; (void)XB; (void)PA; (void)HB; (void)MB; (void)GT; (void)OB; (void)U; (void)ST; (void)wb; (void)ss0; (void)ss1; (void)ss2; (void)ss3;
#define PH_BEGIN(n) if (ph >= lo && ph < hi) { PH_PTRS for (int rep_ = 0; rep_ < (n); ++rep_) {
#define PH_END if (ph + 1 < hi) { if (ph == 0) { asm volatile("s_waitcnt vmcnt(0)" ::: "memory"); grid.sync(); xbar = xcd_barrier_post((unsigned*)(kp0->ws + WS_BAR), (volatile LAS unsigned*)(lds + 131072)); } else xcd_barrier(xbar); } } } ++ph;

    { const int l = 0;
    PH_BEGIN(1)
        if (bid == 0) { for (int i = tid; i < XCD_BAR_WORDS; i += NTHR) ((unsigned*)(ws + WS_BAR))[i] = 0u; }
        init_rows(a, X, XB, SS, RS, OB, gw, ngw, lane);
        convert_layer(a, 0, ws + WS_W0, lds, gw, ngw, wave, lane);
    PH_END
    }

#pragma unroll 1
    for (int l = 0; l < DEPTH; ++l) {
        PH_BEGIN(R_GU)
            pg8::Gemm g{XB, (const bf16_t*)(wb + W_GU1), TROW0, 4096, DM, 1, 0}; pg8::StaticOrder S; S.init(TROW0, 4096, G, bid);
            rs_prestep(S, ss0, RS + (size_t)(3 * l) * MP);
            pg8::EpiSwiGLU E{HB, rs0}; pg8::gemm_phase<pg8::EpiSwiGLU, pg8::StaticOrder, true, true>(lds, g, S, E);
            { const TailArgs ta{XB, (const bf16_t*)(wb + W_GU1), DM, 4096, HB, nullptr, nullptr, rs0, nullptr, nullptr, 0.f}; tail_gemm<TM_SWIGLU>(ta, bid, G, lds); }
        PH_END
        PH_BEGIN(1)
            pg8::Gemm g{HB, (const bf16_t*)(wb + W_D1), TROW0, DM, FF, 1, 0}; pg8::StaticOrder S; S.init(TROW0, DM, G, bid);
            pg8::EpiResid E{X, XB, ss1, 0.5f}; pg8::gemm_phase<pg8::EpiResid, pg8::StaticOrder, true, true>(lds, g, S, E);
            { const TailArgs ta{HB, (const bf16_t*)(wb + W_D1), FF, DM, XB, nullptr, X, nullptr, ss1, nullptr, 0.5f}; tail_gemm<TM_RESID>(ta, bid, G, lds); }
        PH_END
        PH_BEGIN(R_WIN)
            pg8::Gemm g{XB, (const bf16_t*)(wb + W_IN), TROW0, NIN, DM, 1, 0}; pg8::StaticOrder S; S.init(TROW0, NIN, G, bid);
            rs_prestep(S, ss1, rs1);
            pg8::EpiProj E{PA, GT, rs1}; pg8::gemm_phase<pg8::EpiProj, pg8::StaticOrder, true, true>(lds, g, S, E);
            { const TailArgs ta{XB, (const bf16_t*)(wb + W_IN), DM, NIN, PA, GT, nullptr, rs1, nullptr, nullptr, 0.f}; if (G == 256) { if (bid >= 64) tail_gemm<TM_PROJ>(ta, bid - 64, 192, lds); } else tail_gemm<TM_PROJ>(ta, bid, G, lds); }
        PH_END
        PH_BEGIN(R_MIX1)
            for (int it = bid; it < 1048 + 520 + 260; it += G) {
                if (it < 1048) lru1_item(a, l, it >> 3, it & 7, PA, OB, LSUM, AG, BG, lds);
                else if (it < 1048 + 520) ret_u_item(it - 1048, PA, U, lds);
                else swa_item(a, l, it - (1048 + 520), PA, OB + 512, lds);
            }
        PH_END
        PH_BEGIN(R_CARRY)
            for (int it = bid; it < 130; it += G) carry_item(a, l, it, LSUM, LCAR, U, ST);
            if (G == 256) { if (bid >= 128) sample_item(a, l, bid - 128, PA, OB + 512, OB + 1024, lds); } else { for (int it = bid; it < 128; it += G) sample_item(a, l, it, PA, OB + 512, OB + 1024, lds); }
            if (l + 1 < DEPTH) {
                __syncthreads();
                const int nsh = (G == 256) ? (bid < 128 ? 3 : 1) : 1, sh0 = (G == 256) ? (bid < 128 ? bid * 3 : 384 + (bid - 128)) : bid, nshares = (G == 256) ? 512 : G;
#pragma unroll 1
                for (int v = 0; v < nsh; ++v) convert_layer(a, l + 1, ws + WS_W0 + (size_t)((l + 1) & 1) * WSZ, lds, (sh0 + v) * 8 + wave, nshares * 8, wave, lane);
            }
        PH_END
        PH_BEGIN(R_MIX2)
            for (int it = bid; it < 520 + 1040; it += G) {
                if (it < 520) ret_out_item(a, l, it, PA, ST, OB + 1024, lds);
                else { const int q = it - 520; lru2_item(q >> 3, q & 7, PA, OB, LCAR, AG, BG, lds); }
            }
        PH_END
        PH_BEGIN(1)
            pg8::Gemm g{OB, (const bf16_t*)(wb + W_BR), TROW0, DM, OBS, 1, 0}; pg8::StaticOrder S; S.init(TROW0, DM, G, bid);
            pg8::EpiBranch E{MB, GT}; pg8::gemm_phase<pg8::EpiBranch, pg8::StaticOrder, true, true>(lds, g, S, E);
            { const TailArgs ta{OB, (const bf16_t*)(wb + W_BR), OBS, DM, MB, nullptr, nullptr, nullptr, nullptr, GT, 0.f}; tail_gemm<TM_BRANCH>(ta, bid, G, lds); }
        PH_END
        PH_BEGIN(1)
            pg8::Gemm g{MB, (const bf16_t*)(wb + W_OUT), TROW0, DM, DM, 1, 0}; pg8::StaticOrder S; S.init(TROW0, DM, G, bid);
            pg8::EpiResid E{X, XB, ss2, 1.0f}; pg8::gemm_phase<pg8::EpiResid, pg8::StaticOrder, true, true>(lds, g, S, E);
            { const TailArgs ta{MB, (const bf16_t*)(wb + W_OUT), DM, DM, XB, nullptr, X, nullptr, ss2, nullptr, 1.0f}; tail_gemm<TM_RESID>(ta, bid, G, lds); }
        PH_END
        PH_BEGIN(1)
            for (int xs_ = 0; xs_ < R_XSYNC; ++xs_) grid.sync();
            pg8::Gemm g{XB, (const bf16_t*)(wb + W_GU2), TROW0, 4096, DM, 1, 0}; pg8::StaticOrder S; S.init(TROW0, 4096, G, bid);
            rs_prestep(S, ss2, rs2);
            pg8::EpiSwiGLU E{HB, rs2}; pg8::gemm_phase<pg8::EpiSwiGLU, pg8::StaticOrder, true, true>(lds, g, S, E);
            { const TailArgs ta{XB, (const bf16_t*)(wb + W_GU2), DM, 4096, HB, nullptr, nullptr, rs2, nullptr, nullptr, 0.f}; tail_gemm<TM_SWIGLU>(ta, bid, G, lds); }
        PH_END
        PH_BEGIN(1)
            pg8::Gemm g{HB, (const bf16_t*)(wb + W_D2), TROW0, DM, FF, 1, 0}; pg8::StaticOrder S; S.init(TROW0, DM, G, bid);
            pg8::EpiResid E{X, XB, ss3, 0.5f}; pg8::gemm_phase<pg8::EpiResid, pg8::StaticOrder, true, true>(lds, g, S, E);
            { const TailArgs ta{HB, (const bf16_t*)(wb + W_D2), FF, DM, XB, nullptr, X, nullptr, ss3, nullptr, 0.5f}; tail_gemm<TM_RESID>(ta, bid, G, lds); }
        PH_END
    }
    { const int l = 0;
    PH_BEGIN(1)
        const float* ssf = SS + (size_t)12 * MP * 16; const float* gf = a->in[I_FINN];
        for (int r = gw; r < MREAL; r += ngw) {
            float* dst = nullptr;
            if (r < 2 * BROWS) { const int b = r / BROWS, pr = r % BROWS; if (pr >= PADR + 16) dst = a->out + O_YP + ((size_t)b * 8192 + (pr - PADR - 16)) * DM; }
            else dst = a->out + O_YS + (size_t)(r - SROW0) * DM;
            if (dst) {
                const float rs = __builtin_amdgcn_rsqf(pg8::row_ss(ssf, r) * (1.0f / 1024.0f) + 1e-6f);
#pragma unroll
                for (int j = 0; j < 4; ++j) { const f32x4 v = *((const f32x4*)(X + (size_t)r * DM) + lane + 64 * j); const f32x4 gg = *((const f32x4*)gf + lane + 64 * j); *((f32x4*)dst + lane + 64 * j) = v * rs * gg; }
            }
        }
    PH_END
    }
#undef PH_BEGIN
#undef PH_END
}
constexpr int NPHASES = 2 + 10 * DEPTH;

#ifndef MK_MULTI
#define MK_MULTI 0
#endif
extern "C" void kernel_launch(void* const* d_in, const int* in_sizes, int n_in, void* d_out, int out_size, void* d_ws, size_t ws_size, hipStream_t stream) {
    static int grid = 0;
    if (grid == 0) {
        if (n_in != 30 || ws_size < WS_END) { fprintf(stderr, "kernel_launch: unexpected inputs (n_in %d, ws %zu < %zu)\n", n_in, ws_size, (size_t)WS_END); grid = -1; return; }
        int dev = 0, cus = 0, per_cu = 0;
        (void)hipGetDevice(&dev); (void)hipDeviceGetAttribute(&cus, hipDeviceAttributeMultiprocessorCount, dev);
        if (hipFuncSetAttribute((const void*)mk_fwd, hipFuncAttributeMaxDynamicSharedMemorySize, LDS_BYTES) != hipSuccess) { fprintf(stderr, "kernel_launch: hipFuncSetAttribute failed\n"); grid = -1; return; }
        if (hipOccupancyMaxActiveBlocksPerMultiprocessor(&per_cu, (const void*)mk_fwd, NTHR, LDS_BYTES) != hipSuccess || per_cu < 1) { fprintf(stderr, "kernel_launch: occupancy query says %d\n", per_cu); per_cu = 1; }
        (void)hipGetLastError();
        grid = cus * 1;
        if (grid <= 0) grid = 256;
    }
    if (grid < 0) return;
    Args a{};
    for (int i = 0; i < 30; ++i) a.in[i] = (const float*)d_in[i];
    a.out = (float*)d_out; a.ws = (unsigned char*)d_ws;
#if MK_MULTI
    for (int p = 0; p < NPHASES; ++p) { a.ph_lo = p; a.ph_hi = p + 1; hipLaunchKernelGGL(mk_fwd, dim3(grid), dim3(NTHR), LDS_BYTES, stream, a); }
#else
    a.ph_lo = 0; a.ph_hi = NPHASES;
    void* args[] = {&a};
    hipError_t e = hipLaunchCooperativeKernel((const void*)mk_fwd, dim3(grid), dim3(NTHR), args, LDS_BYTES, stream);
    if (e != hipSuccess) fprintf(stderr, "cooperative launch failed: %s (grid %d)\n", hipGetErrorString(e), grid);
#endif
}
```

```cpp
#include <hip/hip_runtime.h>
#include <hip/hip_cooperative_groups.h>
#include <cstdio>
#include <cstdint>
#include <cmath>
namespace cg = cooperative_groups;

namespace pg8 {
#define PG8_LAS __attribute__((address_space(3)))
typedef unsigned short bf16_t;
typedef short bf16x8 __attribute__((ext_vector_type(8)));
typedef float f32x4 __attribute__((ext_vector_type(4)));
typedef unsigned u32x4 __attribute__((ext_vector_type(4)));
constexpr int BM = 256, BK = 64, HALF = 128, HTB = HALF * BK * 2  , STAGE_BYTES = 8 * HTB, NXCD = 8, WGM = 8;

__host__ __device__ __forceinline__ int lds_byte(int r, int c) { const int st = (r >> 4) * 2 + (c >> 5), rr = r & 15, cc = c & 31, ob = rr * 64 + cc * 2; return st * 1024 + (ob ^ (((ob >> 9) & 1) << 5)); }
__host__ __device__ __forceinline__ void stage_rc(int b, int& R, int& C) { const int st = b / 1024, sb = b % 1024, swz = sb ^ (((sb >> 9) & 1) << 5); R = (st >> 1) * 16 + swz / 64; C = (st & 1) * 32 + (swz % 64) / 2; }
__host__ __device__ __forceinline__ int perm32(int rho) { const int n = rho >> 4, i = rho & 15; return 8 * (i >> 2) + 4 * n + (i & 3); }

struct Unit { int pm, pn; };
struct Gemm { const bf16_t* A; const bf16_t* Bt; int M, N, K; int agdiv; size_t agstride; };

struct StaticOrder {
    int nM, nN, nwg, G, c;
    __host__ __device__ void init(int M, int N, int G_, int c_) { nM = M / BM; nN = N / BM; nwg = nM * nN; G = G_; c = c_; }
    __host__ __device__ bool next(int i, Unit& u) const {
        const long L = (long)i * G + c; if (L >= nwg) return false;
        int wgid = (int)L; { const int q = nwg / NXCD, r = nwg % NXCD, xcd = wgid % NXCD, off = wgid / NXCD; wgid = (xcd < r ? xcd * (q + 1) : r * (q + 1) + (xcd - r) * q) + off; }
        const int nig = WGM * nN, gid = wgid / nig, fm = gid * WGM, gsz = (nM - fm) < WGM ? (nM - fm) : WGM;
        u.pm = fm + ((wgid % nig) % gsz); u.pn = (wgid % nig) / gsz; return true;
    }
    __device__ __forceinline__ void a_ready(const Unit&) const {}
    __device__ __forceinline__ void done(const Unit&) const {}
};

__device__ __forceinline__ unsigned cvt_pk_bf16(float lo, float hi) { unsigned r; asm volatile("v_cvt_pk_bf16_f32 %0, %1, %2" : "=v"(r) : "v"(lo), "v"(hi)); return r; }
typedef unsigned u32x2 __attribute__((ext_vector_type(2)));
__device__ __forceinline__ float fsigmoid(float x) { return __builtin_amdgcn_rcpf(1.0f + __expf(-x)); }
__device__ __forceinline__ float fsilu(float x) { return x * fsigmoid(x); }
__device__ __forceinline__ float bflo(unsigned w) { return __uint_as_float(w << 16); }
__device__ __forceinline__ float bfhi(unsigned w) { return __uint_as_float(w & 0xffff0000u); }

__device__ __forceinline__ float row_ss(const float* ss, int row) {
    const f32x4* p = (const f32x4*)(ss + (size_t)row * 16); const f32x4 a = p[0], b = p[1], c = p[2], d = p[3];
    return (((a[0] + a[1]) + (a[2] + a[3])) + ((b[0] + b[1]) + (b[2] + b[3]))) + (((c[0] + c[1]) + (c[2] + c[3])) + ((d[0] + d[1]) + (d[2] + d[3])));
}
struct EpiSwiGLU {
    static constexpr bool PERM = true, AFTER_DRAIN = false, HAS_MID = false, HAS_PRE = true;
    bf16_t* H; const float* ss;
    __device__ __forceinline__ void pre(float (&rsv)[8], const Unit& u, int wr, int fr) const {
#pragma unroll
        for (int q = 0; q < 8; ++q) rsv[q] = ss[u.pm * BM + wr * 64 + fr + (q >> 2) * HALF + (q & 3) * 16];
    }
    __device__ __forceinline__ void operator()(const f32x4 (&acc)[2][2][4][2], const Unit& u, int wr, int wc, int fr, int fq, const float (&rsv)[8]) const {
        const int row0 = u.pm * BM + wr * 64 + fr, col0 = u.pn * 128 + wc * 32 + 8 * fq;
#pragma unroll
        for (int ai = 0; ai < 2; ++ai)
#pragma unroll
            for (int m = 0; m < 4; ++m) {
                const int row = row0 + ai * HALF + m * 16;
                const float rs = rsv[ai * 4 + m];
                const f32x4 g0 = acc[ai][0][m][0] * rs, g1 = acc[ai][0][m][1] * rs, u0 = acc[ai][1][m][0] * rs, u1 = acc[ai][1][m][1] * rs;
                u32x4 w;
                w.x = cvt_pk_bf16(fsilu(g0[0]) * u0[0], fsilu(g0[1]) * u0[1]); w.y = cvt_pk_bf16(fsilu(g0[2]) * u0[2], fsilu(g0[3]) * u0[3]);
                w.z = cvt_pk_bf16(fsilu(g1[0]) * u1[0], fsilu(g1[1]) * u1[1]); w.w = cvt_pk_bf16(fsilu(g1[2]) * u1[2], fsilu(g1[3]) * u1[3]);
                *(u32x4*)(H + (size_t)row * 2048 + col0) = w;
            }
    }
};
struct EpiResid {
    static constexpr bool PERM = false, AFTER_DRAIN = false, HAS_MID = false, HAS_PRE = false;
    float* X; bf16_t* XB; float* ssn; float scale;
    __device__ __forceinline__ void operator()(const f32x4 (&acc)[2][2][4][2], const Unit& u, int wr, int wc, int fr, int fq, const float (&)[8]) const {
        const int row0 = u.pm * BM + wr * 64 + fr, col0 = u.pn * BM + wc * 32 + 4 * fq;
#pragma unroll
        for (int ai = 0; ai < 2; ++ai)
#pragma unroll
            for (int m = 0; m < 4; ++m) {
                const int row = row0 + ai * HALF + m * 16; float sq = 0.f;
#pragma unroll
                for (int bj = 0; bj < 2; ++bj)
#pragma unroll
                    for (int n = 0; n < 2; ++n) {
                        const size_t off = (size_t)row * 1024 + col0 + bj * HALF + n * 16;
                        f32x4 x = *(const f32x4*)(X + off); x = x + acc[ai][bj][m][n] * scale; *(f32x4*)(X + off) = x;
                        u32x2 w; w.x = cvt_pk_bf16(x[0], x[1]); w.y = cvt_pk_bf16(x[2], x[3]); *(u32x2*)(XB + off) = w;
                        sq += (x[0] * x[0] + x[1] * x[1]) + (x[2] * x[2] + x[3] * x[3]);
                    }
                sq += __shfl_xor(sq, 16); sq += __shfl_xor(sq, 32);
                if (fq == 0) ssn[(size_t)row * 16 + u.pn * 4 + wc] = sq;
            }
    }
};
struct EpiProj {
    static constexpr bool PERM = true, AFTER_DRAIN = false, HAS_MID = false, HAS_PRE = true;
    bf16_t* PA; bf16_t* GT; const float* ss;
    __device__ __forceinline__ void pre(float (&rsv)[8], const Unit& u, int wr, int fr) const {
#pragma unroll
        for (int q = 0; q < 8; ++q) rsv[q] = ss[u.pm * BM + wr * 64 + fr + (q >> 2) * HALF + (q & 3) * 16];
    }
    __device__ __forceinline__ void operator()(const f32x4 (&acc)[2][2][4][2], const Unit& u, int wr, int wc, int fr, int fq, const float (&rsv)[8]) const {
        const int row0 = u.pm * BM + wr * 64 + fr; const bool gate = u.pn >= 13;
        const int col0 = (gate ? (u.pn - 13) : u.pn) * BM + wc * 32 + 8 * fq;
        bf16_t* base = gate ? GT : PA; const int ld = gate ? 3072 : 3328;
#pragma unroll
        for (int ai = 0; ai < 2; ++ai)
#pragma unroll
            for (int m = 0; m < 4; ++m) {
                const int row = row0 + ai * HALF + m * 16;
                const float rs = rsv[ai * 4 + m];
#pragma unroll
                for (int bj = 0; bj < 2; ++bj) {
                    f32x4 v0 = acc[ai][bj][m][0] * rs, v1 = acc[ai][bj][m][1] * rs;
                    if (gate) {
#pragma unroll
                        for (int k = 0; k < 4; ++k) { v0[k] = fsigmoid(v0[k]); v1[k] = fsigmoid(v1[k]); }
                    }
                    u32x4 w; w.x = cvt_pk_bf16(v0[0], v0[1]); w.y = cvt_pk_bf16(v0[2], v0[3]); w.z = cvt_pk_bf16(v1[0], v1[1]); w.w = cvt_pk_bf16(v1[2], v1[3]);
                    *(u32x4*)(base + (size_t)row * ld + col0 + bj * HALF) = w;
                }
            }
    }
};
struct EpiBranch {
    static constexpr bool PERM = true, AFTER_DRAIN = false, HAS_MID = true, HAS_PRE = false;
    bf16_t* MB; const bf16_t* GT;
    __device__ __forceinline__ void mid(f32x4 (&acc)[2][2][4][2], const Unit& u, int seg, int wr, int wc, int fr, int fq) const {
        int fr_ = fr; asm volatile("" : "+v"(fr_));
        const int row0 = u.pm * BM + wr * 64 + fr_, col0 = u.pn * BM + wc * 32 + 8 * fq;
#pragma unroll
        for (int ai = 0; ai < 2; ++ai)
#pragma unroll
            for (int m = 0; m < 4; ++m) {
                const int row = row0 + ai * HALF + m * 16;
#pragma unroll
                for (int bj = 0; bj < 2; ++bj) {
                    const bf16_t* gp = GT + (size_t)row * 3072 + (seg - 1) * 1024 + col0 + bj * HALF;
                    const u32x4 g0 = *(const u32x4*)gp, g1 = *(const u32x4*)(gp + 1024);
                    f32x4 r0, r1;
                    r0[0] = bflo(g0.x) * __builtin_amdgcn_rcpf(fmaxf(bflo(g1.x), 1e-30f)); r0[1] = bfhi(g0.x) * __builtin_amdgcn_rcpf(fmaxf(bfhi(g1.x), 1e-30f));
                    r0[2] = bflo(g0.y) * __builtin_amdgcn_rcpf(fmaxf(bflo(g1.y), 1e-30f)); r0[3] = bfhi(g0.y) * __builtin_amdgcn_rcpf(fmaxf(bfhi(g1.y), 1e-30f));
                    r1[0] = bflo(g0.z) * __builtin_amdgcn_rcpf(fmaxf(bflo(g1.z), 1e-30f)); r1[1] = bfhi(g0.z) * __builtin_amdgcn_rcpf(fmaxf(bfhi(g1.z), 1e-30f));
                    r1[2] = bflo(g0.w) * __builtin_amdgcn_rcpf(fmaxf(bflo(g1.w), 1e-30f)); r1[3] = bfhi(g0.w) * __builtin_amdgcn_rcpf(fmaxf(bfhi(g1.w), 1e-30f));
                    acc[ai][bj][m][0] = acc[ai][bj][m][0] * r0; acc[ai][bj][m][1] = acc[ai][bj][m][1] * r1;
                }
                if (m == 3) asm volatile("" ::: "memory");
            }
    }
    __device__ __forceinline__ void operator()(const f32x4 (&acc)[2][2][4][2], const Unit& u, int wr, int wc, int fr, int fq, const float (&)[8]) const {
        const int row0 = u.pm * BM + wr * 64 + fr, col0 = u.pn * BM + wc * 32 + 8 * fq;
#pragma unroll
        for (int ai = 0; ai < 2; ++ai)
#pragma unroll
            for (int m = 0; m < 4; ++m) {
                const int row = row0 + ai * HALF + m * 16;
#pragma unroll
                for (int bj = 0; bj < 2; ++bj) {
                    const u32x4 gt = *(const u32x4*)(GT + (size_t)row * 3072 + 2048 + col0 + bj * HALF);
                    const f32x4 v0 = acc[ai][bj][m][0], v1 = acc[ai][bj][m][1];
                    u32x4 w;
                    w.x = cvt_pk_bf16(v0[0] * bflo(gt.x), v0[1] * bfhi(gt.x)); w.y = cvt_pk_bf16(v0[2] * bflo(gt.y), v0[3] * bfhi(gt.y));
                    w.z = cvt_pk_bf16(v1[0] * bflo(gt.z), v1[1] * bfhi(gt.z)); w.w = cvt_pk_bf16(v1[2] * bflo(gt.w), v1[3] * bfhi(gt.w));
                    *(u32x4*)(MB + (size_t)row * 1024 + col0 + bj * HALF) = w;
                }
            }
    }
};


template <class Epi, class Sched, bool ALIGN_EPI = false, bool SP2 = false>
__device__ __forceinline__ void gemm_phase(PG8_LAS unsigned char* lds, const Gemm g, const Sched& S, const Epi& E) {
    int tid_ = threadIdx.x; asm volatile("" : "+v"(tid_));
    const int tid = tid_, wid = __builtin_amdgcn_readfirstlane(tid >> 6), lane = tid & 63, wr = wid >> 2, wc = wid & 3, fr = lane & 15, fq = lane >> 4;
    const int K = g.K, nt = K / BK;
    unsigned voffA[2], voffB[2];
#pragma unroll
    for (int i = 0; i < 2; ++i) { int R, C; stage_rc(tid * 16 + i * 8192, R, C); const int Rb = Epi::PERM ? ((R & ~31) + perm32(R & 31)) : R;
        voffA[i] = (unsigned)(R * K + C) * 2u; voffB[i] = (unsigned)(Rb * K + C) * 2u; }
    const size_t kstep = (size_t)(BK * 2);
    const size_t hstep = (size_t)HALF * K * 2;
    const size_t tstep = 2 * hstep;
    const unsigned ldsw = (unsigned)wid * 1024u;
    const int aoff = lds_byte(wr * 64 + fr, fq * 8), boff = lds_byte(wc * 32 + fr, fq * 8);
#define PG8_SA(b, h) (((b) * 2 + (h)) * HTB)
#define PG8_SB(b, h) ((4 + (b) * 2 + (h)) * HTB)
#define PG8_STAGE(bufoff, gbase, voff) do { _Pragma("unroll") for (int _i = 0; _i < 2; ++_i) \
        __builtin_amdgcn_global_load_lds((const unsigned*)((const char*)(gbase) + (voff)[_i]), (PG8_LAS unsigned*)(lds + (bufoff) + ldsw + _i * 8192), 16, 0, 0); } while (0)
#define PG8_LDA(dst, b, h) do { _Pragma("unroll") for (int m = 0; m < 4; ++m) _Pragma("unroll") for (int k = 0; k < 2; ++k) dst[m][k] = *(const PG8_LAS bf16x8*)(lds + PG8_SA(b, h) + aoff + m * 2048 + k * 1024); } while (0)
#define PG8_LDB(dst, b, h) do { _Pragma("unroll") for (int n = 0; n < 2; ++n) _Pragma("unroll") for (int k = 0; k < 2; ++k) dst[n][k] = *(const PG8_LAS bf16x8*)(lds + PG8_SB(b, h) + boff + n * 2048 + k * 1024); } while (0)
#define PG8_MMA(ai, bj, At, Bt) do { __builtin_amdgcn_s_setprio(1); _Pragma("unroll") for (int m = 0; m < 4; ++m) _Pragma("unroll") for (int n = 0; n < 2; ++n) _Pragma("unroll") for (int k = 0; k < 2; ++k) \
        acc[ai][bj][m][n] = __builtin_amdgcn_mfma_f32_16x16x32_bf16(Bt[n][k], At[m][k], acc[ai][bj][m][n], 0, 0, 0); __builtin_amdgcn_s_setprio(0); } while (0)
#define PG8_WAIT_V(n) asm volatile("s_waitcnt vmcnt(" #n ")" ::: "memory")
#define PG8_WAIT_L(n) asm volatile("s_waitcnt lgkmcnt(" #n ")" ::: "memory")
#define PG8_BAR __builtin_amdgcn_s_barrier()
#define PG8_SCHED __builtin_amdgcn_sched_barrier(0)
    Unit cur, nxt; int ui = 0;
    if (!S.next(0, cur)) return;
    float rsv[8] = {0.f, 0.f, 0.f, 0.f, 0.f, 0.f, 0.f, 0.f};
    f32x4 acc[2][2][4][2];
#pragma unroll
    for (int a = 0; a < 2; ++a)
#pragma unroll
        for (int b = 0; b < 2; ++b)
#pragma unroll
            for (int m = 0; m < 4; ++m)
#pragma unroll
                for (int n = 0; n < 2; ++n) acc[a][b][m][n] = (f32x4){0.f, 0.f, 0.f, 0.f};
    bf16x8 At[4][2], B0[2][2], B1[2][2];
    const char* cA = (const char*)g.A + (size_t)cur.pm * tstep + (size_t)(cur.pn / g.agdiv) * g.agstride; const char* cB = (const char*)g.Bt + (size_t)cur.pn * tstep;
    S.a_ready(cur);
    if constexpr (SP2) {
        PG8_STAGE(PG8_SB(0, 0), cB, voffB); PG8_STAGE(PG8_SB(0, 1), cB + hstep, voffB); PG8_STAGE(PG8_SA(0, 0), cA, voffA); PG8_STAGE(PG8_SA(0, 1), cA + hstep, voffA);
        if (wr == 1) PG8_BAR;
        PG8_WAIT_V(2); PG8_BAR;
        PG8_STAGE(PG8_SB(1, 0), cB + kstep, voffB); PG8_STAGE(PG8_SA(1, 0), cA + kstep, voffA); PG8_STAGE(PG8_SB(1, 1), cB + hstep + kstep, voffB);
        PG8_WAIT_V(6); PG8_BAR;
    } else {
        PG8_STAGE(PG8_SB(0, 0), cB, voffB); PG8_STAGE(PG8_SA(0, 0), cA, voffA); PG8_STAGE(PG8_SB(0, 1), cB + hstep, voffB); PG8_STAGE(PG8_SA(0, 1), cA + hstep, voffA);
        if (wr == 1) PG8_BAR;
        PG8_WAIT_V(4); PG8_BAR;
        PG8_STAGE(PG8_SB(1, 0), cB + kstep, voffB); PG8_STAGE(PG8_SA(1, 0), cA + kstep, voffA); PG8_STAGE(PG8_SB(1, 1), cB + hstep + kstep, voffB);
        PG8_WAIT_V(6); PG8_BAR;
    }
    for (;;) {
        const bool has_next = S.next(ui + 1, nxt);
        const char* nA = has_next ? (const char*)g.A + (size_t)nxt.pm * tstep + (size_t)(nxt.pn / g.agdiv) * g.agstride : cA; const char* nB = has_next ? (const char*)g.Bt + (size_t)nxt.pn * tstep : cB;
        for (int t = 0; t < nt; t += 2) {
            if constexpr (Epi::HAS_MID) { if (t == 8 || t == 16) E.mid(acc, cur, t >> 3, wr, wc, fr, fq); }
            const bool last = (t == nt - 2);
            const char* a1 = cA + (size_t)(t + 1) * kstep;
            const char* a2 = last ? nA : cA + (size_t)(t + 2) * kstep; const char* b2 = last ? nB : cB + (size_t)(t + 2) * kstep;
            const char* a3 = a2 + kstep; const char* b3 = b2 + kstep;
            if (last && has_next) S.a_ready(nxt);
            if constexpr (Epi::HAS_PRE) { if (last) E.pre(rsv, cur, wr, fr); }
            if constexpr (SP2) {
            PG8_LDB(B0, 0, 0); PG8_LDB(B1, 0, 1); PG8_SCHED; PG8_LDA(At, 0, 0); PG8_STAGE(PG8_SA(1, 1), a1 + hstep, voffA);
            PG8_WAIT_V(8); PG8_WAIT_L(0); PG8_BAR; PG8_MMA(0, 0, At, B0); PG8_MMA(0, 1, At, B1); PG8_BAR; PG8_SCHED;
            PG8_LDA(At, 0, 1); PG8_STAGE(PG8_SB(0, 0), b2, voffB); PG8_STAGE(PG8_SB(0, 1), b2 + hstep, voffB); PG8_STAGE(PG8_SA(0, 0), a2, voffA);
            PG8_WAIT_V(8); PG8_WAIT_L(0); PG8_BAR; PG8_MMA(1, 0, At, B0); PG8_MMA(1, 1, At, B1); PG8_BAR; PG8_SCHED;
            PG8_LDB(B0, 1, 0); PG8_LDB(B1, 1, 1); PG8_SCHED; PG8_LDA(At, 1, 0); PG8_STAGE(PG8_SA(0, 1), a2 + hstep, voffA);
            PG8_WAIT_V(8); PG8_WAIT_L(0); PG8_BAR; PG8_MMA(0, 0, At, B0); PG8_MMA(0, 1, At, B1); PG8_BAR; PG8_SCHED;
            PG8_LDA(At, 1, 1); PG8_STAGE(PG8_SB(1, 0), b3, voffB); PG8_STAGE(PG8_SB(1, 1), b3 + hstep, voffB); PG8_STAGE(PG8_SA(1, 0), a3, voffA);
            PG8_WAIT_V(8); PG8_WAIT_L(0); PG8_BAR; PG8_MMA(1, 0, At, B0); PG8_MMA(1, 1, At, B1); PG8_BAR; PG8_SCHED;
            } else {
            PG8_LDB(B0, 0, 0); PG8_SCHED; PG8_LDA(At, 0, 0); PG8_STAGE(PG8_SA(1, 1), a1 + hstep, voffA);
            PG8_WAIT_L(8); PG8_BAR; PG8_WAIT_L(0); PG8_MMA(0, 0, At, B0); PG8_BAR; PG8_SCHED;
            PG8_LDB(B1, 0, 1); PG8_STAGE(PG8_SB(0, 0), b2, voffB);
            PG8_BAR; PG8_WAIT_L(0); PG8_MMA(0, 1, At, B1); PG8_BAR;
            PG8_LDA(At, 0, 1); PG8_STAGE(PG8_SA(0, 0), a2, voffA);
            PG8_BAR; PG8_WAIT_L(0); PG8_MMA(1, 0, At, B0); PG8_BAR; PG8_SCHED;
            PG8_STAGE(PG8_SB(0, 1), b2 + hstep, voffB);
            PG8_WAIT_V(6); PG8_BAR; PG8_MMA(1, 1, At, B1); PG8_BAR;
            PG8_LDB(B0, 1, 0); PG8_SCHED; PG8_LDA(At, 1, 0); PG8_STAGE(PG8_SA(0, 1), a2 + hstep, voffA);
            PG8_WAIT_L(8); PG8_BAR; PG8_WAIT_L(0); PG8_MMA(0, 0, At, B0); PG8_BAR; PG8_SCHED;
            PG8_LDB(B1, 1, 1); PG8_STAGE(PG8_SB(1, 0), b3, voffB);
            PG8_BAR; PG8_WAIT_L(0); PG8_MMA(0, 1, At, B1); PG8_BAR;
            PG8_LDA(At, 1, 1); PG8_STAGE(PG8_SA(1, 0), a3, voffA);
            PG8_BAR; PG8_WAIT_L(0); PG8_MMA(1, 0, At, B0); PG8_BAR; PG8_SCHED;
            PG8_STAGE(PG8_SB(1, 1), b3 + hstep, voffB);
            PG8_WAIT_V(6); PG8_BAR; PG8_MMA(1, 1, At, B1); PG8_BAR;
            }
        }
        if constexpr (ALIGN_EPI) { if (wr == 0) PG8_BAR; }
        if constexpr (!Epi::AFTER_DRAIN) { E(acc, cur, wr, wc, fr, fq, rsv); S.done(cur); }
        if (!has_next) break;
#pragma unroll
        for (int a = 0; a < 2; ++a)
#pragma unroll
            for (int b = 0; b < 2; ++b)
#pragma unroll
                for (int m = 0; m < 4; ++m)
#pragma unroll
                    for (int n = 0; n < 2; ++n) acc[a][b][m][n] = (f32x4){0.f, 0.f, 0.f, 0.f};
        cur = nxt; cA = nA; cB = nB; ++ui;
        if constexpr (ALIGN_EPI) { if (wr == 1) PG8_BAR; }
    }
    PG8_WAIT_V(0);
    if constexpr (!ALIGN_EPI) { if (wr == 0) PG8_BAR; }
    PG8_BAR;
    if constexpr (Epi::AFTER_DRAIN) { E.fused(acc, cur, wr, wc, fr, fq, lds, wid, lane); S.done(cur); }
#undef PG8_SA
#undef PG8_SB
#undef PG8_STAGE
#undef PG8_LDA
#undef PG8_LDB
#undef PG8_MMA
#undef PG8_WAIT_V
#undef PG8_WAIT_L
#undef PG8_BAR
#undef PG8_SCHED
}
}

#define LAS __attribute__((address_space(3)))
typedef unsigned short bf16_t;
typedef short bf16x8 __attribute__((ext_vector_type(8)));
typedef short s16x4 __attribute__((ext_vector_type(4)));
typedef float f32x4 __attribute__((ext_vector_type(4)));
typedef unsigned u32x4 __attribute__((ext_vector_type(4)));
typedef unsigned u32x2 __attribute__((ext_vector_type(2)));
using pg8::cvt_pk_bf16; using pg8::fsigmoid; using pg8::fsilu; using pg8::bflo; using pg8::bfhi;

constexpr int DM = 1024, FF = 2048, NIN = 6400, DEPTH = 4;
constexpr int MP = 16896;
constexpr int BROWS = 8320;
constexpr int PADR = 112, TPB = 8208, NT = 65;
constexpr int SROW0 = 16640;
constexpr int MREAL = 16768;
constexpr int PAW = 3328, GTW = 3072;
constexpr int C_XA = 0, C_YA = 512, C_QS = 1024, C_KS = 1536, C_VS = 1664, C_QR = 1792, C_KR = 2048, C_VR = 2304, C_GR = 2816;
constexpr int NTHR = 512;
constexpr int OBS = 1536;
constexpr int LDS_BYTES = 131072 + 256;

constexpr size_t MiB = 1u << 20;
constexpr size_t WS_BAR = 0;
constexpr size_t WS_LSUM = 1 * MiB;
constexpr size_t WS_LCAR = WS_LSUM + 1 * MiB;
constexpr size_t WS_W0 = 3 * MiB;
constexpr size_t WSZ = 46 * MiB;
constexpr size_t W_GU1 = 0, W_D1 = 8 * MiB, W_IN = 12 * MiB, W_BR = 25 * MiB, W_OUT = 28 * MiB, W_GU2 = 34 * MiB, W_D2 = 42 * MiB;
constexpr size_t WS_X = WS_W0 + 2 * WSZ;
constexpr size_t WS_XB = WS_X + 66 * MiB;
constexpr size_t WS_PA = WS_XB + 33 * MiB;
constexpr size_t WS_GT = WS_PA + 108 * MiB;
constexpr size_t WS_OB = WS_GT + 99 * MiB;
constexpr size_t WS_U = WS_OB + 50 * MiB;
constexpr size_t WS_ST = WS_U + 17 * MiB;
constexpr size_t WS_SS16 = WS_ST + 9 * MiB;
constexpr size_t WS_BG = WS_SS16 + 14 * MiB;
constexpr size_t WS_RS = WS_BG + 33 * MiB;
constexpr size_t WS_END = WS_RS + 1 * MiB;

constexpr int O_YP = 0, O_YS = 16777216, O_PK = 16908288, O_PV = 17039360, O_PC = 17170432, O_PL = 17182720, O_PR = 17186816,
              O_SK = 17448960, O_SV = 25837568, O_SC = 34226176, O_SL = 35012608, O_SR = 35274752;

enum { I_XP = 0, I_XS, I_CK, I_CV, I_SCONV, I_SLRU, I_SRET, I_META, I_F1N, I_F1GU, I_F1D, I_MIXN, I_WIN, I_CONVW, I_CONVB, I_LWA, I_LBA, I_LWX, I_LBX, I_LAM,
       I_SINK, I_RETN, I_WBA, I_WBB, I_WBC, I_WOUT, I_F2N, I_F2GU, I_F2D, I_FINN };

struct Args { const float* in[30]; float* out; unsigned char* ws; int ph_lo, ph_hi; };
typedef const __attribute__((address_space(4))) Args CArgs;

__device__ __forceinline__ float bf2f(bf16_t v) { return __uint_as_float((unsigned)v << 16); }
__device__ __forceinline__ bf16_t f2bf(float f) { return (bf16_t)(cvt_pk_bf16(f, 0.f) & 0xffffu); }
__device__ __forceinline__ float gelu_tanh(float x) { const float t = 0.7978845608028654f * (x + 0.044715f * x * x * x); const float e = __expf(2.0f * t); const float th = 1.0f - 2.0f * __builtin_amdgcn_rcpf(e + 1.0f); return 0.5f * x * (1.0f + th); }
__device__ __forceinline__ void sincos_rev(float ang, float& s, float& c) {
    const double rv = (double)ang * 0.15915494309189535; const float fr = (float)(rv - __builtin_rint(rv));
    s = __builtin_amdgcn_sinf(fr); c = __builtin_amdgcn_cosf(fr);
}
__device__ __forceinline__ float rope_inv(int i) { return exp2f(-(float)i * (13.287712379549449f / 32.0f)); }
__device__ __forceinline__ float log2_gamma(int h) { return log2f(1.0f - exp2f(-5.0f - (float)h)); }
__device__ __forceinline__ int tid_opaque() { int t = threadIdx.x; asm volatile("" : "+v"(t)); return t; }
#define LDSW() asm volatile("s_waitcnt lgkmcnt(0)" ::: "memory")

__device__ __forceinline__ void cvt_item(const float* W, int K, int N, bf16_t* WT, int ldk, int rep, const float* g, int mode, LAS float* scr, int item, int lane) {
    const int nblk = N / 32, kb = item / nblk, nb = item % nblk, k0 = 64 * kb, n0 = 32 * nb;
    float wv[32];
#pragma unroll
    for (int i = 0; i < 32; ++i) { const int kk = 2 * i + (lane >> 5); wv[i] = W[(size_t)(k0 + kk) * N + n0 + (lane & 31)]; }
#pragma unroll
    for (int i = 0; i < 32; ++i) { const int kk = 2 * i + (lane >> 5); float w = wv[i]; if (g) w *= g[k0 + kk]; scr[kk * 33 + (lane & 31)] = w; }
    LDSW();
    const int c = lane & 7;
#pragma unroll
    for (int j = 0; j < 4; ++j) {
        const int n = (lane >> 3) + 8 * j; const LAS float* s = scr + (8 * c) * 33 + n;
        u32x4 o; o.x = cvt_pk_bf16(s[0 * 33], s[1 * 33]); o.y = cvt_pk_bf16(s[2 * 33], s[3 * 33]); o.z = cvt_pk_bf16(s[4 * 33], s[5 * 33]); o.w = cvt_pk_bf16(s[6 * 33], s[7 * 33]);
        const int nn = n0 + n; const int drow = mode ? (256 * ((nn & 2047) >> 7) + 128 * (nn >> 11) + (nn & 127)) : nn;
        for (int r = 0; r < rep; ++r) *(u32x4*)(WT + (size_t)drow * ldk + r * K + k0 + 8 * c) = o;
    }
    LDSW();
}
__device__ __forceinline__ void convert_layer(CArgs* a, int l, unsigned char* wbuf, LAS unsigned char* lds, int gw, int ngw, int wave, int lane) {
    LAS float* scr = (LAS float*)(lds + wave * 8448);
    constexpr int I_GU = 16 * 128, I_D = 32 * 32, I_W = 16 * 200, I_B = 8 * 32, I_O = 16 * 32;
    constexpr int NITEMS = 2 * I_GU + 2 * I_D + I_W + 3 * I_B + I_O;
    for (int it = gw; it < NITEMS; it += ngw) {
        int r = it;
        if (r < I_GU) { cvt_item(a->in[I_F1GU] + (size_t)l * DM * 4096, DM, 4096, (bf16_t*)(wbuf + W_GU1), DM, 1, a->in[I_F1N] + l * DM, 1, scr, r, lane); continue; } r -= I_GU;
        if (r < I_GU) { cvt_item(a->in[I_F2GU] + (size_t)l * DM * 4096, DM, 4096, (bf16_t*)(wbuf + W_GU2), DM, 1, a->in[I_F2N] + l * DM, 1, scr, r, lane); continue; } r -= I_GU;
        if (r < I_D) { cvt_item(a->in[I_F1D] + (size_t)l * FF * DM, FF, DM, (bf16_t*)(wbuf + W_D1), FF, 1, nullptr, 0, scr, r, lane); continue; } r -= I_D;
        if (r < I_D) { cvt_item(a->in[I_F2D] + (size_t)l * FF * DM, FF, DM, (bf16_t*)(wbuf + W_D2), FF, 1, nullptr, 0, scr, r, lane); continue; } r -= I_D;
        if (r < I_W) { cvt_item(a->in[I_WIN] + (size_t)l * DM * NIN, DM, NIN, (bf16_t*)(wbuf + W_IN), DM, 1, a->in[I_MIXN] + l * DM, 0, scr, r, lane); continue; } r -= I_W;
        if (r < 3 * I_B) { const int br = r / I_B; cvt_item((br == 0 ? a->in[I_WBA] : (br == 1 ? a->in[I_WBB] : a->in[I_WBC])) + (size_t)l * 512 * DM, 512, DM, (bf16_t*)(wbuf + W_BR) + br * 512, OBS, 1, nullptr, 0, scr, r % I_B, lane); continue; } r -= 3 * I_B;
        cvt_item(a->in[I_WOUT] + (size_t)l * DM * DM, DM, DM, (bf16_t*)(wbuf + W_OUT), DM, 1, nullptr, 0, scr, r, lane);
    }
}

__device__ __forceinline__ float wave_sum(float v) {
#pragma unroll
    for (int o = 1; o < 64; o <<= 1) v += __shfl_xor(v, o);
    return v;
}
__device__ __forceinline__ void init_rows(CArgs* a, float* X, bf16_t* XB, float* SS, float* RS0, bf16_t* OB, int gw, int ngw, int lane) {
    for (int r = gw; r < MP; r += ngw) {
        const float* src = nullptr;
        if (r < 2 * BROWS) { const int b = r / BROWS, pr = r % BROWS; if (pr >= PADR) { const int t = pr - PADR; src = (t < 16) ? a->in[I_META] + (size_t)t * DM : a->in[I_XP] + ((size_t)b * 8192 + (t - 16)) * DM; } }
        else if (r < MREAL) src = a->in[I_XS] + (size_t)(r - SROW0) * DM;
        float sq = 0.f;
#pragma unroll
        for (int j = 0; j < 4; ++j) {
            f32x4 v = (f32x4){0.f, 0.f, 0.f, 0.f};
            if (src) v = *((const f32x4*)src + lane + 64 * j);
            *((f32x4*)(X + (size_t)r * DM) + lane + 64 * j) = v;
            u32x2 w; w.x = cvt_pk_bf16(v[0], v[1]); w.y = cvt_pk_bf16(v[2], v[3]); *((u32x2*)(XB + (size_t)r * DM) + lane + 64 * j) = w;
            sq += (v[0] * v[0] + v[1] * v[1]) + (v[2] * v[2] + v[3] * v[3]);
        }
        sq = wave_sum(sq);
        if (lane < 16) SS[(size_t)r * 16 + lane] = (lane == 0) ? sq : 0.f;
        if (lane == 0) RS0[r] = __builtin_amdgcn_rsqf(sq * (1.0f / 1024.0f) + 1e-6f);
        if (r >= MREAL) {
#pragma unroll
            for (int br = 0; br < 3; ++br) *((u32x4*)(OB + (size_t)r * OBS + br * 512) + lane) = (u32x4){0u, 0u, 0u, 0u};
        }
    }
}

__device__ __forceinline__ void lru1_item(CArgs* a, int l, int tt, int chblk, const bf16_t* PA, bf16_t* OB0, float* LSUM, float* AG, float* BG, LAS unsigned char* lds) {
    LAS float* xa_s = (LAS float*)lds;
    LAS float* xc_s = xa_s + 131 * 64;
    LAS bf16_t* wt_s = (LAS bf16_t*)(xc_s + 128 * 64);
    LAS float* seg_s = (LAS float*)(wt_s + 128 * 72);
    const int tid = tid_opaque(), lane = tid & 63, w = tid >> 6, fr = lane & 15, fq = lane >> 4;
    const int ch0 = chblk * 64, ch = ch0 + lane;
    const bool sample = (tt == 130);
    const int b = tt / NT, n = tt % NT;
    const int row0 = sample ? SROW0 : b * BROWS + n * 128;
    {
        const float* wa = a->in[I_LWA] + ((size_t)l * 8 + chblk) * 4096; const float* wx = a->in[I_LWX] + ((size_t)l * 8 + chblk) * 4096;
        float wv[16];
#pragma unroll
        for (int k = 0; k < 16; ++k) { const int i = tid + k * NTHR; wv[k] = (i < 4096) ? wa[i] : wx[i - 4096]; }
#pragma unroll
        for (int k = 0; k < 16; ++k) { const int i = tid + k * NTHR; const int m = i >> 12, c = (i >> 6) & 63, d = i & 63; wt_s[(m * 64 + d) * 72 + c] = f2bf(wv[k]); }
    }
    const float cw0 = a->in[I_CONVW][(l * 4 + 0) * 512 + ch], cw1 = a->in[I_CONVW][(l * 4 + 1) * 512 + ch], cw2 = a->in[I_CONVW][(l * 4 + 2) * 512 + ch], cw3 = a->in[I_CONVW][(l * 4 + 3) * 512 + ch];
    const float cb = a->in[I_CONVB][l * 512 + ch];
    if (!sample) {
        float xv[17];
#pragma unroll
        for (int k = 0; k < 17; ++k) {
            const int rr = w + 8 * k; const int grow = row0 - 3 + rr; xv[k] = 0.f;
            if (rr < 131 && !(n == 0 && rr < 3)) xv[k] = bf2f(PA[(size_t)grow * PAW + C_XA + ch]);
        }
#pragma unroll
        for (int k = 0; k < 17; ++k) { const int rr = w + 8 * k; if (rr < 131) xa_s[rr * 64 + lane] = xv[k]; }
        __syncthreads();
#pragma unroll 4
        for (int r = w; r < 128; r += 8) xc_s[r * 64 + lane] = cb + cw0 * xa_s[r * 64 + lane] + cw1 * xa_s[(r + 1) * 64 + lane] + cw2 * xa_s[(r + 2) * 64 + lane] + cw3 * xa_s[(r + 3) * 64 + lane];
        if (n == NT - 1 && w < 3) a->out[O_PC + ((l * 2 + b) * 3 + w) * 512 + ch] = xa_s[(128 + w) * 64 + lane];
    } else {
#pragma unroll
        for (int k = 0; k < 16; ++k) { const int r = w + 8 * k;
            const float* sc = a->in[I_SCONV] + ((size_t)(l * 128 + r) * 3) * 512 + ch; const float s0 = sc[0], s1 = sc[512], s2 = sc[1024];
            const float xa = bf2f(PA[(size_t)(SROW0 + r) * PAW + C_XA + ch]);
            xc_s[r * 64 + lane] = cb + cw0 * s0 + cw1 * s1 + cw2 * s2 + cw3 * xa;
            float* oc = a->out + O_SC + ((size_t)(l * 128 + r) * 3) * 512 + ch; oc[0] = s1; oc[512] = s2; oc[1024] = xa;
        }
    }
    __syncthreads();
    f32x4 acc[8];
    {
        bf16x8 af[2];
#pragma unroll
        for (int ks = 0; ks < 2; ++ks) {
            const f32x4 x0 = *(const LAS f32x4*)(xc_s + (16 * w + fr) * 64 + 32 * ks + 8 * fq), x1 = *(const LAS f32x4*)(xc_s + (16 * w + fr) * 64 + 32 * ks + 8 * fq + 4);
            u32x4 p; p.x = cvt_pk_bf16(x0[0], x0[1]); p.y = cvt_pk_bf16(x0[2], x0[3]); p.z = cvt_pk_bf16(x1[0], x1[1]); p.w = cvt_pk_bf16(x1[2], x1[3]); af[ks] = __builtin_bit_cast(bf16x8, p);
        }
#pragma unroll
        for (int t = 0; t < 8; ++t) {
            acc[t] = (f32x4){0.f, 0.f, 0.f, 0.f};
#pragma unroll
            for (int ks = 0; ks < 2; ++ks) { const bf16x8 bfr = *(const LAS bf16x8*)(wt_s + (t * 16 + fr) * 72 + 32 * ks + 8 * fq); acc[t] = __builtin_amdgcn_mfma_f32_16x16x32_bf16(af[ks], bfr, acc[t], 0, 0, 0); }
        }
    }
    LAS float* a_s = xa_s;
#pragma unroll
    for (int dt = 0; dt < 4; ++dt) {
        const int d = 16 * dt + fr, cch = ch0 + d;
        const float ba = a->in[I_LBA][l * 512 + cch], bx = a->in[I_LBX][l * 512 + cch];
        const float sp = log1pf(__expf(-a->in[I_LAM][l * 512 + cch]));
#pragma unroll
        for (int i = 0; i < 4; ++i) {
            const int r = 16 * w + 4 * fq + i;
            const float rg = fsigmoid(acc[dt][i] + ba), ig = fsigmoid(acc[4 + dt][i] + bx);
            const float la = -8.0f * rg * sp; float av = __expf(la);
            const float t2 = 2.0f * la;
            const float om = (t2 > -0.0625f) ? -t2 * (1.0f + t2 * (0.5f + t2 * (0.16666667f + t2 * (0.041666667f + t2 * 0.0083333333f)))) : 1.0f - av * av;
            float bv = __builtin_amdgcn_sqrtf(om) * (ig * xc_s[r * 64 + d]);
            if (!sample && n == 0 && r < PADR) { av = 1.0f; bv = 0.0f; }
            a_s[r * 64 + d] = av; xc_s[r * 64 + d] = bv;
        }
    }
    __syncthreads();
    if (sample) {
#pragma unroll
        for (int i = 0; i < 16; ++i) {
            const int r = w * 16 + i;
            const float hs = a_s[r * 64 + lane] * a->in[I_SLRU][(size_t)(l * 128 + r) * 512 + ch] + xc_s[r * 64 + lane];
            a->out[O_SL + (size_t)(l * 128 + r) * 512 + ch] = hs;
            const float ya = bf2f(PA[(size_t)(SROW0 + r) * PAW + C_YA + ch]);
            OB0[(size_t)(SROW0 + r) * OBS + ch] = f2bf(hs * gelu_tanh(ya));
        }
        __syncthreads();
        return;
    }
    float P = 1.0f, h = 0.0f;
#pragma unroll 4
    for (int i = 0; i < 16; ++i) {
        const int r = w * 16 + i; const float av = a_s[r * 64 + lane], bv = xc_s[r * 64 + lane];
        AG[(size_t)(row0 + r) * 512 + ch] = av; BG[(size_t)(row0 + r) * 512 + ch] = bv;
        h = av * h + bv; P *= av;
    }
    seg_s[(w * 64 + lane) * 2] = P; seg_s[(w * 64 + lane) * 2 + 1] = h;
    __syncthreads();
    if (w == 0) {
        float Pt = 1.0f, ht = 0.0f;
#pragma unroll
        for (int q = 0; q < 8; ++q) { const float p = seg_s[(q * 64 + lane) * 2], hh = seg_s[(q * 64 + lane) * 2 + 1]; ht = p * ht + hh; Pt *= p; }
        LSUM[((size_t)tt * 512 + ch) * 2] = Pt; LSUM[((size_t)tt * 512 + ch) * 2 + 1] = ht;
    }
    __syncthreads();
}
__device__ __forceinline__ void lru2_item(int tt, int chblk, const bf16_t* PA, bf16_t* OB0, const float* LCAR, const float* AG, const float* BG, LAS unsigned char* lds) {
    LAS float* seg_s = (LAS float*)lds;
    const int tid = tid_opaque(), lane = tid & 63, w = tid >> 6; const int ch = chblk * 64 + lane;
    const int b = tt / NT, n = tt % NT, row0 = b * BROWS + n * 128 + w * 16;
    float av[16], bv[16], yv[16];
#pragma unroll
    for (int i = 0; i < 16; ++i) { av[i] = AG[(size_t)(row0 + i) * 512 + ch]; bv[i] = BG[(size_t)(row0 + i) * 512 + ch]; yv[i] = bf2f(PA[(size_t)(row0 + i) * PAW + C_YA + ch]); }
    float hc = LCAR[(size_t)tt * 512 + ch];
    float P = 1.0f, h = 0.0f;
#pragma unroll
    for (int i = 0; i < 16; ++i) { h = av[i] * h + bv[i]; P *= av[i]; }
    seg_s[(w * 64 + lane) * 2] = P; seg_s[(w * 64 + lane) * 2 + 1] = h;
    __syncthreads();
    for (int q = 0; q < w; ++q) { const float p = seg_s[(q * 64 + lane) * 2], hh = seg_s[(q * 64 + lane) * 2 + 1]; hc = p * hc + hh; }
#pragma unroll
    for (int i = 0; i < 16; ++i) { hc = av[i] * hc + bv[i]; OB0[(size_t)(row0 + i) * OBS + ch] = f2bf(hc * gelu_tanh(yv[i])); }
    __syncthreads();
}

__device__ __forceinline__ void swa_item(CArgs* a, int l, int item, const bf16_t* PA, bf16_t* OB1, LAS unsigned char* lds) {
    const int kvh = item & 1, bn = item >> 1, b = bn / NT, n = bn % NT, row0 = b * BROWS + n * 128;
    LAS bf16_t* Ks = (LAS bf16_t*)lds;
    LAS bf16_t* Vt = Ks + 256 * 72;
    const int tid = tid_opaque(), lane = tid & 63, w = tid >> 6, fr = lane & 15, fq = lane >> 4;
    const int g = w >> 1, h = kvh * 4 + g;
    const float sink = a->in[I_SINK][l * 8 + h];
    bf16x8 qfa[4][2];
#pragma unroll
    for (int qb = 0; qb < 4; ++qb) { const int row = row0 + (w & 1) * 64 + qb * 16 + fr; qfa[qb][0] = *(const bf16x8*)(PA + (size_t)row * PAW + C_QS + h * 64 + fq * 8); qfa[qb][1] = *(const bf16x8*)(PA + (size_t)row * PAW + C_QS + h * 64 + 32 + fq * 8); }
    {
        const int key = tid >> 1, hf = tid & 1; const int grow = row0 - 128 + key; const bool valid = (n > 0) || (key >= 128);
        u32x4 kk[4], vv[4];
#pragma unroll
        for (int j = 0; j < 4; ++j) { kk[j] = (u32x4){0u, 0u, 0u, 0u}; vv[j] = (u32x4){0u, 0u, 0u, 0u}; }
        if (valid) {
            const u32x4* kp = (const u32x4*)(PA + (size_t)grow * PAW + C_KS + kvh * 64 + hf * 32); const u32x4* vp = (const u32x4*)(PA + (size_t)grow * PAW + C_VS + kvh * 64 + hf * 32);
#pragma unroll
            for (int j = 0; j < 4; ++j) { kk[j] = kp[j]; vv[j] = vp[j]; }
        }
#pragma unroll
        for (int j = 0; j < 4; ++j) *(LAS u32x4*)(Ks + key * 72 + hf * 32 + j * 8) = kk[j];
#pragma unroll
        for (int j = 0; j < 4; ++j) {
            const unsigned ws4[4] = {vv[j].x, vv[j].y, vv[j].z, vv[j].w};
#pragma unroll
            for (int q = 0; q < 4; ++q) { const int d = hf * 32 + j * 8 + q * 2; Vt[d * 280 + key] = (bf16_t)(ws4[q] & 0xffffu); Vt[(d + 1) * 280 + key] = (bf16_t)(ws4[q] >> 16); }
        }
        if (tid < 64) {
#pragma unroll
            for (int e = 256; e < 280; ++e) Vt[tid * 280 + e] = 0;
        }
        if (n == NT - 1 && key >= 128) {
            float* ok = a->out + O_PK + ((size_t)(l * 2 + b) * 128 + (key - 128)) * 128 + kvh * 64 + hf * 32; float* ov = a->out + O_PV + ((size_t)(l * 2 + b) * 128 + (key - 128)) * 128 + kvh * 64 + hf * 32;
#pragma unroll
            for (int j = 0; j < 4; ++j) {
                *(f32x4*)(ok + j * 8) = (f32x4){bflo(kk[j].x), bfhi(kk[j].x), bflo(kk[j].y), bfhi(kk[j].y)}; *(f32x4*)(ok + j * 8 + 4) = (f32x4){bflo(kk[j].z), bfhi(kk[j].z), bflo(kk[j].w), bfhi(kk[j].w)};
                *(f32x4*)(ov + j * 8) = (f32x4){bflo(vv[j].x), bfhi(vv[j].x), bflo(vv[j].y), bfhi(vv[j].y)}; *(f32x4*)(ov + j * 8 + 4) = (f32x4){bflo(vv[j].z), bfhi(vv[j].z), bflo(vv[j].w), bfhi(vv[j].w)};
            }
        }
    }
    __syncthreads();
#pragma unroll
    for (int qb = 0; qb < 4; ++qb) {
        const int r0 = (w & 1) * 64 + qb * 16, jt0 = r0 >> 4, r = r0 + fr, row = row0 + r;
        const bf16x8 qf[2] = {qfa[qb][0], qfa[qb][1]};
        f32x4 sacc[10];
#pragma unroll
        for (int t = 0; t < 9; ++t) {
            sacc[t] = (f32x4){0.f, 0.f, 0.f, 0.f};
#pragma unroll
            for (int ks = 0; ks < 2; ++ks) { const bf16x8 kf = *(const LAS bf16x8*)(Ks + ((jt0 + t) * 16 + fr) * 72 + ks * 32 + fq * 8); sacc[t] = __builtin_amdgcn_mfma_f32_16x16x32_bf16(kf, qf[ks], sacc[t], 0, 0, 0); }
        }
        sacc[9] = (f32x4){0.f, 0.f, 0.f, 0.f};
        float mx = -INFINITY;
#pragma unroll
        for (int t = 0; t < 9; ++t)
#pragma unroll
            for (int i = 0; i < 4; ++i) {
                const int kj = (jt0 + t) * 16 + 4 * fq + i;
                const bool valid = (kj > r) && (kj <= r + 128) && (n * 128 - 128 + kj >= PADR);
                const float s = valid ? sacc[t][i] * 0.125f : -INFINITY; sacc[t][i] = s; mx = fmaxf(mx, s);
            }
        mx = fmaxf(mx, __shfl_xor(mx, 16)); mx = fmaxf(mx, __shfl_xor(mx, 32));
        const float mm = fmaxf(mx, sink);
        float sum = 0.f;
#pragma unroll
        for (int t = 0; t < 9; ++t)
#pragma unroll
            for (int i = 0; i < 4; ++i) { const float e = __expf(sacc[t][i] - mm); sacc[t][i] = e; sum += e; }
        sum += __shfl_xor(sum, 16); sum += __shfl_xor(sum, 32);
        const float inv = 1.0f / (sum + __expf(sink - mm));
        f32x4 oacc[4];
#pragma unroll
        for (int dt = 0; dt < 4; ++dt) oacc[dt] = (f32x4){0.f, 0.f, 0.f, 0.f};
#pragma unroll
        for (int p = 0; p < 5; ++p) {
            const f32x4 ea = sacc[2 * p] * inv, eb = sacc[2 * p + 1] * inv;
            u32x4 pw; pw.x = cvt_pk_bf16(ea[0], ea[1]); pw.y = cvt_pk_bf16(ea[2], ea[3]); pw.z = cvt_pk_bf16(eb[0], eb[1]); pw.w = cvt_pk_bf16(eb[2], eb[3]);
            const bf16x8 pb = __builtin_bit_cast(bf16x8, pw);
            const int ja = jt0 + 2 * p;
#pragma unroll
            for (int dt = 0; dt < 4; ++dt) {
                const u32x2 va = *(const LAS u32x2*)(Vt + (dt * 16 + fr) * 280 + ja * 16 + 4 * fq), vb = *(const LAS u32x2*)(Vt + (dt * 16 + fr) * 280 + (ja + 1) * 16 + 4 * fq);
                const u32x4 vw = (u32x4){va.x, va.y, vb.x, vb.y};
                oacc[dt] = __builtin_amdgcn_mfma_f32_16x16x32_bf16(__builtin_bit_cast(bf16x8, vw), pb, oacc[dt], 0, 0, 0);
            }
        }
#pragma unroll
        for (int dt = 0; dt < 4; ++dt) { u32x2 o; o.x = cvt_pk_bf16(oacc[dt][0], oacc[dt][1]); o.y = cvt_pk_bf16(oacc[dt][2], oacc[dt][3]); *(u32x2*)(OB1 + (size_t)row * OBS + h * 64 + dt * 16 + 4 * fq) = o; }
    }
    __syncthreads();
}

__device__ __forceinline__ void ret_u_item(int item, const bf16_t* PA, float* U, LAS unsigned char* lds) {
    const int hh = item & 3, bc = item >> 2, b = bc / NT, c = bc % NT, row0 = b * BROWS + c * 128;
    LAS bf16_t* Kt = (LAS bf16_t*)lds;
    LAS bf16_t* Vt = Kt + 64 * 136;
    const int tid = tid_opaque(), lane = tid & 63, w = tid >> 6, fr = lane & 15, fq = lane >> 4; const float l2g = log2_gamma(hh);
    {
        const int j = tid >> 2, q = tid & 3; const bf16_t* rowp = PA + (size_t)(row0 + j) * PAW;
        const u32x4* vp = (const u32x4*)(rowp + C_VR + hh * 128 + q * 32);
        u32x4 vv[4];
#pragma unroll
        for (int t = 0; t < 4; ++t) vv[t] = vp[t];
        const u32x4 k1 = *(const u32x4*)(rowp + C_KR + hh * 64 + q * 8), k2 = *(const u32x4*)(rowp + C_KR + hh * 64 + 32 + q * 8);
#pragma unroll
        for (int t = 0; t < 4; ++t) {
            const unsigned ws4[4] = {vv[t].x, vv[t].y, vv[t].z, vv[t].w};
#pragma unroll
            for (int k = 0; k < 4; ++k) { const int e = q * 32 + t * 8 + k * 2; Vt[e * 136 + j] = (bf16_t)(ws4[k] & 0xffffu); Vt[(e + 1) * 136 + j] = (bf16_t)(ws4[k] >> 16); }
        }
        const unsigned w1[4] = {k1.x, k1.y, k1.z, k1.w}, w2[4] = {k2.x, k2.y, k2.z, k2.w};
        const int pos = c * 128 + j - PADR; const float dec = exp2f((float)(127 - j) * l2g) * 0.125f;
#pragma unroll
        for (int k = 0; k < 4; ++k) {
            float sa, ca, sb, cb; sincos_rev((float)pos * rope_inv(q * 8 + 2 * k), sa, ca); sincos_rev((float)pos * rope_inv(q * 8 + 2 * k + 1), sb, cb);
            const float x1a = bflo(w1[k]), x1b = bfhi(w1[k]), x2a = bflo(w2[k]), x2b = bfhi(w2[k]);
            const int d = q * 8 + 2 * k;
            Kt[d * 136 + j] = f2bf((x1a * ca - x2a * sa) * dec); Kt[(d + 32) * 136 + j] = f2bf((x1a * sa + x2a * ca) * dec);
            Kt[(d + 1) * 136 + j] = f2bf((x1b * cb - x2b * sb) * dec); Kt[(d + 33) * 136 + j] = f2bf((x1b * sb + x2b * cb) * dec);
        }
    }
    __syncthreads();
    const int dt = w >> 1;
    f32x4 acc[4];
#pragma unroll
    for (int t = 0; t < 4; ++t) acc[t] = (f32x4){0.f, 0.f, 0.f, 0.f};
#pragma unroll
    for (int ks = 0; ks < 4; ++ks) {
        const bf16x8 kf = *(const LAS bf16x8*)(Kt + (dt * 16 + fr) * 136 + 32 * ks + 8 * fq);
#pragma unroll
        for (int t = 0; t < 4; ++t) { const bf16x8 vf = *(const LAS bf16x8*)(Vt + ((4 * (w & 1) + t) * 16 + fr) * 136 + 32 * ks + 8 * fq); acc[t] = __builtin_amdgcn_mfma_f32_16x16x32_bf16(vf, kf, acc[t], 0, 0, 0); }
    }
#pragma unroll
    for (int t = 0; t < 4; ++t)
#pragma unroll
        for (int i = 0; i < 4; ++i) U[(size_t)item * 8192 + ((4 * (w & 1) + t) * 16 + 4 * fq + i) * 64 + dt * 16 + fr] = acc[t][i];
    __syncthreads();
}
__device__ __forceinline__ void ret_out_item(CArgs* a, int l, int item, const bf16_t* PA, const bf16_t* ST, bf16_t* OB2, LAS unsigned char* lds) {
    const int hh = item & 3, bc = item >> 2, b = bc / NT, c = bc % NT, row0 = b * BROWS + c * 128;
    LAS bf16_t* Kr = (LAS bf16_t*)lds;
    LAS bf16_t* Vt = Kr + 128 * 72;
    const int tid = tid_opaque(), lane = tid & 63, w = tid >> 6, fr = lane & 15, fq = lane >> 4; const float l2g = log2_gamma(hh);
    {
        const int j = tid >> 2, q = tid & 3; const bf16_t* rowp = PA + (size_t)(row0 + j) * PAW;
        const u32x4* vp = (const u32x4*)(rowp + C_VR + hh * 128 + q * 32);
        u32x4 vv[4];
#pragma unroll
        for (int t = 0; t < 4; ++t) vv[t] = vp[t];
        const u32x4 k1 = *(const u32x4*)(rowp + C_KR + hh * 64 + q * 8), k2 = *(const u32x4*)(rowp + C_KR + hh * 64 + 32 + q * 8);
#pragma unroll
        for (int t = 0; t < 4; ++t) {
            const unsigned ws4[4] = {vv[t].x, vv[t].y, vv[t].z, vv[t].w};
#pragma unroll
            for (int k = 0; k < 4; ++k) { const int e = q * 32 + t * 8 + k * 2; Vt[e * 136 + j] = (bf16_t)(ws4[k] & 0xffffu); Vt[(e + 1) * 136 + j] = (bf16_t)(ws4[k] >> 16); }
        }
        const unsigned w1[4] = {k1.x, k1.y, k1.z, k1.w}, w2[4] = {k2.x, k2.y, k2.z, k2.w};
        const int pos = c * 128 + j - PADR; unsigned o1[4], o2[4];
#pragma unroll
        for (int k = 0; k < 4; ++k) {
            float sa, ca, sb, cb; sincos_rev((float)pos * rope_inv(q * 8 + 2 * k), sa, ca); sincos_rev((float)pos * rope_inv(q * 8 + 2 * k + 1), sb, cb);
            const float x1a = bflo(w1[k]), x1b = bfhi(w1[k]), x2a = bflo(w2[k]), x2b = bfhi(w2[k]);
            o1[k] = cvt_pk_bf16((x1a * ca - x2a * sa) * 0.125f, (x1b * cb - x2b * sb) * 0.125f); o2[k] = cvt_pk_bf16((x1a * sa + x2a * ca) * 0.125f, (x1b * sb + x2b * cb) * 0.125f);
        }
        *(LAS u32x4*)(Kr + j * 72 + q * 8) = (u32x4){o1[0], o1[1], o1[2], o1[3]}; *(LAS u32x4*)(Kr + j * 72 + 32 + q * 8) = (u32x4){o2[0], o2[1], o2[2], o2[3]};
    }
    __syncthreads();
    const int il = 16 * w + fr, row = row0 + il, pos = c * 128 + il - PADR;
    bf16x8 qf[2], qs[2];
    {
        const u32x4 q1 = *(const u32x4*)(PA + (size_t)row * PAW + C_QR + hh * 64 + fq * 8), q2 = *(const u32x4*)(PA + (size_t)row * PAW + C_QR + hh * 64 + 32 + fq * 8);
        const unsigned w1[4] = {q1.x, q1.y, q1.z, q1.w}, w2[4] = {q2.x, q2.y, q2.z, q2.w};
        const float dsc = exp2f((float)(il + 1) * l2g);
        u32x4 o1, o2, s1, s2; unsigned r1[4], r2[4], t1[4], t2[4];
#pragma unroll
        for (int k = 0; k < 4; ++k) {
            float sa, ca, sb, cb; sincos_rev((float)pos * rope_inv(fq * 8 + 2 * k), sa, ca); sincos_rev((float)pos * rope_inv(fq * 8 + 2 * k + 1), sb, cb);
            const float x1a = bflo(w1[k]), x1b = bfhi(w1[k]), x2a = bflo(w2[k]), x2b = bfhi(w2[k]);
            const float y1a = x1a * ca - x2a * sa, y2a = x1a * sa + x2a * ca, y1b = x1b * cb - x2b * sb, y2b = x1b * sb + x2b * cb;
            r1[k] = cvt_pk_bf16(y1a, y1b); r2[k] = cvt_pk_bf16(y2a, y2b); t1[k] = cvt_pk_bf16(y1a * dsc, y1b * dsc); t2[k] = cvt_pk_bf16(y2a * dsc, y2b * dsc);
        }
        o1 = (u32x4){r1[0], r1[1], r1[2], r1[3]}; o2 = (u32x4){r2[0], r2[1], r2[2], r2[3]}; s1 = (u32x4){t1[0], t1[1], t1[2], t1[3]}; s2 = (u32x4){t2[0], t2[1], t2[2], t2[3]};
        qf[0] = __builtin_bit_cast(bf16x8, o1); qf[1] = __builtin_bit_cast(bf16x8, o2); qs[0] = __builtin_bit_cast(bf16x8, s1); qs[1] = __builtin_bit_cast(bf16x8, s2);
    }
    f32x4 sacc[8];
#pragma unroll
    for (int jt = 0; jt < 8; ++jt) {
        sacc[jt] = (f32x4){0.f, 0.f, 0.f, 0.f};
        if (jt <= w) {
#pragma unroll
            for (int ks = 0; ks < 2; ++ks) { const bf16x8 kf = *(const LAS bf16x8*)(Kr + (jt * 16 + fr) * 72 + ks * 32 + fq * 8); sacc[jt] = __builtin_amdgcn_mfma_f32_16x16x32_bf16(kf, qf[ks], sacc[jt], 0, 0, 0); }
        }
#pragma unroll
        for (int i = 0; i < 4; ++i) { const int dl = il - (jt * 16 + 4 * fq + i); sacc[jt][i] = (dl >= 0) ? sacc[jt][i] * exp2f((float)dl * l2g) : 0.f; }
    }
    f32x4 oacc[8];
#pragma unroll
    for (int et = 0; et < 8; ++et) oacc[et] = (f32x4){0.f, 0.f, 0.f, 0.f};
#pragma unroll
    for (int p = 0; p < 4; ++p) {
        if (2 * p <= w) {
            u32x4 pw; pw.x = cvt_pk_bf16(sacc[2 * p][0], sacc[2 * p][1]); pw.y = cvt_pk_bf16(sacc[2 * p][2], sacc[2 * p][3]); pw.z = cvt_pk_bf16(sacc[2 * p + 1][0], sacc[2 * p + 1][1]); pw.w = cvt_pk_bf16(sacc[2 * p + 1][2], sacc[2 * p + 1][3]);
            const bf16x8 pb = __builtin_bit_cast(bf16x8, pw);
#pragma unroll
            for (int et = 0; et < 8; ++et) {
                const u32x2 va = *(const LAS u32x2*)(Vt + (et * 16 + fr) * 136 + 32 * p + 4 * fq), vb = *(const LAS u32x2*)(Vt + (et * 16 + fr) * 136 + 32 * p + 16 + 4 * fq);
                const u32x4 vw = (u32x4){va.x, va.y, vb.x, vb.y};
                oacc[et] = __builtin_amdgcn_mfma_f32_16x16x32_bf16(__builtin_bit_cast(bf16x8, vw), pb, oacc[et], 0, 0, 0);
            }
        }
    }
    {
        const bf16_t* sb = ST + (size_t)item * 8192;
#pragma unroll
        for (int et = 0; et < 8; ++et)
#pragma unroll
            for (int ks = 0; ks < 2; ++ks) { const bf16x8 sf = *(const bf16x8*)(sb + (et * 16 + fr) * 64 + ks * 32 + fq * 8); oacc[et] = __builtin_amdgcn_mfma_f32_16x16x32_bf16(sf, qs[ks], oacc[et], 0, 0, 0); }
    }
    float sm = 0.f;
#pragma unroll
    for (int et = 0; et < 8; ++et) sm += (oacc[et][0] + oacc[et][1]) + (oacc[et][2] + oacc[et][3]);
    sm += __shfl_xor(sm, 16); sm += __shfl_xor(sm, 32);
    const float mu = sm * (1.0f / 128.0f); float vr = 0.f;
#pragma unroll
    for (int et = 0; et < 8; ++et) { const f32x4 d = oacc[et] - mu; vr += (d[0] * d[0] + d[1] * d[1]) + (d[2] * d[2] + d[3] * d[3]); }
    vr += __shfl_xor(vr, 16); vr += __shfl_xor(vr, 32);
    const float rstd = 1.0f / sqrtf(vr * (1.0f / 128.0f) + 1e-5f);
#pragma unroll
    for (int et = 0; et < 8; ++et) {
        const int e = et * 16 + 4 * fq; const f32x4 gn = *(const f32x4*)(a->in[I_RETN] + l * 512 + hh * 128 + e);
        const u32x2 gr = *(const u32x2*)(PA + (size_t)row * PAW + C_GR + hh * 128 + e);
        const f32x4 y = (oacc[et] - mu) * rstd * gn;
        u32x2 o; o.x = cvt_pk_bf16(y[0] * fsilu(bflo(gr.x)), y[1] * fsilu(bfhi(gr.x))); o.y = cvt_pk_bf16(y[2] * fsilu(bflo(gr.y)), y[3] * fsilu(bfhi(gr.y)));
        *(u32x2*)(OB2 + (size_t)row * OBS + hh * 128 + e) = o;
    }
    __syncthreads();
}


enum { TM_SWIGLU = 0, TM_RESID = 1, TM_PROJ = 2, TM_BRANCH = 3 };
constexpr int TROW0 = 16384;
struct TailArgs { const bf16_t* A; const bf16_t* Bt; int K, N; bf16_t* O1; bf16_t* O2; float* X; const float* ss; float* ssn; const bf16_t* GT; float scale; };
template <int MODE> __device__ __forceinline__ void tail_gemm(const TailArgs& t, int u0, int G, LAS unsigned char* lds) {
    const int tid = tid_opaque(), lane = tid & 63, w = __builtin_amdgcn_readfirstlane(tid >> 6), fr = lane & 15, fq = lane >> 4;
    LAS float* part = (LAS float*)lds;
    const int K = t.K, nu = 8 * (t.N / 64);
    int ks0, nks;
    if (MODE == TM_BRANCH) { if (w < 6) { const int q = w % 3; ks0 = 16 * (w / 3) + (q == 0 ? 0 : (q == 1 ? 6 : 11)); nks = (q == 0) ? 6 : 5; } else { ks0 = 32 + 8 * (w - 6); nks = 8; } }
    else { nks = K / 256; ks0 = w * nks; }
    bf16x8 af[4][3], bfr[4][4];
#define TG_LOAD(uu, s0) do { const int rowb_ = TROW0 + 48 * ((uu) & 7), cgp_ = (uu) >> 3; \
        _Pragma("unroll") for (int sI = 0; sI < 4; ++sI) { if ((s0) + sI < nks) { const int kk = (ks0 + (s0) + sI) * 32 + 8 * fq; \
            _Pragma("unroll") for (int rt = 0; rt < 3; ++rt) af[sI][rt] = *(const bf16x8*)(t.A + (size_t)(rowb_ + 16 * rt + fr) * K + kk); \
            _Pragma("unroll") for (int ct = 0; ct < 4; ++ct) { const int brow = (MODE == TM_SWIGLU) ? 256 * (cgp_ >> 2) + (ct >> 1) * 128 + 32 * (cgp_ & 3) + 16 * (ct & 1) : 64 * cgp_ + 16 * ct; \
                bfr[sI][ct] = *(const bf16x8*)(t.Bt + (size_t)(brow + fr) * K + kk); } } } } while (0)
#define TG_MMA(s0) do { _Pragma("unroll") for (int sI = 0; sI < 4; ++sI) { if ((s0) + sI < nks) { _Pragma("unroll") for (int rt = 0; rt < 3; ++rt) _Pragma("unroll") for (int ct = 0; ct < 4; ++ct) \
            acc[rt][ct] = __builtin_amdgcn_mfma_f32_16x16x32_bf16(af[sI][rt], bfr[sI][ct], acc[rt][ct], 0, 0, 0); } } } while (0)
#pragma unroll 1
    for (int u = u0; u < nu; u += G) {
        const int rg = u & 7, cgp = u >> 3, rowb0 = TROW0 + 48 * rg;
        f32x4 acc[3][4];
#pragma unroll
        for (int rt = 0; rt < 3; ++rt)
#pragma unroll
            for (int ct = 0; ct < 4; ++ct) acc[rt][ct] = (f32x4){0.f, 0.f, 0.f, 0.f};
#pragma unroll 1
        for (int s0 = 0; s0 < nks; s0 += 4) { TG_LOAD(u, s0); TG_MMA(s0); }
#pragma unroll
        for (int rt = 0; rt < 3; ++rt)
#pragma unroll
            for (int ct = 0; ct < 4; ++ct) *(LAS f32x4*)(part + ((w * 12 + rt * 4 + ct) * 64 + lane) * 4) = acc[rt][ct];
        __syncthreads();
        if (w < 3) {
            const int rowb = rowb0 + 16 * w;
            f32x4 sum[4], tot[4];
#pragma unroll
            for (int ct = 0; ct < 4; ++ct) {
                f32x4 p[8];
#pragma unroll
                for (int q = 0; q < 8; ++q) p[q] = *(const LAS f32x4*)(part + ((q * 12 + w * 4 + ct) * 64 + lane) * 4);
                if (MODE == TM_BRANCH) {
                    const f32x4 pa = (p[0] + p[1]) + p[2], pb = (p[3] + p[4]) + p[5], pc = p[6] + p[7];
#pragma unroll
                    for (int i = 0; i < 4; ++i) { const bf16_t* gp = t.GT + (size_t)(rowb + 4 * fq + i) * 3072 + 64 * cgp + 16 * ct + fr; tot[ct][i] = pa[i] * bf2f(gp[0]) + pb[i] * bf2f(gp[1024]) + pc[i] * bf2f(gp[2048]); }
                } else sum[ct] = ((p[0] + p[1]) + (p[2] + p[3])) + ((p[4] + p[5]) + (p[6] + p[7]));
            }
            (void)sum; (void)tot;
            if (MODE == TM_SWIGLU) {
#pragma unroll
                for (int i = 0; i < 4; ++i) {
                    const int row = rowb + 4 * fq + i; const float rs = t.ss[row];
#pragma unroll
                    for (int c2 = 0; c2 < 2; ++c2) t.O1[(size_t)row * 2048 + 128 * (cgp >> 2) + 32 * (cgp & 3) + 16 * c2 + fr] = f2bf(fsilu(sum[c2][i] * rs) * (sum[2 + c2][i] * rs));
                }
            } else if (MODE == TM_RESID) {
#pragma unroll
                for (int i = 0; i < 4; ++i) {
                    const int row = rowb + 4 * fq + i; float sq = 0.f;
#pragma unroll
                    for (int ct = 0; ct < 4; ++ct) {
                        const size_t off = (size_t)row * 1024 + 64 * cgp + 16 * ct + fr;
                        const float x = t.X[off] + sum[ct][i] * t.scale; t.X[off] = x; t.O1[off] = f2bf(x); sq += x * x;
                    }
                    sq += __shfl_xor(sq, 1); sq += __shfl_xor(sq, 2); sq += __shfl_xor(sq, 4); sq += __shfl_xor(sq, 8);
                    if (fr == 0) t.ssn[(size_t)row * 16 + cgp] = sq;
                }
            } else if (MODE == TM_PROJ) {
                const bool gate = 64 * cgp >= PAW;
#pragma unroll
                for (int i = 0; i < 4; ++i) {
                    const int row = rowb + 4 * fq + i; const float rs = t.ss[row];
#pragma unroll
                    for (int ct = 0; ct < 4; ++ct) {
                        const int col = 64 * cgp + 16 * ct + fr; const float v = sum[ct][i] * rs;
                        if (gate) t.O2[(size_t)row * GTW + (col - PAW)] = f2bf(fsigmoid(v)); else t.O1[(size_t)row * PAW + col] = f2bf(v);
                    }
                }
            } else {
#pragma unroll
                for (int i = 0; i < 4; ++i)
#pragma unroll
                    for (int ct = 0; ct < 4; ++ct) t.O1[(size_t)(rowb + 4 * fq + i) * 1024 + 64 * cgp + 16 * ct + fr] = f2bf(tot[ct][i]);
            }
        }
        __syncthreads();
    }
#undef TG_LOAD
#undef TG_MMA
}

__device__ __forceinline__ void carry_item(CArgs* a, int l, int it, const float* LSUM, float* LCAR, const float* U, bf16_t* ST) {
    const int tid = tid_opaque();
    if (it < 2) {
        const int b = it, ch = tid; float h = 0.f;
#pragma unroll 1
        for (int n0 = 0; n0 < NT; n0 += 13) {
            float p[13], q[13];
#pragma unroll
            for (int k = 0; k < 13; ++k) { const size_t o = (size_t)(b * NT + n0 + k) * 512 + ch; p[k] = LSUM[o * 2]; q[k] = LSUM[o * 2 + 1]; }
#pragma unroll
            for (int k = 0; k < 13; ++k) { LCAR[(size_t)(b * NT + n0 + k) * 512 + ch] = h; h = p[k] * h + q[k]; }
        }
        a->out[O_PL + (l * 2 + b) * 512 + ch] = h;
    } else {
        const int eid = (it - 2) * 512 + tid; const int b = eid >> 15, hh = (eid >> 13) & 3, de = eid & 8191, e = de >> 6, d = de & 63;
        const float g128 = exp2f(128.0f * log2_gamma(hh)); float s = 0.f;
#pragma unroll 1
        for (int c0 = 0; c0 < NT; c0 += 13) {
            float u[13];
#pragma unroll
            for (int k = 0; k < 13; ++k) u[k] = U[(size_t)((b * NT + c0 + k) * 4 + hh) * 8192 + de];
#pragma unroll
            for (int k = 0; k < 13; ++k) { ST[(size_t)((b * NT + c0 + k) * 4 + hh) * 8192 + de] = f2bf(s); s = g128 * s + u[k]; }
        }
        a->out[O_PR + ((size_t)(l * 2 + b) * 4 + hh) * 8192 + d * 128 + e] = s;
    }
}

__device__ __forceinline__ void sample_item(CArgs* a, int l, int j, const bf16_t* PA, bf16_t* OB1, bf16_t* OB2, LAS unsigned char* lds) {
    const int tid = tid_opaque(), lane = tid & 63, w = tid >> 6; const int row = SROW0 + j;
    LAS float* q_s = (LAS float*)lds;
    LAS float* p_s = q_s + 512;
    LAS float* rq_s = p_s + 8 * 132;
    LAS float* rk_s = rq_s + 256;
    LAS float* red_s = rk_s + 256;
    const float* ck = a->in[I_CK] + (size_t)(l * 128 + j) * 16384; const float* cv = a->in[I_CV] + (size_t)(l * 128 + j) * 16384;
    const bf16_t* pr = PA + (size_t)row * PAW;
    q_s[tid] = bf2f(pr[C_QS + tid]);
    if (tid < 128) {
        const int hh = tid >> 5, i = tid & 31; float s, co; sincos_rev(8192.0f * rope_inv(i), s, co);
        const float q1 = bf2f(pr[C_QR + hh * 64 + i]), q2 = bf2f(pr[C_QR + hh * 64 + i + 32]), k1 = bf2f(pr[C_KR + hh * 64 + i]), k2 = bf2f(pr[C_KR + hh * 64 + i + 32]);
        rq_s[hh * 64 + i] = q1 * co - q2 * s; rq_s[hh * 64 + i + 32] = q1 * s + q2 * co;
        rk_s[hh * 64 + i] = (k1 * co - k2 * s) * 0.125f; rk_s[hh * 64 + i + 32] = (k1 * s + k2 * co) * 0.125f;
    }
    {
        float* ok = a->out + O_SK + (size_t)(l * 128 + j) * 16384; float* ov = a->out + O_SV + (size_t)(l * 128 + j) * 16384;
        f32x4 ckv[8], cvv[8];
#pragma unroll
        for (int k = 0; k < 8; ++k) { const int i = tid + k * NTHR; if (i < 127 * 32) { ckv[k] = *((const f32x4*)ck + 32 + i); cvv[k] = *((const f32x4*)cv + 32 + i); } }
#pragma unroll
        for (int k = 0; k < 8; ++k) { const int i = tid + k * NTHR; if (i < 127 * 32) { *((f32x4*)ok + i) = ckv[k]; *((f32x4*)ov + i) = cvv[k]; } }
        if (tid < 128) { ok[127 * 128 + tid] = bf2f(pr[C_KS + tid]); ov[127 * 128 + tid] = bf2f(pr[C_VS + tid]); }
    }
    __syncthreads();
    {
        const int h = w, kvh = h >> 2; const float sink = a->in[I_SINK][l * 8 + h];
        float sc[3]; sc[2] = -INFINITY;
#pragma unroll
        for (int t = 0; t < 2; ++t) {
            const int s = lane + 64 * t; const f32x4* kp = (const f32x4*)(ck + (size_t)s * 128 + kvh * 64); float d = 0.f;
#pragma unroll
            for (int q = 0; q < 16; ++q) { const f32x4 k = kp[q]; const f32x4 qq = *(const LAS f32x4*)(q_s + h * 64 + q * 4); d += (k[0] * qq[0] + k[1] * qq[1]) + (k[2] * qq[2] + k[3] * qq[3]); }
            sc[t] = (s == 0) ? -INFINITY : d * 0.125f;
        }
        {
            sc[2] = wave_sum(bf2f(pr[C_KS + kvh * 64 + lane]) * q_s[h * 64 + lane]) * 0.125f;
        }
        float mx = fmaxf(fmaxf(sc[0], sc[1]), sc[2]);
#pragma unroll
        for (int o = 1; o < 64; o <<= 1) mx = fmaxf(mx, __shfl_xor(mx, o));
        const float mm = fmaxf(mx, sink);
        const float e0 = __expf(sc[0] - mm), e1 = __expf(sc[1] - mm), e2 = __expf(sc[2] - mm);
        const float sum = wave_sum(e0 + e1) + e2; const float inv = 1.0f / (sum + __expf(sink - mm));
        p_s[h * 132 + lane] = e0 * inv; p_s[h * 132 + 64 + lane] = e1 * inv; if (lane == 0) p_s[h * 132 + 128] = e2 * inv;
        LDSW();
        float o = p_s[h * 132 + 128] * bf2f(pr[C_VS + kvh * 64 + lane]);
#pragma unroll 32
        for (int s = 0; s < 128; ++s) o += p_s[h * 132 + s] * cv[(size_t)s * 128 + kvh * 64 + lane];
        OB1[(size_t)row * OBS + h * 64 + lane] = f2bf(o);
    }
    {
        const int hh = tid >> 7, e = tid & 127; const float gam = 1.0f - exp2f(-5.0f - (float)hh);
        const float* S = a->in[I_SRET] + ((size_t)(l * 128 + j) * 4 + hh) * 8192; float* So = a->out + O_SR + ((size_t)(l * 128 + j) * 4 + hh) * 8192;
        const float v = bf2f(pr[C_VR + hh * 128 + e]); float acc = 0.f, qk = 0.f;
#pragma unroll 32
        for (int d = 0; d < 64; ++d) { const float s = S[d * 128 + e]; const float q = rq_s[hh * 64 + d], k = rk_s[hh * 64 + d]; acc += q * s; qk += q * k; So[d * 128 + e] = gam * s + k * v; }
        const float o = qk * v + gam * acc;
        float sm = wave_sum(o); if (lane == 0) red_s[w * 2] = sm;
        __syncthreads();
        const float mu = (red_s[(w & ~1) * 2] + red_s[(w | 1) * 2]) * (1.0f / 128.0f); const float dv = o - mu;
        float vs = wave_sum(dv * dv); if (lane == 0) red_s[w * 2 + 1] = vs;
        __syncthreads();
        const float var = (red_s[(w & ~1) * 2 + 1] + red_s[(w | 1) * 2 + 1]) * (1.0f / 128.0f);
        const float y = dv * (1.0f / sqrtf(var + 1e-5f)) * a->in[I_RETN][l * 512 + hh * 128 + e] * fsilu(bf2f(pr[C_GR + hh * 128 + e]));
        OB2[(size_t)row * OBS + hh * 128 + e] = f2bf(y);
    }
    __syncthreads();
}

#define GAS __attribute__((address_space(1)))
#define XB_TMO      128
#define XB_XCNT(j)  (256  + 64 * (j))
#define XB_XSUB(j)  (1280 + 64 * (j))
#define XB_XGEN(j)  (2304 + 64 * (j))
#define XB_TOP      3328
#define XB_TOPGEN   3392
#define XCD_BAR_WORDS 3456
#define XB_SPIN_CAP (1u << 18)

__device__ __forceinline__ unsigned xb_ld(unsigned* p)              { return __hip_atomic_load(p, __ATOMIC_RELAXED, __HIP_MEMORY_SCOPE_AGENT); }
__device__ __forceinline__ unsigned xb_add(unsigned* p, unsigned v) { return __hip_atomic_fetch_add(p, v, __ATOMIC_RELAXED, __HIP_MEMORY_SCOPE_AGENT); }
__device__ __forceinline__ unsigned xb_xcc_id() { return (unsigned)__builtin_amdgcn_s_getreg((3 << 11) | 20) & 0xFu; }
#define XB_SPIN(cond, bar) do { unsigned _sp = 0; while (cond) { __builtin_amdgcn_s_sleep(1); \
    if ((++_sp & 255u) == 0u) { if (xb_ld(&(bar)[XB_TMO])) break; if (_sp > XB_SPIN_CAP) { atomicAdd(&(bar)[XB_TMO], 1u); break; } } } } while (0)

struct XcdBarrier {
    unsigned* bar; unsigned x;
    volatile LAS unsigned* st;
};

__device__ __forceinline__ XcdBarrier xcd_barrier_post(unsigned* bar, volatile LAS unsigned* st) {
    XcdBarrier b; b.bar = bar; b.x = xb_xcc_id(); b.st = st;
    if (threadIdx.x == 0) (void)xb_add(&bar[XB_XCNT(b.x)], 1u);
    return b;
}
__device__ __forceinline__ void xcd_barrier_complete(unsigned* bar, unsigned x, unsigned& nloc, unsigned& nx) {
    const unsigned G = gridDim.x * gridDim.y * gridDim.z;
    unsigned sum, cnt, mine, sp = 0u;
    for (;;) {
        sum = 0u; cnt = 0u; mine = 0u;
#pragma unroll
        for (unsigned j = 0; j < 16; ++j) { const unsigned c = xb_ld(&bar[XB_XCNT(j)]); sum += c; cnt += (c > 0u) ? 1u : 0u; mine = (j == x) ? c : mine; }
        if (sum == G) break;
        __builtin_amdgcn_s_sleep(1);
        if ((++sp & 255u) == 0u) { if (xb_ld(&bar[XB_TMO])) break; if (sp > XB_SPIN_CAP) { atomicAdd(&bar[XB_TMO], 1u); break; } }
    }
    nloc = mine > 0u ? mine : 1u; nx = cnt > 0u ? cnt : 1u;
}

__device__ __forceinline__ void xcd_barrier(const XcdBarrier& b) {
    asm volatile("s_waitcnt vmcnt(0)" ::: "memory");
    __syncthreads();
    if (threadIdx.x == 0) {
        unsigned* bar = b.bar;
        __builtin_amdgcn_s_waitcnt(0);
        unsigned nloc = b.st[0], nx = b.st[1];
        if (nloc == 0u) { xcd_barrier_complete(bar, b.x, nloc, nx); b.st[0] = nloc; b.st[1] = nx; }
        const unsigned old = xb_add(&bar[XB_XSUB(b.x)], 1u);
        const unsigned gen = old / nloc;
        if (old + 1u == (gen + 1u) * nloc) {
            __builtin_amdgcn_fence(__ATOMIC_RELEASE, "agent");
            asm volatile("s_waitcnt vmcnt(0)" ::: "memory");
            const unsigned og = xb_add(&bar[XB_TOP], 1u);
            const unsigned tg = og / nx;
            if (og + 1u == (tg + 1u) * nx) xb_add(&bar[XB_TOPGEN], 1u);
            else XB_SPIN(xb_ld(&bar[XB_TOPGEN]) == tg, bar);
            __builtin_amdgcn_fence(__ATOMIC_ACQUIRE, "agent");
            xb_add(&bar[XB_XGEN(b.x)], 1u);
            asm volatile("s_waitcnt vmcnt(0)" ::: "memory");
        } else {
            XB_SPIN(xb_ld(&bar[XB_XGEN(b.x)]) == gen, bar);
            __builtin_amdgcn_fence(__ATOMIC_ACQUIRE, "agent");
            asm volatile("s_waitcnt vmcnt(0)" ::: "memory");
        }
    }
    __syncthreads();
}


template <class Sched> __device__ __forceinline__ void rs_prestep(const Sched& S, const float* ss, float* rs) {
    const int tid = tid_opaque();
    int pmv[8];
#pragma unroll
    for (int i = 0; i < 8; ++i) { pg8::Unit u; pmv[i] = S.next(i, u) ? u.pm : -1; }
    const int r0 = (tid < 256) ? tid : TROW0 + (tid - 256);
    float v[9];
#pragma unroll
    for (int i = 0; i < 8; ++i) { v[i] = 0.f; if (tid < 256 && pmv[i] >= 0) v[i] = pg8::row_ss(ss, pmv[i] * 256 + tid); }
    v[8] = 0.f; if (tid >= 256) v[8] = pg8::row_ss(ss, r0);
    float v9 = 0.f; if (tid < 128) v9 = pg8::row_ss(ss, TROW0 + 256 + tid);
#pragma unroll
    for (int i = 0; i < 8; ++i) if (tid < 256 && pmv[i] >= 0) rs[pmv[i] * 256 + tid] = __builtin_amdgcn_rsqf(v[i] * (1.0f / 1024.0f) + 1e-6f);
    if (tid >= 256) rs[r0] = __builtin_amdgcn_rsqf(v[8] * (1.0f / 1024.0f) + 1e-6f);
    if (tid < 128) rs[TROW0 + 256 + tid] = __builtin_amdgcn_rsqf(v9 * (1.0f / 1024.0f) + 1e-6f);
    asm volatile("s_waitcnt vmcnt(0)" ::: "memory");
    __syncthreads();
}

#define R_GU 1
#define R_WIN 1
#define R_MIX1 1
#define R_CARRY 1
#define R_MIX2 1
#define R_XSYNC 0
__global__ void __launch_bounds__(NTHR, 2) mk_fwd(Args a_unused) {
    extern __shared__ __attribute__((aligned(16))) unsigned char lds_raw[];
    LAS unsigned char* lds = (LAS unsigned char*)lds_raw;
    cg::grid_group grid = cg::this_grid();
    CArgs* kp0 = (CArgs*)__builtin_amdgcn_kernarg_segment_ptr();
    if (threadIdx.x < 64) ((LAS unsigned*)(lds + 131072))[threadIdx.x] = 0u;
    __syncthreads();
    XcdBarrier xbar; xbar.bar = (unsigned*)(kp0->ws + WS_BAR); xbar.x = 0; xbar.st = (volatile LAS unsigned*)(lds + 131072);
    const int lo = kp0->ph_lo, hi = kp0->ph_hi; int ph = 0;
#define PH_PTRS int tid = threadIdx.x; asm volatile("" : "+v"(tid)); const int lane = tid & 63, wave = __builtin_amdgcn_readfirstlane(tid >> 6); \
    int bid_ = blockIdx.x; asm volatile("" : "+s"(bid_)); const int G = gridDim.x, bid = bid_, gw = bid * 8 + wave, ngw = G * 8; (void)lane; (void)gw; (void)ngw; CArgs* a = kp0; asm volatile("" : "+s"(a)); unsigned char* ws = a->ws; \
    float* SS = (float*)(ws + WS_SS16); float* LSUM = (float*)(ws + WS_LSUM); float* LCAR = (float*)(ws + WS_LCAR); \
    float* X = (float*)(ws + WS_X); bf16_t* XB = (bf16_t*)(ws + WS_XB); bf16_t* PA = (bf16_t*)(ws + WS_PA); bf16_t* HB = PA; bf16_t* MB = (bf16_t*)(ws + WS_PA); \
    bf16_t* GT = (bf16_t*)(ws + WS_GT); bf16_t* OB = (bf16_t*)(ws + WS_OB); float* U = (float*)(ws + WS_U); float* AG = (float*)(ws + WS_XB); float* BG = (float*)(ws + WS_BG); (void)AG; (void)BG; bf16_t* ST = (bf16_t*)(ws + WS_ST); \
    unsigned char* wb = ws + WS_W0 + (size_t)(l & 1) * WSZ; \
    float* RS = (float*)(ws + WS_RS); const float* rs0 = RS + (size_t)(3 * l) * MP; float* rs1 = RS + (size_t)(3 * l + 1) * MP; float* rs2 = RS + (size_t)(3 * l + 2) * MP; float* rs3 = RS + (size_t)(3 * l + 3) * MP; (void)rs0; (void)rs1; (void)rs2; (void)rs3; \
    const float* ss0 = SS + (size_t)(3 * l) * MP * 16; float* ss1 = SS + (size_t)(3 * l + 1) * MP * 16; float* ss2 = SS + (size_t)(3 * l + 2) * MP * 16; float* ss3 = SS + (size_t)(3 * l + 3) * MP * 16; \
    (void)SS; (void)LSUM; (void)LCAR; (void)X; (void)XB; (void)PA; (void)HB; (void)MB; (void)GT; (void)OB; (void)U; (void)ST; (void)wb; (void)ss0; (void)ss1; (void)ss2; (void)ss3;
#define PH_BEGIN(n) if (ph >= lo && ph < hi) { PH_PTRS for (int rep_ = 0; rep_ < (n); ++rep_) {
#define PH_END if (ph + 1 < hi) { if (ph == 0) { asm volatile("s_waitcnt vmcnt(0)" ::: "memory"); grid.sync(); xbar = xcd_barrier_post((unsigned*)(kp0->ws + WS_BAR), (volatile LAS unsigned*)(lds + 131072)); } else xcd_barrier(xbar); } } } ++ph;

    { const int l = 0;
    PH_BEGIN(1)
        if (bid == 0) { for (int i = tid; i < XCD_BAR_WORDS; i += NTHR) ((unsigned*)(ws + WS_BAR))[i] = 0u; }
        init_rows(a, X, XB, SS, RS, OB, gw, ngw, lane);
        convert_layer(a, 0, ws + WS_W0, lds, gw, ngw, wave, lane);
    PH_END
    }

#pragma unroll 1
    for (int l = 0; l < DEPTH; ++l) {
        PH_BEGIN(R_GU)
            pg8::Gemm g{XB, (const bf16_t*)(wb + W_GU1), TROW0, 4096, DM, 1, 0}; pg8::StaticOrder S; S.init(TROW0, 4096, G, bid);
            rs_prestep(S, ss0, RS + (size_t)(3 * l) * MP);
            pg8::EpiSwiGLU E{HB, rs0}; pg8::gemm_phase<pg8::EpiSwiGLU, pg8::StaticOrder, true, true>(lds, g, S, E);
            { const TailArgs ta{XB, (const bf16_t*)(wb + W_GU1), DM, 4096, HB, nullptr, nullptr, rs0, nullptr, nullptr, 0.f}; tail_gemm<TM_SWIGLU>(ta, bid, G, lds); }
        PH_END
        PH_BEGIN(1)
            pg8::Gemm g{HB, (const bf16_t*)(wb + W_D1), TROW0, DM, FF, 1, 0}; pg8::StaticOrder S; S.init(TROW0, DM, G, bid);
            pg8::EpiResid E{X, XB, ss1, 0.5f}; pg8::gemm_phase<pg8::EpiResid, pg8::StaticOrder, true, true>(lds, g, S, E);
            { const TailArgs ta{HB, (const bf16_t*)(wb + W_D1), FF, DM, XB, nullptr, X, nullptr, ss1, nullptr, 0.5f}; tail_gemm<TM_RESID>(ta, bid, G, lds); }
        PH_END
        PH_BEGIN(R_WIN)
            pg8::Gemm g{XB, (const bf16_t*)(wb + W_IN), TROW0, NIN, DM, 1, 0}; pg8::StaticOrder S; S.init(TROW0, NIN, G, bid);
            rs_prestep(S, ss1, rs1);
            pg8::EpiProj E{PA, GT, rs1}; pg8::gemm_phase<pg8::EpiProj, pg8::StaticOrder, true, true>(lds, g, S, E);
            { const TailArgs ta{XB, (const bf16_t*)(wb + W_IN), DM, NIN, PA, GT, nullptr, rs1, nullptr, nullptr, 0.f}; if (G == 256) { if (bid >= 64) tail_gemm<TM_PROJ>(ta, bid - 64, 192, lds); } else tail_gemm<TM_PROJ>(ta, bid, G, lds); }
        PH_END
        PH_BEGIN(R_MIX1)
            for (int it = bid; it < 1048 + 520 + 260; it += G) {
                if (it < 1048) lru1_item(a, l, it >> 3, it & 7, PA, OB, LSUM, AG, BG, lds);
                else if (it < 1048 + 520) ret_u_item(it - 1048, PA, U, lds);
                else swa_item(a, l, it - (1048 + 520), PA, OB + 512, lds);
            }
        PH_END
        PH_BEGIN(R_CARRY)
            for (int it = bid; it < 130; it += G) carry_item(a, l, it, LSUM, LCAR, U, ST);
            if (G == 256) { if (bid >= 128) sample_item(a, l, bid - 128, PA, OB + 512, OB + 1024, lds); } else { for (int it = bid; it < 128; it += G) sample_item(a, l, it, PA, OB + 512, OB + 1024, lds); }
            if (l + 1 < DEPTH) {
                __syncthreads();
                const int nsh = (G == 256) ? (bid < 128 ? 3 : 1) : 1, sh0 = (G == 256) ? (bid < 128 ? bid * 3 : 384 + (bid - 128)) : bid, nshares = (G == 256) ? 512 : G;
#pragma unroll 1
                for (int v = 0; v < nsh; ++v) convert_layer(a, l + 1, ws + WS_W0 + (size_t)((l + 1) & 1) * WSZ, lds, (sh0 + v) * 8 + wave, nshares * 8, wave, lane);
            }
        PH_END
        PH_BEGIN(R_MIX2)
            for (int it = bid; it < 520 + 1040; it += G) {
                if (it < 520) ret_out_item(a, l, it, PA, ST, OB + 1024, lds);
                else { const int q = it - 520; lru2_item(q >> 3, q & 7, PA, OB, LCAR, AG, BG, lds); }
            }
        PH_END
        PH_BEGIN(1)
            pg8::Gemm g{OB, (const bf16_t*)(wb + W_BR), TROW0, DM, OBS, 1, 0}; pg8::StaticOrder S; S.init(TROW0, DM, G, bid);
            pg8::EpiBranch E{MB, GT}; pg8::gemm_phase<pg8::EpiBranch, pg8::StaticOrder, true, true>(lds, g, S, E);
            { const TailArgs ta{OB, (const bf16_t*)(wb + W_BR), OBS, DM, MB, nullptr, nullptr, nullptr, nullptr, GT, 0.f}; tail_gemm<TM_BRANCH>(ta, bid, G, lds); }
        PH_END
        PH_BEGIN(1)
            pg8::Gemm g{MB, (const bf16_t*)(wb + W_OUT), TROW0, DM, DM, 1, 0}; pg8::StaticOrder S; S.init(TROW0, DM, G, bid);
            pg8::EpiResid E{X, XB, ss2, 1.0f}; pg8::gemm_phase<pg8::EpiResid, pg8::StaticOrder, true, true>(lds, g, S, E);
            { const TailArgs ta{MB, (const bf16_t*)(wb + W_OUT), DM, DM, XB, nullptr, X, nullptr, ss2, nullptr, 1.0f}; tail_gemm<TM_RESID>(ta, bid, G, lds); }
        PH_END
        PH_BEGIN(1)
            for (int xs_ = 0; xs_ < R_XSYNC; ++xs_) grid.sync();
            pg8::Gemm g{XB, (const bf16_t*)(wb + W_GU2), TROW0, 4096, DM, 1, 0}; pg8::StaticOrder S; S.init(TROW0, 4096, G, bid);
            rs_prestep(S, ss2, rs2);
            pg8::EpiSwiGLU E{HB, rs2}; pg8::gemm_phase<pg8::EpiSwiGLU, pg8::StaticOrder, true, true>(lds, g, S, E);
            { const TailArgs ta{XB, (const bf16_t*)(wb + W_GU2), DM, 4096, HB, nullptr, nullptr, rs2, nullptr, nullptr, 0.f}; tail_gemm<TM_SWIGLU>(ta, bid, G, lds); }
        PH_END
        PH_BEGIN(1)
            pg8::Gemm g{HB, (const bf16_t*)(wb + W_D2), TROW0, DM, FF, 1, 0}; pg8::StaticOrder S; S.init(TROW0, DM, G, bid);
            pg8::EpiResid E{X, XB, ss3, 0.5f}; pg8::gemm_phase<pg8::EpiResid, pg8::StaticOrder, true, true>(lds, g, S, E);
            { const TailArgs ta{HB, (const bf16_t*)(wb + W_D2), FF, DM, XB, nullptr, X, nullptr, ss3, nullptr, 0.5f}; tail_gemm<TM_RESID>(ta, bid, G, lds); }
        PH_END
    }
    { const int l = 0;
    PH_BEGIN(1)
        const float* ssf = SS + (size_t)12 * MP * 16; const float* gf = a->in[I_FINN];
        for (int r = gw; r < MREAL; r += ngw) {
            float* dst = nullptr;
            if (r < 2 * BROWS) { const int b = r / BROWS, pr = r % BROWS; if (pr >= PADR + 16) dst = a->out + O_YP + ((size_t)b * 8192 + (pr - PADR - 16)) * DM; }
            else dst = a->out + O_YS + (size_t)(r - SROW0) * DM;
            if (dst) {
                const float rs = __builtin_amdgcn_rsqf(pg8::row_ss(ssf, r) * (1.0f / 1024.0f) + 1e-6f);
#pragma unroll
                for (int j = 0; j < 4; ++j) { const f32x4 v = *((const f32x4*)(X + (size_t)r * DM) + lane + 64 * j); const f32x4 gg = *((const f32x4*)gf + lane + 64 * j); *((f32x4*)dst + lane + 64 * j) = v * rs * gg; }
            }
        }
    PH_END
    }
#undef PH_BEGIN
#undef PH_END
}
constexpr int NPHASES = 2 + 10 * DEPTH;

#ifndef MK_MULTI
#define MK_MULTI 0
#endif
extern "C" void kernel_launch(void* const* d_in, const int* in_sizes, int n_in, void* d_out, int out_size, void* d_ws, size_t ws_size, hipStream_t stream) {
    static int grid = 0;
    if (grid == 0) {
        if (n_in != 30 || ws_size < WS_END) { fprintf(stderr, "kernel_launch: unexpected inputs (n_in %d, ws %zu < %zu)\n", n_in, ws_size, (size_t)WS_END); grid = -1; return; }
        int dev = 0, cus = 0, per_cu = 0;
        (void)hipGetDevice(&dev); (void)hipDeviceGetAttribute(&cus, hipDeviceAttributeMultiprocessorCount, dev);
        if (hipFuncSetAttribute((const void*)mk_fwd, hipFuncAttributeMaxDynamicSharedMemorySize, LDS_BYTES) != hipSuccess) { fprintf(stderr, "kernel_launch: hipFuncSetAttribute failed\n"); grid = -1; return; }
        if (hipOccupancyMaxActiveBlocksPerMultiprocessor(&per_cu, (const void*)mk_fwd, NTHR, LDS_BYTES) != hipSuccess || per_cu < 1) { fprintf(stderr, "kernel_launch: occupancy query says %d\n", per_cu); per_cu = 1; }
        (void)hipGetLastError();
        grid = cus * 1;
        if (grid <= 0) grid = 256;
    }
    if (grid < 0) return;
    Args a{};
    for (int i = 0; i < 30; ++i) a.in[i] = (const float*)d_in[i];
    a.out = (float*)d_out; a.ws = (unsigned char*)d_ws;
#if MK_MULTI
    for (int p = 0; p < NPHASES; ++p) { a.ph_lo = p; a.ph_hi = p + 1; hipLaunchKernelGGL(mk_fwd, dim3(grid), dim3(NTHR), LDS_BYTES, stream, a); }
#else
    a.ph_lo = 0; a.ph_hi = NPHASES;
    void* args[] = {&a};
    hipError_t e = hipLaunchCooperativeKernel((const void*)mk_fwd, dim3(grid), dim3(NTHR), args, LDS_BYTES, stream);
    if (e != hipSuccess) fprintf(stderr, "cooperative launch failed: %s (grid %d)\n", hipGetErrorString(e), grid);
#endif
}
```

```cpp
#include <hip/hip_runtime.h>
#include <hip/hip_cooperative_groups.h>
#include <cstdio>
#include <cstdint>
#include <cmath>
namespace cg = cooperative_groups;

namespace pg8 {
#define PG8_LAS __attribute__((address_space(3)))
typedef unsigned short bf16_t;
typedef short bf16x8 __attribute__((ext_vector_type(8)));
typedef float f32x4 __attribute__((ext_vector_type(4)));
typedef unsigned u32x4 __attribute__((ext_vector_type(4)));
constexpr int BM = 256, BK = 64, HALF = 128, HTB = HALF * BK * 2  , STAGE_BYTES = 8 * HTB, NXCD = 8, WGM = 8;

__host__ __device__ __forceinline__ int lds_byte(int r, int c) { const int st = (r >> 4) * 2 + (c >> 5), rr = r & 15, cc = c & 31, ob = rr * 64 + cc * 2; return st * 1024 + (ob ^ (((ob >> 9) & 1) << 5)); }
__host__ __device__ __forceinline__ void stage_rc(int b, int& R, int& C) { const int st = b / 1024, sb = b % 1024, swz = sb ^ (((sb >> 9) & 1) << 5); R = (st >> 1) * 16 + swz / 64; C = (st & 1) * 32 + (swz % 64) / 2; }
__host__ __device__ __forceinline__ int perm32(int rho) { const int n = rho >> 4, i = rho & 15; return 8 * (i >> 2) + 4 * n + (i & 3); }

struct Unit { int pm, pn; };
struct Gemm { const bf16_t* A; const bf16_t* Bt; int M, N, K; int agdiv; size_t agstride; };

struct StaticOrder {
    int nM, nN, nwg, G, c;
    __host__ __device__ void init(int M, int N, int G_, int c_) { nM = M / BM; nN = N / BM; nwg = nM * nN; G = G_; c = c_; }
    __host__ __device__ bool next(int i, Unit& u) const {
        const long L = (long)i * G + c; if (L >= nwg) return false;
        int wgid = (int)L; { const int q = nwg / NXCD, r = nwg % NXCD, xcd = wgid % NXCD, off = wgid / NXCD; wgid = (xcd < r ? xcd * (q + 1) : r * (q + 1) + (xcd - r) * q) + off; }
        const int nig = WGM * nN, gid = wgid / nig, fm = gid * WGM, gsz = (nM - fm) < WGM ? (nM - fm) : WGM;
        u.pm = fm + ((wgid % nig) % gsz); u.pn = (wgid % nig) / gsz; return true;
    }
    __device__ __forceinline__ void a_ready(const Unit&) const {}
    __device__ __forceinline__ void done(const Unit&) const {}
};

__device__ __forceinline__ unsigned cvt_pk_bf16(float lo, float hi) { unsigned r; asm volatile("v_cvt_pk_bf16_f32 %0, %1, %2" : "=v"(r) : "v"(lo), "v"(hi)); return r; }
typedef unsigned u32x2 __attribute__((ext_vector_type(2)));
__device__ __forceinline__ float fsigmoid(float x) { return __builtin_amdgcn_rcpf(1.0f + __expf(-x)); }
__device__ __forceinline__ float fsilu(float x) { return x * fsigmoid(x); }
__device__ __forceinline__ float bflo(unsigned w) { return __uint_as_float(w << 16); }
__device__ __forceinline__ float bfhi(unsigned w) { return __uint_as_float(w & 0xffff0000u); }

__device__ __forceinline__ float row_ss(const float* ss, int row) {
    const f32x4* p = (const f32x4*)(ss + (size_t)row * 16); const f32x4 a = p[0], b = p[1], c = p[2], d = p[3];
    return (((a[0] + a[1]) + (a[2] + a[3])) + ((b[0] + b[1]) + (b[2] + b[3]))) + (((c[0] + c[1]) + (c[2] + c[3])) + ((d[0] + d[1]) + (d[2] + d[3])));
}
struct EpiSwiGLU {
    static constexpr bool PERM = true, AFTER_DRAIN = false, HAS_MID = false, HAS_PRE = true;
    bf16_t* H; const float* ss;
    __device__ __forceinline__ void pre(float (&rsv)[8], const Unit& u, int wr, int fr) const {
#pragma unroll
        for (int q = 0; q < 8; ++q) rsv[q] = ss[u.pm * BM + wr * 64 + fr + (q >> 2) * HALF + (q & 3) * 16];
    }
    __device__ __forceinline__ void operator()(const f32x4 (&acc)[2][2][4][2], const Unit& u, int wr, int wc, int fr, int fq, const float (&rsv)[8]) const {
        const int row0 = u.pm * BM + wr * 64 + fr, col0 = u.pn * 128 + wc * 32 + 8 * fq;
#pragma unroll
        for (int ai = 0; ai < 2; ++ai)
#pragma unroll
            for (int m = 0; m < 4; ++m) {
                const int row = row0 + ai * HALF + m * 16;
                const float rs = rsv[ai * 4 + m];
                const f32x4 g0 = acc[ai][0][m][0] * rs, g1 = acc[ai][0][m][1] * rs, u0 = acc[ai][1][m][0] * rs, u1 = acc[ai][1][m][1] * rs;
                u32x4 w;
                w.x = cvt_pk_bf16(fsilu(g0[0]) * u0[0], fsilu(g0[1]) * u0[1]); w.y = cvt_pk_bf16(fsilu(g0[2]) * u0[2], fsilu(g0[3]) * u0[3]);
                w.z = cvt_pk_bf16(fsilu(g1[0]) * u1[0], fsilu(g1[1]) * u1[1]); w.w = cvt_pk_bf16(fsilu(g1[2]) * u1[2], fsilu(g1[3]) * u1[3]);
                *(u32x4*)(H + (size_t)row * 2048 + col0) = w;
            }
    }
};
struct EpiResid {
    static constexpr bool PERM = false, AFTER_DRAIN = false, HAS_MID = false, HAS_PRE = false;
    float* X; bf16_t* XB; float* ssn; float scale;
    __device__ __forceinline__ void operator()(const f32x4 (&acc)[2][2][4][2], const Unit& u, int wr, int wc, int fr, int fq, const float (&)[8]) const {
        const int row0 = u.pm * BM + wr * 64 + fr, col0 = u.pn * BM + wc * 32 + 4 * fq;
#pragma unroll
        for (int ai = 0; ai < 2; ++ai)
#pragma unroll
            for (int m = 0; m < 4; ++m) {
                const int row = row0 + ai * HALF + m * 16; float sq = 0.f;
#pragma unroll
                for (int bj = 0; bj < 2; ++bj)
#pragma unroll
                    for (int n = 0; n < 2; ++n) {
                        const size_t off = (size_t)row * 1024 + col0 + bj * HALF + n * 16;
                        f32x4 x = *(const f32x4*)(X + off); x = x + acc[ai][bj][m][n] * scale; *(f32x4*)(X + off) = x;
                        u32x2 w; w.x = cvt_pk_bf16(x[0], x[1]); w.y = cvt_pk_bf16(x[2], x[3]); *(u32x2*)(XB + off) = w;
                        sq += (x[0] * x[0] + x[1] * x[1]) + (x[2] * x[2] + x[3] * x[3]);
                    }
                sq += __shfl_xor(sq, 16); sq += __shfl_xor(sq, 32);
                if (fq == 0) ssn[(size_t)row * 16 + u.pn * 4 + wc] = sq;
            }
    }
};
struct EpiProj {
    static constexpr bool PERM = true, AFTER_DRAIN = false, HAS_MID = false, HAS_PRE = true;
    bf16_t* PA; bf16_t* GT; const float* ss;
    __device__ __forceinline__ void pre(float (&rsv)[8], const Unit& u, int wr, int fr) const {
#pragma unroll
        for (int q = 0; q < 8; ++q) rsv[q] = ss[u.pm * BM + wr * 64 + fr + (q >> 2) * HALF + (q & 3) * 16];
    }
    __device__ __forceinline__ void operator()(const f32x4 (&acc)[2][2][4][2], const Unit& u, int wr, int wc, int fr, int fq, const float (&rsv)[8]) const {
        const int row0 = u.pm * BM + wr * 64 + fr; const bool gate = u.pn >= 13;
        const int col0 = (gate ? (u.pn - 13) : u.pn) * BM + wc * 32 + 8 * fq;
        bf16_t* base = gate ? GT : PA; const int ld = gate ? 3072 : 3328;
#pragma unroll
        for (int ai = 0; ai < 2; ++ai)
#pragma unroll
            for (int m = 0; m < 4; ++m) {
                const int row = row0 + ai * HALF + m * 16;
                const float rs = rsv[ai * 4 + m];
#pragma unroll
                for (int bj = 0; bj < 2; ++bj) {
                    f32x4 v0 = acc[ai][bj][m][0] * rs, v1 = acc[ai][bj][m][1] * rs;
                    if (gate) {
#pragma unroll
                        for (int k = 0; k < 4; ++k) { v0[k] = fsigmoid(v0[k]); v1[k] = fsigmoid(v1[k]); }
                    }
                    u32x4 w; w.x = cvt_pk_bf16(v0[0], v0[1]); w.y = cvt_pk_bf16(v0[2], v0[3]); w.z = cvt_pk_bf16(v1[0], v1[1]); w.w = cvt_pk_bf16(v1[2], v1[3]);
                    *(u32x4*)(base + (size_t)row * ld + col0 + bj * HALF) = w;
                }
            }
    }
};
struct EpiBranch {
    static constexpr bool PERM = true, AFTER_DRAIN = false, HAS_MID = true, HAS_PRE = false;
    bf16_t* MB; const bf16_t* GT;
    __device__ __forceinline__ void mid(f32x4 (&acc)[2][2][4][2], const Unit& u, int seg, int wr, int wc, int fr, int fq) const {
        int fr_ = fr; asm volatile("" : "+v"(fr_));
        const int row0 = u.pm * BM + wr * 64 + fr_, col0 = u.pn * BM + wc * 32 + 8 * fq;
#pragma unroll
        for (int ai = 0; ai < 2; ++ai)
#pragma unroll
            for (int m = 0; m < 4; ++m) {
                const int row = row0 + ai * HALF + m * 16;
#pragma unroll
                for (int bj = 0; bj < 2; ++bj) {
                    const bf16_t* gp = GT + (size_t)row * 3072 + (seg - 1) * 1024 + col0 + bj * HALF;
                    const u32x4 g0 = *(const u32x4*)gp, g1 = *(const u32x4*)(gp + 1024);
                    f32x4 r0, r1;
                    r0[0] = bflo(g0.x) * __builtin_amdgcn_rcpf(fmaxf(bflo(g1.x), 1e-30f)); r0[1] = bfhi(g0.x) * __builtin_amdgcn_rcpf(fmaxf(bfhi(g1.x), 1e-30f));
                    r0[2] = bflo(g0.y) * __builtin_amdgcn_rcpf(fmaxf(bflo(g1.y), 1e-30f)); r0[3] = bfhi(g0.y) * __builtin_amdgcn_rcpf(fmaxf(bfhi(g1.y), 1e-30f));
                    r1[0] = bflo(g0.z) * __builtin_amdgcn_rcpf(fmaxf(bflo(g1.z), 1e-30f)); r1[1] = bfhi(g0.z) * __builtin_amdgcn_rcpf(fmaxf(bfhi(g1.z), 1e-30f));
                    r1[2] = bflo(g0.w) * __builtin_amdgcn_rcpf(fmaxf(bflo(g1.w), 1e-30f)); r1[3] = bfhi(g0.w) * __builtin_amdgcn_rcpf(fmaxf(bfhi(g1.w), 1e-30f));
                    acc[ai][bj][m][0] = acc[ai][bj][m][0] * r0; acc[ai][bj][m][1] = acc[ai][bj][m][1] * r1;
                }
                if (m == 3) asm volatile("" ::: "memory");
            }
    }
    __device__ __forceinline__ void operator()(const f32x4 (&acc)[2][2][4][2], const Unit& u, int wr, int wc, int fr, int fq, const float (&)[8]) const {
        const int row0 = u.pm * BM + wr * 64 + fr, col0 = u.pn * BM + wc * 32 + 8 * fq;
#pragma unroll
        for (int ai = 0; ai < 2; ++ai)
#pragma unroll
            for (int m = 0; m < 4; ++m) {
                const int row = row0 + ai * HALF + m * 16;
#pragma unroll
                for (int bj = 0; bj < 2; ++bj) {
                    const u32x4 gt = *(const u32x4*)(GT + (size_t)row * 3072 + 2048 + col0 + bj * HALF);
                    const f32x4 v0 = acc[ai][bj][m][0], v1 = acc[ai][bj][m][1];
                    u32x4 w;
                    w.x = cvt_pk_bf16(v0[0] * bflo(gt.x), v0[1] * bfhi(gt.x)); w.y = cvt_pk_bf16(v0[2] * bflo(gt.y), v0[3] * bfhi(gt.y));
                    w.z = cvt_pk_bf16(v1[0] * bflo(gt.z), v1[1] * bfhi(gt.z)); w.w = cvt_pk_bf16(v1[2] * bflo(gt.w), v1[3] * bfhi(gt.w));
                    *(u32x4*)(MB + (size_t)row * 1024 + col0 + bj * HALF) = w;
                }
            }
    }
};


template <class Epi, class Sched, bool ALIGN_EPI = false, bool SP2 = false>
__device__ __forceinline__ void gemm_phase(PG8_LAS unsigned char* lds, const Gemm g, const Sched& S, const Epi& E) {
    int tid_ = threadIdx.x; asm volatile("" : "+v"(tid_));
    const int tid = tid_, wid = __builtin_amdgcn_readfirstlane(tid >> 6), lane = tid & 63, wr = wid >> 2, wc = wid & 3, fr = lane & 15, fq = lane >> 4;
    const int K = g.K, nt = K / BK;
    unsigned voffA[2], voffB[2];
#pragma unroll
    for (int i = 0; i < 2; ++i) { int R, C; stage_rc(tid * 16 + i * 8192, R, C); const int Rb = Epi::PERM ? ((R & ~31) + perm32(R & 31)) : R;
        voffA[i] = (unsigned)(R * K + C) * 2u; voffB[i] = (unsigned)(Rb * K + C) * 2u; }
    const size_t kstep = (size_t)(BK * 2);
    const size_t hstep = (size_t)HALF * K * 2;
    const size_t tstep = 2 * hstep;
    const unsigned ldsw = (unsigned)wid * 1024u;
    const int aoff = lds_byte(wr * 64 + fr, fq * 8), boff = lds_byte(wc * 32 + fr, fq * 8);
#define PG8_SA(b, h) (((b) * 2 + (h)) * HTB)
#define PG8_SB(b, h) ((4 + (b) * 2 + (h)) * HTB)
#define PG8_STAGE(bufoff, gbase, voff) do { _Pragma("unroll") for (int _i = 0; _i < 2; ++_i) \
        __builtin_amdgcn_global_load_lds((const unsigned*)((const char*)(gbase) + (voff)[_i]), (PG8_LAS unsigned*)(lds + (bufoff) + ldsw + _i * 8192), 16, 0, 0); } while (0)
#define PG8_LDA(dst, b, h) do { _Pragma("unroll") for (int m = 0; m < 4; ++m) _Pragma("unroll") for (int k = 0; k < 2; ++k) dst[m][k] = *(const PG8_LAS bf16x8*)(lds + PG8_SA(b, h) + aoff + m * 2048 + k * 1024); } while (0)
#define PG8_LDB(dst, b, h) do { _Pragma("unroll") for (int n = 0; n < 2; ++n) _Pragma("unroll") for (int k = 0; k < 2; ++k) dst[n][k] = *(const PG8_LAS bf16x8*)(lds + PG8_SB(b, h) + boff + n * 2048 + k * 1024); } while (0)
#define PG8_MMA(ai, bj, At, Bt) do { __builtin_amdgcn_s_setprio(1); _Pragma("unroll") for (int m = 0; m < 4; ++m) _Pragma("unroll") for (int n = 0; n < 2; ++n) _Pragma("unroll") for (int k = 0; k < 2; ++k) \
        acc[ai][bj][m][n] = __builtin_amdgcn_mfma_f32_16x16x32_bf16(Bt[n][k], At[m][k], acc[ai][bj][m][n], 0, 0, 0); __builtin_amdgcn_s_setprio(0); } while (0)
#define PG8_WAIT_V(n) asm volatile("s_waitcnt vmcnt(" #n ")" ::: "memory")
#define PG8_WAIT_L(n) asm volatile("s_waitcnt lgkmcnt(" #n ")" ::: "memory")
#define PG8_BAR __builtin_amdgcn_s_barrier()
#define PG8_SCHED __builtin_amdgcn_sched_barrier(0)
    Unit cur, nxt; int ui = 0;
    if (!S.next(0, cur)) return;
    float rsv[8] = {0.f, 0.f, 0.f, 0.f, 0.f, 0.f, 0.f, 0.f};
    f32x4 acc[2][2][4][2];
#pragma unroll
    for (int a = 0; a < 2; ++a)
#pragma unroll
        for (int b = 0; b < 2; ++b)
#pragma unroll
            for (int m = 0; m < 4; ++m)
#pragma unroll
                for (int n = 0; n < 2; ++n) acc[a][b][m][n] = (f32x4){0.f, 0.f, 0.f, 0.f};
    bf16x8 At[4][2], B0[2][2], B1[2][2];
    const char* cA = (const char*)g.A + (size_t)cur.pm * tstep + (size_t)(cur.pn / g.agdiv) * g.agstride; const char* cB = (const char*)g.Bt + (size_t)cur.pn * tstep;
    S.a_ready(cur);
    if constexpr (SP2) {
        PG8_STAGE(PG8_SB(0, 0), cB, voffB); PG8_STAGE(PG8_SB(0, 1), cB + hstep, voffB); PG8_STAGE(PG8_SA(0, 0), cA, voffA); PG8_STAGE(PG8_SA(0, 1), cA + hstep, voffA);
        if (wr == 1) PG8_BAR;
        PG8_WAIT_V(2); PG8_BAR;
        PG8_STAGE(PG8_SB(1, 0), cB + kstep, voffB); PG8_STAGE(PG8_SA(1, 0), cA + kstep, voffA); PG8_STAGE(PG8_SB(1, 1), cB + hstep + kstep, voffB);
        PG8_WAIT_V(6); PG8_BAR;
    } else {
        PG8_STAGE(PG8_SB(0, 0), cB, voffB); PG8_STAGE(PG8_SA(0, 0), cA, voffA); PG8_STAGE(PG8_SB(0, 1), cB + hstep, voffB); PG8_STAGE(PG8_SA(0, 1), cA + hstep, voffA);
        if (wr == 1) PG8_BAR;
        PG8_WAIT_V(4); PG8_BAR;
        PG8_STAGE(PG8_SB(1, 0), cB + kstep, voffB); PG8_STAGE(PG8_SA(1, 0), cA + kstep, voffA); PG8_STAGE(PG8_SB(1, 1), cB + hstep + kstep, voffB);
        PG8_WAIT_V(6); PG8_BAR;
    }
    for (;;) {
        const bool has_next = S.next(ui + 1, nxt);
        const char* nA = has_next ? (const char*)g.A + (size_t)nxt.pm * tstep + (size_t)(nxt.pn / g.agdiv) * g.agstride : cA; const char* nB = has_next ? (const char*)g.Bt + (size_t)nxt.pn * tstep : cB;
        for (int t = 0; t < nt; t += 2) {
            if constexpr (Epi::HAS_MID) { if (t == 8 || t == 16) E.mid(acc, cur, t >> 3, wr, wc, fr, fq); }
            const bool last = (t == nt - 2);
            const char* a1 = cA + (size_t)(t + 1) * kstep;
            const char* a2 = last ? nA : cA + (size_t)(t + 2) * kstep; const char* b2 = last ? nB : cB + (size_t)(t + 2) * kstep;
            const char* a3 = a2 + kstep; const char* b3 = b2 + kstep;
            if (last && has_next) S.a_ready(nxt);
            if constexpr (Epi::HAS_PRE) { if (last) E.pre(rsv, cur, wr, fr); }
            if constexpr (SP2) {
            PG8_LDB(B0, 0, 0); PG8_LDB(B1, 0, 1); PG8_SCHED; PG8_LDA(At, 0, 0); PG8_STAGE(PG8_SA(1, 1), a1 + hstep, voffA);
            PG8_WAIT_V(8); PG8_WAIT_L(0); PG8_BAR; PG8_MMA(0, 0, At, B0); PG8_MMA(0, 1, At, B1); PG8_BAR; PG8_SCHED;
            PG8_LDA(At, 0, 1); PG8_STAGE(PG8_SB(0, 0), b2, voffB); PG8_STAGE(PG8_SB(0, 1), b2 + hstep, voffB); PG8_STAGE(PG8_SA(0, 0), a2, voffA);
            PG8_WAIT_V(8); PG8_WAIT_L(0); PG8_BAR; PG8_MMA(1, 0, At, B0); PG8_MMA(1, 1, At, B1); PG8_BAR; PG8_SCHED;
            PG8_LDB(B0, 1, 0); PG8_LDB(B1, 1, 1); PG8_SCHED; PG8_LDA(At, 1, 0); PG8_STAGE(PG8_SA(0, 1), a2 + hstep, voffA);
            PG8_WAIT_V(8); PG8_WAIT_L(0); PG8_BAR; PG8_MMA(0, 0, At, B0); PG8_MMA(0, 1, At, B1); PG8_BAR; PG8_SCHED;
            PG8_LDA(At, 1, 1); PG8_STAGE(PG8_SB(1, 0), b3, voffB); PG8_STAGE(PG8_SB(1, 1), b3 + hstep, voffB); PG8_STAGE(PG8_SA(1, 0), a3, voffA);
            PG8_WAIT_V(8); PG8_WAIT_L(0); PG8_BAR; PG8_MMA(1, 0, At, B0); PG8_MMA(1, 1, At, B1); PG8_BAR; PG8_SCHED;
            } else {
            PG8_LDB(B0, 0, 0); PG8_SCHED; PG8_LDA(At, 0, 0); PG8_STAGE(PG8_SA(1, 1), a1 + hstep, voffA);
            PG8_WAIT_L(8); PG8_BAR; PG8_WAIT_L(0); PG8_MMA(0, 0, At, B0); PG8_BAR; PG8_SCHED;
            PG8_LDB(B1, 0, 1); PG8_STAGE(PG8_SB(0, 0), b2, voffB);
            PG8_BAR; PG8_WAIT_L(0); PG8_MMA(0, 1, At, B1); PG8_BAR;
            PG8_LDA(At, 0, 1); PG8_STAGE(PG8_SA(0, 0), a2, voffA);
            PG8_BAR; PG8_WAIT_L(0); PG8_MMA(1, 0, At, B0); PG8_BAR; PG8_SCHED;
            PG8_STAGE(PG8_SB(0, 1), b2 + hstep, voffB);
            PG8_WAIT_V(6); PG8_BAR; PG8_MMA(1, 1, At, B1); PG8_BAR;
            PG8_LDB(B0, 1, 0); PG8_SCHED; PG8_LDA(At, 1, 0); PG8_STAGE(PG8_SA(0, 1), a2 + hstep, voffA);
            PG8_WAIT_L(8); PG8_BAR; PG8_WAIT_L(0); PG8_MMA(0, 0, At, B0); PG8_BAR; PG8_SCHED;
            PG8_LDB(B1, 1, 1); PG8_STAGE(PG8_SB(1, 0), b3, voffB);
            PG8_BAR; PG8_WAIT_L(0); PG8_MMA(0, 1, At, B1); PG8_BAR;
            PG8_LDA(At, 1, 1); PG8_STAGE(PG8_SA(1, 0), a3, voffA);
            PG8_BAR; PG8_WAIT_L(0); PG8_MMA(1, 0, At, B0); PG8_BAR; PG8_SCHED;
            PG8_STAGE(PG8_SB(1, 1), b3 + hstep, voffB);
            PG8_WAIT_V(6); PG8_BAR; PG8_MMA(1, 1, At, B1); PG8_BAR;
            }
        }
        if constexpr (ALIGN_EPI) { if (wr == 0) PG8_BAR; }
        if constexpr (!Epi::AFTER_DRAIN) { E(acc, cur, wr, wc, fr, fq, rsv); S.done(cur); }
        if (!has_next) break;
#pragma unroll
        for (int a = 0; a < 2; ++a)
#pragma unroll
            for (int b = 0; b < 2; ++b)
#pragma unroll
                for (int m = 0; m < 4; ++m)
#pragma unroll
                    for (int n = 0; n < 2; ++n) acc[a][b][m][n] = (f32x4){0.f, 0.f, 0.f, 0.f};
        cur = nxt; cA = nA; cB = nB; ++ui;
        if constexpr (ALIGN_EPI) { if (wr == 1) PG8_BAR; }
    }
    PG8_WAIT_V(0);
    if constexpr (!ALIGN_EPI) { if (wr == 0) PG8_BAR; }
    PG8_BAR;
    if constexpr (Epi::AFTER_DRAIN) { E.fused(acc, cur, wr, wc, fr, fq, lds, wid, lane); S.done(cur); }
#undef PG8_SA
#undef PG8_SB
#undef PG8_STAGE
#undef PG8_LDA
#undef PG8_LDB
#undef PG8_MMA
#undef PG8_WAIT_V
#undef PG8_WAIT_L
#undef PG8_BAR
#undef PG8_SCHED
}
}

#define LAS __attribute__((address_space(3)))
typedef unsigned short bf16_t;
typedef short bf16x8 __attribute__((ext_vector_type(8)));
typedef short s16x4 __attribute__((ext_vector_type(4)));
typedef float f32x4 __attribute__((ext_vector_type(4)));
typedef unsigned u32x4 __attribute__((ext_vector_type(4)));
typedef unsigned u32x2 __attribute__((ext_vector_type(2)));
using pg8::cvt_pk_bf16; using pg8::fsigmoid; using pg8::fsilu; using pg8::bflo; using pg8::bfhi;

constexpr int DM = 1024, FF = 2048, NIN = 6400, DEPTH = 4;
constexpr int MP = 16896;
constexpr int BROWS = 8320;
constexpr int PADR = 112, TPB = 8208, NT = 65;
constexpr int SROW0 = 16640;
constexpr int MREAL = 16768;
constexpr int PAW = 3328, GTW = 3072;
constexpr int C_XA = 0, C_YA = 512, C_QS = 1024, C_KS = 1536, C_VS = 1664, C_QR = 1792, C_KR = 2048, C_VR = 2304, C_GR = 2816;
constexpr int NTHR = 512;
constexpr int OBS = 1536;
constexpr int LDS_BYTES = 131072 + 256;

constexpr size_t MiB = 1u << 20;
constexpr size_t WS_BAR = 0;
constexpr size_t WS_LSUM = 1 * MiB;
constexpr size_t WS_LCAR = WS_LSUM + 1 * MiB;
constexpr size_t WS_W0 = 3 * MiB;
constexpr size_t WSZ = 46 * MiB;
constexpr size_t W_GU1 = 0, W_D1 = 8 * MiB, W_IN = 12 * MiB, W_BR = 25 * MiB, W_OUT = 28 * MiB, W_GU2 = 34 * MiB, W_D2 = 42 * MiB;
constexpr size_t WS_X = WS_W0 + 2 * WSZ;
constexpr size_t WS_XB = WS_X + 66 * MiB;
constexpr size_t WS_PA = WS_XB + 33 * MiB;
constexpr size_t WS_GT = WS_PA + 108 * MiB;
constexpr size_t WS_OB = WS_GT + 99 * MiB;
constexpr size_t WS_U = WS_OB + 50 * MiB;
constexpr size_t WS_ST = WS_U + 17 * MiB;
constexpr size_t WS_SS16 = WS_ST + 9 * MiB;
constexpr size_t WS_BG = WS_SS16 + 14 * MiB;
constexpr size_t WS_RS = WS_BG + 33 * MiB;
constexpr size_t WS_END = WS_RS + 1 * MiB;

constexpr int O_YP = 0, O_YS = 16777216, O_PK = 16908288, O_PV = 17039360, O_PC = 17170432, O_PL = 17182720, O_PR = 17186816,
              O_SK = 17448960, O_SV = 25837568, O_SC = 34226176, O_SL = 35012608, O_SR = 35274752;

enum { I_XP = 0, I_XS, I_CK, I_CV, I_SCONV, I_SLRU, I_SRET, I_META, I_F1N, I_F1GU, I_F1D, I_MIXN, I_WIN, I_CONVW, I_CONVB, I_LWA, I_LBA, I_LWX, I_LBX, I_LAM,
       I_SINK, I_RETN, I_WBA, I_WBB, I_WBC, I_WOUT, I_F2N, I_F2GU, I_F2D, I_FINN };

struct Args { const float* in[30]; float* out; unsigned char* ws; int ph_lo, ph_hi; };
typedef const __attribute__((address_space(4))) Args CArgs;

__device__ __forceinline__ float bf2f(bf16_t v) { return __uint_as_float((unsigned)v << 16); }
__device__ __forceinline__ bf16_t f2bf(float f) { return (bf16_t)(cvt_pk_bf16(f, 0.f) & 0xffffu); }
__device__ __forceinline__ float gelu_tanh(float x) { const float t = 0.7978845608028654f * (x + 0.044715f * x * x * x); const float e = __expf(2.0f * t); const float th = 1.0f - 2.0f * __builtin_amdgcn_rcpf(e + 1.0f); return 0.5f * x * (1.0f + th); }
__device__ __forceinline__ void sincos_rev(float ang, float& s, float& c) {
    const double rv = (double)ang * 0.15915494309189535; const float fr = (float)(rv - __builtin_rint(rv));
    s = __builtin_amdgcn_sinf(fr); c = __builtin_amdgcn_cosf(fr);
}
__device__ __forceinline__ float rope_inv(int i) { return exp2f(-(float)i * (13.287712379549449f / 32.0f)); }
__device__ __forceinline__ float log2_gamma(int h) { return log2f(1.0f - exp2f(-5.0f - (float)h)); }
__device__ __forceinline__ int tid_opaque() { int t = threadIdx.x; asm volatile("" : "+v"(t)); return t; }
#define LDSW() asm volatile("s_waitcnt lgkmcnt(0)" ::: "memory")

__device__ __forceinline__ void cvt_item(const float* W, int K, int N, bf16_t* WT, int ldk, int rep, const float* g, int mode, LAS float* scr, int item, int lane) {
    const int nblk = N / 32, kb = item / nblk, nb = item % nblk, k0 = 64 * kb, n0 = 32 * nb;
    float wv[32];
#pragma unroll
    for (int i = 0; i < 32; ++i) { const int kk = 2 * i + (lane >> 5); wv[i] = __builtin_nontemporal_load(&W[(size_t)(k0 + kk) * N + n0 + (lane & 31)]); }
#pragma unroll
    for (int i = 0; i < 32; ++i) { const int kk = 2 * i + (lane >> 5); float w = wv[i]; if (g) w *= g[k0 + kk]; scr[kk * 33 + (lane & 31)] = w; }
    LDSW();
    const int c = lane & 7;
#pragma unroll
    for (int j = 0; j < 4; ++j) {
        const int n = (lane >> 3) + 8 * j; const LAS float* s = scr + (8 * c) * 33 + n;
        u32x4 o; o.x = cvt_pk_bf16(s[0 * 33], s[1 * 33]); o.y = cvt_pk_bf16(s[2 * 33], s[3 * 33]); o.z = cvt_pk_bf16(s[4 * 33], s[5 * 33]); o.w = cvt_pk_bf16(s[6 * 33], s[7 * 33]);
        const int nn = n0 + n; const int drow = mode ? (256 * ((nn & 2047) >> 7) + 128 * (nn >> 11) + (nn & 127)) : nn;
        for (int r = 0; r < rep; ++r) *(u32x4*)(WT + (size_t)drow * ldk + r * K + k0 + 8 * c) = o;
    }
    LDSW();
}
__device__ __forceinline__ void convert_layer(CArgs* a, int l, unsigned char* wbuf, LAS unsigned char* lds, int gw, int ngw, int wave, int lane) {
    LAS float* scr = (LAS float*)(lds + wave * 8448);
    constexpr int I_GU = 16 * 128, I_D = 32 * 32, I_W = 16 * 200, I_B = 8 * 32, I_O = 16 * 32;
    constexpr int NITEMS = 2 * I_GU + 2 * I_D + I_W + 3 * I_B + I_O;
    for (int it = gw; it < NITEMS; it += ngw) {
        int r = it;
        if (r < I_GU) { cvt_item(a->in[I_F1GU] + (size_t)l * DM * 4096, DM, 4096, (bf16_t*)(wbuf + W_GU1), DM, 1, a->in[I_F1N] + l * DM, 1, scr, r, lane); continue; } r -= I_GU;
        if (r < I_GU) { cvt_item(a->in[I_F2GU] + (size_t)l * DM * 4096, DM, 4096, (bf16_t*)(wbuf + W_GU2), DM, 1, a->in[I_F2N] + l * DM, 1, scr, r, lane); continue; } r -= I_GU;
        if (r < I_D) { cvt_item(a->in[I_F1D] + (size_t)l * FF * DM, FF, DM, (bf16_t*)(wbuf + W_D1), FF, 1, nullptr, 0, scr, r, lane); continue; } r -= I_D;
        if (r < I_D) { cvt_item(a->in[I_F2D] + (size_t)l * FF * DM, FF, DM, (bf16_t*)(wbuf + W_D2), FF, 1, nullptr, 0, scr, r, lane); continue; } r -= I_D;
        if (r < I_W) { cvt_item(a->in[I_WIN] + (size_t)l * DM * NIN, DM, NIN, (bf16_t*)(wbuf + W_IN), DM, 1, a->in[I_MIXN] + l * DM, 0, scr, r, lane); continue; } r -= I_W;
        if (r < 3 * I_B) { const int br = r / I_B; cvt_item((br == 0 ? a->in[I_WBA] : (br == 1 ? a->in[I_WBB] : a->in[I_WBC])) + (size_t)l * 512 * DM, 512, DM, (bf16_t*)(wbuf + W_BR) + br * 512, OBS, 1, nullptr, 0, scr, r % I_B, lane); continue; } r -= 3 * I_B;
        cvt_item(a->in[I_WOUT] + (size_t)l * DM * DM, DM, DM, (bf16_t*)(wbuf + W_OUT), DM, 1, nullptr, 0, scr, r, lane);
    }
}

__device__ __forceinline__ float wave_sum(float v) {
#pragma unroll
    for (int o = 1; o < 64; o <<= 1) v += __shfl_xor(v, o);
    return v;
}
__device__ __forceinline__ void init_rows(CArgs* a, float* X, bf16_t* XB, float* SS, float* RS0, bf16_t* OB, int gw, int ngw, int lane) {
    for (int r = gw; r < MP; r += ngw) {
        const float* src = nullptr;
        if (r < 2 * BROWS) { const int b = r / BROWS, pr = r % BROWS; if (pr >= PADR) { const int t = pr - PADR; src = (t < 16) ? a->in[I_META] + (size_t)t * DM : a->in[I_XP] + ((size_t)b * 8192 + (t - 16)) * DM; } }
        else if (r < MREAL) src = a->in[I_XS] + (size_t)(r - SROW0) * DM;
        float sq = 0.f;
#pragma unroll
        for (int j = 0; j < 4; ++j) {
            f32x4 v = (f32x4){0.f, 0.f, 0.f, 0.f};
            if (src) v = __builtin_nontemporal_load((const f32x4*)src + lane + 64 * j);
            *((f32x4*)(X + (size_t)r * DM) + lane + 64 * j) = v;
            u32x2 w; w.x = cvt_pk_bf16(v[0], v[1]); w.y = cvt_pk_bf16(v[2], v[3]); *((u32x2*)(XB + (size_t)r * DM) + lane + 64 * j) = w;
            sq += (v[0] * v[0] + v[1] * v[1]) + (v[2] * v[2] + v[3] * v[3]);
        }
        sq = wave_sum(sq);
        if (lane < 16) SS[(size_t)r * 16 + lane] = (lane == 0) ? sq : 0.f;
        if (lane == 0) RS0[r] = __builtin_amdgcn_rsqf(sq * (1.0f / 1024.0f) + 1e-6f);
        if (r >= MREAL) {
#pragma unroll
            for (int br = 0; br < 3; ++br) *((u32x4*)(OB + (size_t)r * OBS + br * 512) + lane) = (u32x4){0u, 0u, 0u, 0u};
        }
    }
}

__device__ __forceinline__ void lru1_item(CArgs* a, int l, int tt, int chblk, const bf16_t* PA, bf16_t* OB0, float* LSUM, float* AG, float* BG, LAS unsigned char* lds) {
    LAS float* xa_s = (LAS float*)lds;
    LAS float* xc_s = xa_s + 131 * 64;
    LAS bf16_t* wt_s = (LAS bf16_t*)(xc_s + 128 * 64);
    LAS float* seg_s = (LAS float*)(wt_s + 128 * 72);
    const int tid = tid_opaque(), lane = tid & 63, w = tid >> 6, fr = lane & 15, fq = lane >> 4;
    const int ch0 = chblk * 64, ch = ch0 + lane;
    const bool sample = (tt == 130);
    const int b = tt / NT, n = tt % NT;
    const int row0 = sample ? SROW0 : b * BROWS + n * 128;
    {
        const float* wa = a->in[I_LWA] + ((size_t)l * 8 + chblk) * 4096; const float* wx = a->in[I_LWX] + ((size_t)l * 8 + chblk) * 4096;
        float wv[16];
#pragma unroll
        for (int k = 0; k < 16; ++k) { const int i = tid + k * NTHR; wv[k] = (i < 4096) ? wa[i] : wx[i - 4096]; }
#pragma unroll
        for (int k = 0; k < 16; ++k) { const int i = tid + k * NTHR; const int m = i >> 12, c = (i >> 6) & 63, d = i & 63; wt_s[(m * 64 + d) * 72 + c] = f2bf(wv[k]); }
    }
    const float cw0 = a->in[I_CONVW][(l * 4 + 0) * 512 + ch], cw1 = a->in[I_CONVW][(l * 4 + 1) * 512 + ch], cw2 = a->in[I_CONVW][(l * 4 + 2) * 512 + ch], cw3 = a->in[I_CONVW][(l * 4 + 3) * 512 + ch];
    const float cb = a->in[I_CONVB][l * 512 + ch];
    if (!sample) {
        float xv[17];
#pragma unroll
        for (int k = 0; k < 17; ++k) {
            const int rr = w + 8 * k; const int grow = row0 - 3 + rr; xv[k] = 0.f;
            if (rr < 131 && !(n == 0 && rr < 3)) xv[k] = bf2f(PA[(size_t)grow * PAW + C_XA + ch]);
        }
#pragma unroll
        for (int k = 0; k < 17; ++k) { const int rr = w + 8 * k; if (rr < 131) xa_s[rr * 64 + lane] = xv[k]; }
        __syncthreads();
#pragma unroll 4
        for (int r = w; r < 128; r += 8) xc_s[r * 64 + lane] = cb + cw0 * xa_s[r * 64 + lane] + cw1 * xa_s[(r + 1) * 64 + lane] + cw2 * xa_s[(r + 2) * 64 + lane] + cw3 * xa_s[(r + 3) * 64 + lane];
        if (n == NT - 1 && w < 3) a->out[O_PC + ((l * 2 + b) * 3 + w) * 512 + ch] = xa_s[(128 + w) * 64 + lane];
    } else {
#pragma unroll
        for (int k = 0; k < 16; ++k) { const int r = w + 8 * k;
            const float* sc = a->in[I_SCONV] + ((size_t)(l * 128 + r) * 3) * 512 + ch; const float s0 = sc[0], s1 = sc[512], s2 = sc[1024];
            const float xa = bf2f(PA[(size_t)(SROW0 + r) * PAW + C_XA + ch]);
            xc_s[r * 64 + lane] = cb + cw0 * s0 + cw1 * s1 + cw2 * s2 + cw3 * xa;
            float* oc = a->out + O_SC + ((size_t)(l * 128 + r) * 3) * 512 + ch; oc[0] = s1; oc[512] = s2; oc[1024] = xa;
        }
    }
    __syncthreads();
    f32x4 acc[8];
    {
        bf16x8 af[2];
#pragma unroll
        for (int ks = 0; ks < 2; ++ks) {
            const f32x4 x0 = *(const LAS f32x4*)(xc_s + (16 * w + fr) * 64 + 32 * ks + 8 * fq), x1 = *(const LAS f32x4*)(xc_s + (16 * w + fr) * 64 + 32 * ks + 8 * fq + 4);
            u32x4 p; p.x = cvt_pk_bf16(x0[0], x0[1]); p.y = cvt_pk_bf16(x0[2], x0[3]); p.z = cvt_pk_bf16(x1[0], x1[1]); p.w = cvt_pk_bf16(x1[2], x1[3]); af[ks] = __builtin_bit_cast(bf16x8, p);
        }
#pragma unroll
        for (int t = 0; t < 8; ++t) {
            acc[t] = (f32x4){0.f, 0.f, 0.f, 0.f};
#pragma unroll
            for (int ks = 0; ks < 2; ++ks) { const bf16x8 bfr = *(const LAS bf16x8*)(wt_s + (t * 16 + fr) * 72 + 32 * ks + 8 * fq); acc[t] = __builtin_amdgcn_mfma_f32_16x16x32_bf16(af[ks], bfr, acc[t], 0, 0, 0); }
        }
    }
    LAS float* a_s = xa_s;
#pragma unroll
    for (int dt = 0; dt < 4; ++dt) {
        const int d = 16 * dt + fr, cch = ch0 + d;
        const float ba = a->in[I_LBA][l * 512 + cch], bx = a->in[I_LBX][l * 512 + cch];
        const float sp = log1pf(__expf(-a->in[I_LAM][l * 512 + cch]));
#pragma unroll
        for (int i = 0; i < 4; ++i) {
            const int r = 16 * w + 4 * fq + i;
            const float rg = fsigmoid(acc[dt][i] + ba), ig = fsigmoid(acc[4 + dt][i] + bx);
            const float la = -8.0f * rg * sp; float av = __expf(la);
            const float t2 = 2.0f * la;
            const float om = (t2 > -0.0625f) ? -t2 * (1.0f + t2 * (0.5f + t2 * (0.16666667f + t2 * (0.041666667f + t2 * 0.0083333333f)))) : 1.0f - av * av;
            float bv = __builtin_amdgcn_sqrtf(om) * (ig * xc_s[r * 64 + d]);
            if (!sample && n == 0 && r < PADR) { av = 1.0f; bv = 0.0f; }
            a_s[r * 64 + d] = av; xc_s[r * 64 + d] = bv;
        }
    }
    __syncthreads();
    if (sample) {
#pragma unroll
        for (int i = 0; i < 16; ++i) {
            const int r = w * 16 + i;
            const float hs = a_s[r * 64 + lane] * a->in[I_SLRU][(size_t)(l * 128 + r) * 512 + ch] + xc_s[r * 64 + lane];
            a->out[O_SL + (size_t)(l * 128 + r) * 512 + ch] = hs;
            const float ya = bf2f(PA[(size_t)(SROW0 + r) * PAW + C_YA + ch]);
            OB0[(size_t)(SROW0 + r) * OBS + ch] = f2bf(hs * gelu_tanh(ya));
        }
        __syncthreads();
        return;
    }
    float P = 1.0f, h = 0.0f;
#pragma unroll 4
    for (int i = 0; i < 16; ++i) {
        const int r = w * 16 + i; const float av = a_s[r * 64 + lane], bv = xc_s[r * 64 + lane];
        AG[(size_t)(row0 + r) * 512 + ch] = av; BG[(size_t)(row0 + r) * 512 + ch] = bv;
        h = av * h + bv; P *= av;
    }
    seg_s[(w * 64 + lane) * 2] = P; seg_s[(w * 64 + lane) * 2 + 1] = h;
    __syncthreads();
    if (w == 0) {
        float Pt = 1.0f, ht = 0.0f;
#pragma unroll
        for (int q = 0; q < 8; ++q) { const float p = seg_s[(q * 64 + lane) * 2], hh = seg_s[(q * 64 + lane) * 2 + 1]; ht = p * ht + hh; Pt *= p; }
        LSUM[((size_t)tt * 512 + ch) * 2] = Pt; LSUM[((size_t)tt * 512 + ch) * 2 + 1] = ht;
    }
    __syncthreads();
}
__device__ __forceinline__ void lru2_item(int tt, int chblk, const bf16_t* PA, bf16_t* OB0, const float* LCAR, const float* AG, const float* BG, LAS unsigned char* lds) {
    LAS float* seg_s = (LAS float*)lds;
    const int tid = tid_opaque(), lane = tid & 63, w = tid >> 6; const int ch = chblk * 64 + lane;
    const int b = tt / NT, n = tt % NT, row0 = b * BROWS + n * 128 + w * 16;
    float av[16], bv[16], yv[16];
#pragma unroll
    for (int i = 0; i < 16; ++i) { av[i] = AG[(size_t)(row0 + i) * 512 + ch]; bv[i] = BG[(size_t)(row0 + i) * 512 + ch]; yv[i] = bf2f(PA[(size_t)(row0 + i) * PAW + C_YA + ch]); }
    float hc = LCAR[(size_t)tt * 512 + ch];
    float P = 1.0f, h = 0.0f;
#pragma unroll
    for (int i = 0; i < 16; ++i) { h = av[i] * h + bv[i]; P *= av[i]; }
    seg_s[(w * 64 + lane) * 2] = P; seg_s[(w * 64 + lane) * 2 + 1] = h;
    __syncthreads();
    for (int q = 0; q < w; ++q) { const float p = seg_s[(q * 64 + lane) * 2], hh = seg_s[(q * 64 + lane) * 2 + 1]; hc = p * hc + hh; }
#pragma unroll
    for (int i = 0; i < 16; ++i) { hc = av[i] * hc + bv[i]; OB0[(size_t)(row0 + i) * OBS + ch] = f2bf(hc * gelu_tanh(yv[i])); }
    __syncthreads();
}

__device__ __forceinline__ void swa_item(CArgs* a, int l, int item, const bf16_t* PA, bf16_t* OB1, LAS unsigned char* lds) {
    const int kvh = item & 1, bn = item >> 1, b = bn / NT, n = bn % NT, row0 = b * BROWS + n * 128;
    LAS bf16_t* Ks = (LAS bf16_t*)lds;
    LAS bf16_t* Vt = Ks + 256 * 72;
    const int tid = tid_opaque(), lane = tid & 63, w = tid >> 6, fr = lane & 15, fq = lane >> 4;
    const int g = w >> 1, h = kvh * 4 + g;
    const float sink = a->in[I_SINK][l * 8 + h];
    bf16x8 qfa[4][2];
#pragma unroll
    for (int qb = 0; qb < 4; ++qb) { const int row = row0 + (w & 1) * 64 + qb * 16 + fr; qfa[qb][0] = *(const bf16x8*)(PA + (size_t)row * PAW + C_QS + h * 64 + fq * 8); qfa[qb][1] = *(const bf16x8*)(PA + (size_t)row * PAW + C_QS + h * 64 + 32 + fq * 8); }
    {
        const int key = tid >> 1, hf = tid & 1; const int grow = row0 - 128 + key; const bool valid = (n > 0) || (key >= 128);
        u32x4 kk[4], vv[4];
#pragma unroll
        for (int j = 0; j < 4; ++j) { kk[j] = (u32x4){0u, 0u, 0u, 0u}; vv[j] = (u32x4){0u, 0u, 0u, 0u}; }
        if (valid) {
            const u32x4* kp = (const u32x4*)(PA + (size_t)grow * PAW + C_KS + kvh * 64 + hf * 32); const u32x4* vp = (const u32x4*)(PA + (size_t)grow * PAW + C_VS + kvh * 64 + hf * 32);
#pragma unroll
            for (int j = 0; j < 4; ++j) { kk[j] = kp[j]; vv[j] = vp[j]; }
        }
#pragma unroll
        for (int j = 0; j < 4; ++j) *(LAS u32x4*)(Ks + key * 72 + hf * 32 + j * 8) = kk[j];
#pragma unroll
        for (int j = 0; j < 4; ++j) {
            const unsigned ws4[4] = {vv[j].x, vv[j].y, vv[j].z, vv[j].w};
#pragma unroll
            for (int q = 0; q < 4; ++q) { const int d = hf * 32 + j * 8 + q * 2; Vt[d * 280 + key] = (bf16_t)(ws4[q] & 0xffffu); Vt[(d + 1) * 280 + key] = (bf16_t)(ws4[q] >> 16); }
        }
        if (tid < 64) {
#pragma unroll
            for (int e = 256; e < 280; ++e) Vt[tid * 280 + e] = 0;
        }
        if (n == NT - 1 && key >= 128) {
            float* ok = a->out + O_PK + ((size_t)(l * 2 + b) * 128 + (key - 128)) * 128 + kvh * 64 + hf * 32; float* ov = a->out + O_PV + ((size_t)(l * 2 + b) * 128 + (key - 128)) * 128 + kvh * 64 + hf * 32;
#pragma unroll
            for (int j = 0; j < 4; ++j) {
                *(f32x4*)(ok + j * 8) = (f32x4){bflo(kk[j].x), bfhi(kk[j].x), bflo(kk[j].y), bfhi(kk[j].y)}; *(f32x4*)(ok + j * 8 + 4) = (f32x4){bflo(kk[j].z), bfhi(kk[j].z), bflo(kk[j].w), bfhi(kk[j].w)};
                *(f32x4*)(ov + j * 8) = (f32x4){bflo(vv[j].x), bfhi(vv[j].x), bflo(vv[j].y), bfhi(vv[j].y)}; *(f32x4*)(ov + j * 8 + 4) = (f32x4){bflo(vv[j].z), bfhi(vv[j].z), bflo(vv[j].w), bfhi(vv[j].w)};
            }
        }
    }
    __syncthreads();
#pragma unroll
    for (int qb = 0; qb < 4; ++qb) {
        const int r0 = (w & 1) * 64 + qb * 16, jt0 = r0 >> 4, r = r0 + fr, row = row0 + r;
        const bf16x8 qf[2] = {qfa[qb][0], qfa[qb][1]};
        f32x4 sacc[10];
#pragma unroll
        for (int t = 0; t < 9; ++t) {
            sacc[t] = (f32x4){0.f, 0.f, 0.f, 0.f};
#pragma unroll
            for (int ks = 0; ks < 2; ++ks) { const bf16x8 kf = *(const LAS bf16x8*)(Ks + ((jt0 + t) * 16 + fr) * 72 + ks * 32 + fq * 8); sacc[t] = __builtin_amdgcn_mfma_f32_16x16x32_bf16(kf, qf[ks], sacc[t], 0, 0, 0); }
        }
        sacc[9] = (f32x4){0.f, 0.f, 0.f, 0.f};
        float mx = -INFINITY;
#pragma unroll
        for (int t = 0; t < 9; ++t)
#pragma unroll
            for (int i = 0; i < 4; ++i) {
                const int kj = (jt0 + t) * 16 + 4 * fq + i;
                const bool valid = (kj > r) && (kj <= r + 128) && (n * 128 - 128 + kj >= PADR);
                const float s = valid ? sacc[t][i] * 0.125f : -INFINITY; sacc[t][i] = s; mx = fmaxf(mx, s);
            }
        mx = fmaxf(mx, __shfl_xor(mx, 16)); mx = fmaxf(mx, __shfl_xor(mx, 32));
        const float mm = fmaxf(mx, sink);
        float sum = 0.f;
#pragma unroll
        for (int t = 0; t < 9; ++t)
#pragma unroll
            for (int i = 0; i < 4; ++i) { const float e = __expf(sacc[t][i] - mm); sacc[t][i] = e; sum += e; }
        sum += __shfl_xor(sum, 16); sum += __shfl_xor(sum, 32);
        const float inv = 1.0f / (sum + __expf(sink - mm));
        f32x4 oacc[4];
#pragma unroll
        for (int dt = 0; dt < 4; ++dt) oacc[dt] = (f32x4){0.f, 0.f, 0.f, 0.f};
#pragma unroll
        for (int p = 0; p < 5; ++p) {
            const f32x4 ea = sacc[2 * p] * inv, eb = sacc[2 * p + 1] * inv;
            u32x4 pw; pw.x = cvt_pk_bf16(ea[0], ea[1]); pw.y = cvt_pk_bf16(ea[2], ea[3]); pw.z = cvt_pk_bf16(eb[0], eb[1]); pw.w = cvt_pk_bf16(eb[2], eb[3]);
            const bf16x8 pb = __builtin_bit_cast(bf16x8, pw);
            const int ja = jt0 + 2 * p;
#pragma unroll
            for (int dt = 0; dt < 4; ++dt) {
                const u32x2 va = *(const LAS u32x2*)(Vt + (dt * 16 + fr) * 280 + ja * 16 + 4 * fq), vb = *(const LAS u32x2*)(Vt + (dt * 16 + fr) * 280 + (ja + 1) * 16 + 4 * fq);
                const u32x4 vw = (u32x4){va.x, va.y, vb.x, vb.y};
                oacc[dt] = __builtin_amdgcn_mfma_f32_16x16x32_bf16(__builtin_bit_cast(bf16x8, vw), pb, oacc[dt], 0, 0, 0);
            }
        }
#pragma unroll
        for (int dt = 0; dt < 4; ++dt) { u32x2 o; o.x = cvt_pk_bf16(oacc[dt][0], oacc[dt][1]); o.y = cvt_pk_bf16(oacc[dt][2], oacc[dt][3]); *(u32x2*)(OB1 + (size_t)row * OBS + h * 64 + dt * 16 + 4 * fq) = o; }
    }
    __syncthreads();
}

__device__ __forceinline__ void ret_u_item(int item, const bf16_t* PA, float* U, LAS unsigned char* lds) {
    const int hh = item & 3, bc = item >> 2, b = bc / NT, c = bc % NT, row0 = b * BROWS + c * 128;
    LAS bf16_t* Kt = (LAS bf16_t*)lds;
    LAS bf16_t* Vt = Kt + 64 * 136;
    const int tid = tid_opaque(), lane = tid & 63, w = tid >> 6, fr = lane & 15, fq = lane >> 4; const float l2g = log2_gamma(hh);
    {
        const int j = tid >> 2, q = tid & 3; const bf16_t* rowp = PA + (size_t)(row0 + j) * PAW;
        const u32x4* vp = (const u32x4*)(rowp + C_VR + hh * 128 + q * 32);
        u32x4 vv[4];
#pragma unroll
        for (int t = 0; t < 4; ++t) vv[t] = vp[t];
        const u32x4 k1 = *(const u32x4*)(rowp + C_KR + hh * 64 + q * 8), k2 = *(const u32x4*)(rowp + C_KR + hh * 64 + 32 + q * 8);
#pragma unroll
        for (int t = 0; t < 4; ++t) {
            const unsigned ws4[4] = {vv[t].x, vv[t].y, vv[t].z, vv[t].w};
#pragma unroll
            for (int k = 0; k < 4; ++k) { const int e = q * 32 + t * 8 + k * 2; Vt[e * 136 + j] = (bf16_t)(ws4[k] & 0xffffu); Vt[(e + 1) * 136 + j] = (bf16_t)(ws4[k] >> 16); }
        }
        const unsigned w1[4] = {k1.x, k1.y, k1.z, k1.w}, w2[4] = {k2.x, k2.y, k2.z, k2.w};
        const int pos = c * 128 + j - PADR; const float dec = exp2f((float)(127 - j) * l2g) * 0.125f;
#pragma unroll
        for (int k = 0; k < 4; ++k) {
            float sa, ca, sb, cb; sincos_rev((float)pos * rope_inv(q * 8 + 2 * k), sa, ca); sincos_rev((float)pos * rope_inv(q * 8 + 2 * k + 1), sb, cb);
            const float x1a = bflo(w1[k]), x1b = bfhi(w1[k]), x2a = bflo(w2[k]), x2b = bfhi(w2[k]);
            const int d = q * 8 + 2 * k;
            Kt[d * 136 + j] = f2bf((x1a * ca - x2a * sa) * dec); Kt[(d + 32) * 136 + j] = f2bf((x1a * sa + x2a * ca) * dec);
            Kt[(d + 1) * 136 + j] = f2bf((x1b * cb - x2b * sb) * dec); Kt[(d + 33) * 136 + j] = f2bf((x1b * sb + x2b * cb) * dec);
        }
    }
    __syncthreads();
    const int dt = w >> 1;
    f32x4 acc[4];
#pragma unroll
    for (int t = 0; t < 4; ++t) acc[t] = (f32x4){0.f, 0.f, 0.f, 0.f};
#pragma unroll
    for (int ks = 0; ks < 4; ++ks) {
        const bf16x8 kf = *(const LAS bf16x8*)(Kt + (dt * 16 + fr) * 136 + 32 * ks + 8 * fq);
#pragma unroll
        for (int t = 0; t < 4; ++t) { const bf16x8 vf = *(const LAS bf16x8*)(Vt + ((4 * (w & 1) + t) * 16 + fr) * 136 + 32 * ks + 8 * fq); acc[t] = __builtin_amdgcn_mfma_f32_16x16x32_bf16(vf, kf, acc[t], 0, 0, 0); }
    }
#pragma unroll
    for (int t = 0; t < 4; ++t)
#pragma unroll
        for (int i = 0; i < 4; ++i) U[(size_t)item * 8192 + ((4 * (w & 1) + t) * 16 + 4 * fq + i) * 64 + dt * 16 + fr] = acc[t][i];
    __syncthreads();
}
__device__ __forceinline__ void ret_out_item(CArgs* a, int l, int item, const bf16_t* PA, const bf16_t* ST, bf16_t* OB2, LAS unsigned char* lds) {
    const int hh = item & 3, bc = item >> 2, b = bc / NT, c = bc % NT, row0 = b * BROWS + c * 128;
    LAS bf16_t* Kr = (LAS bf16_t*)lds;
    LAS bf16_t* Vt = Kr + 128 * 72;
    const int tid = tid_opaque(), lane = tid & 63, w = tid >> 6, fr = lane & 15, fq = lane >> 4; const float l2g = log2_gamma(hh);
    {
        const int j = tid >> 2, q = tid & 3; const bf16_t* rowp = PA + (size_t)(row0 + j) * PAW;
        const u32x4* vp = (const u32x4*)(rowp + C_VR + hh * 128 + q * 32);
        u32x4 vv[4];
#pragma unroll
        for (int t = 0; t < 4; ++t) vv[t] = vp[t];
        const u32x4 k1 = *(const u32x4*)(rowp + C_KR + hh * 64 + q * 8), k2 = *(const u32x4*)(rowp + C_KR + hh * 64 + 32 + q * 8);
#pragma unroll
        for (int t = 0; t < 4; ++t) {
            const unsigned ws4[4] = {vv[t].x, vv[t].y, vv[t].z, vv[t].w};
#pragma unroll
            for (int k = 0; k < 4; ++k) { const int e = q * 32 + t * 8 + k * 2; Vt[e * 136 + j] = (bf16_t)(ws4[k] & 0xffffu); Vt[(e + 1) * 136 + j] = (bf16_t)(ws4[k] >> 16); }
        }
        const unsigned w1[4] = {k1.x, k1.y, k1.z, k1.w}, w2[4] = {k2.x, k2.y, k2.z, k2.w};
        const int pos = c * 128 + j - PADR; unsigned o1[4], o2[4];
#pragma unroll
        for (int k = 0; k < 4; ++k) {
            float sa, ca, sb, cb; sincos_rev((float)pos * rope_inv(q * 8 + 2 * k), sa, ca); sincos_rev((float)pos * rope_inv(q * 8 + 2 * k + 1), sb, cb);
            const float x1a = bflo(w1[k]), x1b = bfhi(w1[k]), x2a = bflo(w2[k]), x2b = bfhi(w2[k]);
            o1[k] = cvt_pk_bf16((x1a * ca - x2a * sa) * 0.125f, (x1b * cb - x2b * sb) * 0.125f); o2[k] = cvt_pk_bf16((x1a * sa + x2a * ca) * 0.125f, (x1b * sb + x2b * cb) * 0.125f);
        }
        *(LAS u32x4*)(Kr + j * 72 + q * 8) = (u32x4){o1[0], o1[1], o1[2], o1[3]}; *(LAS u32x4*)(Kr + j * 72 + 32 + q * 8) = (u32x4){o2[0], o2[1], o2[2], o2[3]};
    }
    __syncthreads();
    const int il = 16 * w + fr, row = row0 + il, pos = c * 128 + il - PADR;
    bf16x8 qf[2], qs[2];
    {
        const u32x4 q1 = *(const u32x4*)(PA + (size_t)row * PAW + C_QR + hh * 64 + fq * 8), q2 = *(const u32x4*)(PA + (size_t)row * PAW + C_QR + hh * 64 + 32 + fq * 8);
        const unsigned w1[4] = {q1.x, q1.y, q1.z, q1.w}, w2[4] = {q2.x, q2.y, q2.z, q2.w};
        const float dsc = exp2f((float)(il + 1) * l2g);
        u32x4 o1, o2, s1, s2; unsigned r1[4], r2[4], t1[4], t2[4];
#pragma unroll
        for (int k = 0; k < 4; ++k) {
            float sa, ca, sb, cb; sincos_rev((float)pos * rope_inv(fq * 8 + 2 * k), sa, ca); sincos_rev((float)pos * rope_inv(fq * 8 + 2 * k + 1), sb, cb);
            const float x1a = bflo(w1[k]), x1b = bfhi(w1[k]), x2a = bflo(w2[k]), x2b = bfhi(w2[k]);
            const float y1a = x1a * ca - x2a * sa, y2a = x1a * sa + x2a * ca, y1b = x1b * cb - x2b * sb, y2b = x1b * sb + x2b * cb;
            r1[k] = cvt_pk_bf16(y1a, y1b); r2[k] = cvt_pk_bf16(y2a, y2b); t1[k] = cvt_pk_bf16(y1a * dsc, y1b * dsc); t2[k] = cvt_pk_bf16(y2a * dsc, y2b * dsc);
        }
        o1 = (u32x4){r1[0], r1[1], r1[2], r1[3]}; o2 = (u32x4){r2[0], r2[1], r2[2], r2[3]}; s1 = (u32x4){t1[0], t1[1], t1[2], t1[3]}; s2 = (u32x4){t2[0], t2[1], t2[2], t2[3]};
        qf[0] = __builtin_bit_cast(bf16x8, o1); qf[1] = __builtin_bit_cast(bf16x8, o2); qs[0] = __builtin_bit_cast(bf16x8, s1); qs[1] = __builtin_bit_cast(bf16x8, s2);
    }
    f32x4 sacc[8];
#pragma unroll
    for (int jt = 0; jt < 8; ++jt) {
        sacc[jt] = (f32x4){0.f, 0.f, 0.f, 0.f};
        if (jt <= w) {
#pragma unroll
            for (int ks = 0; ks < 2; ++ks) { const bf16x8 kf = *(const LAS bf16x8*)(Kr + (jt * 16 + fr) * 72 + ks * 32 + fq * 8); sacc[jt] = __builtin_amdgcn_mfma_f32_16x16x32_bf16(kf, qf[ks], sacc[jt], 0, 0, 0); }
        }
#pragma unroll
        for (int i = 0; i < 4; ++i) { const int dl = il - (jt * 16 + 4 * fq + i); sacc[jt][i] = (dl >= 0) ? sacc[jt][i] * exp2f((float)dl * l2g) : 0.f; }
    }
    f32x4 oacc[8];
#pragma unroll
    for (int et = 0; et < 8; ++et) oacc[et] = (f32x4){0.f, 0.f, 0.f, 0.f};
#pragma unroll
    for (int p = 0; p < 4; ++p) {
        if (2 * p <= w) {
            u32x4 pw; pw.x = cvt_pk_bf16(sacc[2 * p][0], sacc[2 * p][1]); pw.y = cvt_pk_bf16(sacc[2 * p][2], sacc[2 * p][3]); pw.z = cvt_pk_bf16(sacc[2 * p + 1][0], sacc[2 * p + 1][1]); pw.w = cvt_pk_bf16(sacc[2 * p + 1][2], sacc[2 * p + 1][3]);
            const bf16x8 pb = __builtin_bit_cast(bf16x8, pw);
#pragma unroll
            for (int et = 0; et < 8; ++et) {
                const u32x2 va = *(const LAS u32x2*)(Vt + (et * 16 + fr) * 136 + 32 * p + 4 * fq), vb = *(const LAS u32x2*)(Vt + (et * 16 + fr) * 136 + 32 * p + 16 + 4 * fq);
                const u32x4 vw = (u32x4){va.x, va.y, vb.x, vb.y};
                oacc[et] = __builtin_amdgcn_mfma_f32_16x16x32_bf16(__builtin_bit_cast(bf16x8, vw), pb, oacc[et], 0, 0, 0);
            }
        }
    }
    {
        const bf16_t* sb = ST + (size_t)item * 8192;
#pragma unroll
        for (int et = 0; et < 8; ++et)
#pragma unroll
            for (int ks = 0; ks < 2; ++ks) { const bf16x8 sf = *(const bf16x8*)(sb + (et * 16 + fr) * 64 + ks * 32 + fq * 8); oacc[et] = __builtin_amdgcn_mfma_f32_16x16x32_bf16(sf, qs[ks], oacc[et], 0, 0, 0); }
    }
    float sm = 0.f;
#pragma unroll
    for (int et = 0; et < 8; ++et) sm += (oacc[et][0] + oacc[et][1]) + (oacc[et][2] + oacc[et][3]);
    sm += __shfl_xor(sm, 16); sm += __shfl_xor(sm, 32);
    const float mu = sm * (1.0f / 128.0f); float vr = 0.f;
#pragma unroll
    for (int et = 0; et < 8; ++et) { const f32x4 d = oacc[et] - mu; vr += (d[0] * d[0] + d[1] * d[1]) + (d[2] * d[2] + d[3] * d[3]); }
    vr += __shfl_xor(vr, 16); vr += __shfl_xor(vr, 32);
    const float rstd = 1.0f / sqrtf(vr * (1.0f / 128.0f) + 1e-5f);
#pragma unroll
    for (int et = 0; et < 8; ++et) {
        const int e = et * 16 + 4 * fq; const f32x4 gn = *(const f32x4*)(a->in[I_RETN] + l * 512 + hh * 128 + e);
        const u32x2 gr = *(const u32x2*)(PA + (size_t)row * PAW + C_GR + hh * 128 + e);
        const f32x4 y = (oacc[et] - mu) * rstd * gn;
        u32x2 o; o.x = cvt_pk_bf16(y[0] * fsilu(bflo(gr.x)), y[1] * fsilu(bfhi(gr.x))); o.y = cvt_pk_bf16(y[2] * fsilu(bflo(gr.y)), y[3] * fsilu(bfhi(gr.y)));
        *(u32x2*)(OB2 + (size_t)row * OBS + hh * 128 + e) = o;
    }
    __syncthreads();
}


enum { TM_SWIGLU = 0, TM_RESID = 1, TM_PROJ = 2, TM_BRANCH = 3 };
constexpr int TROW0 = 16384;
struct TailArgs { const bf16_t* A; const bf16_t* Bt; int K, N; bf16_t* O1; bf16_t* O2; float* X; const float* ss; float* ssn; const bf16_t* GT; float scale; };
template <int MODE> __device__ __forceinline__ void tail_gemm(const TailArgs& t, int u0, int G, LAS unsigned char* lds) {
    const int tid = tid_opaque(), lane = tid & 63, w = __builtin_amdgcn_readfirstlane(tid >> 6), fr = lane & 15, fq = lane >> 4;
    LAS float* part = (LAS float*)lds;
    const int K = t.K, nu = 8 * (t.N / 64);
    int ks0, nks;
    if (MODE == TM_BRANCH) { if (w < 6) { const int q = w % 3; ks0 = 16 * (w / 3) + (q == 0 ? 0 : (q == 1 ? 6 : 11)); nks = (q == 0) ? 6 : 5; } else { ks0 = 32 + 8 * (w - 6); nks = 8; } }
    else { nks = K / 256; ks0 = w * nks; }
    bf16x8 af[4][3], bfr[4][4];
#define TG_LOAD(uu, s0) do { const int rowb_ = TROW0 + 48 * ((uu) & 7), cgp_ = (uu) >> 3; \
        _Pragma("unroll") for (int sI = 0; sI < 4; ++sI) { if ((s0) + sI < nks) { const int kk = (ks0 + (s0) + sI) * 32 + 8 * fq; \
            _Pragma("unroll") for (int rt = 0; rt < 3; ++rt) af[sI][rt] = *(const bf16x8*)(t.A + (size_t)(rowb_ + 16 * rt + fr) * K + kk); \
            _Pragma("unroll") for (int ct = 0; ct < 4; ++ct) { const int brow = (MODE == TM_SWIGLU) ? 256 * (cgp_ >> 2) + (ct >> 1) * 128 + 32 * (cgp_ & 3) + 16 * (ct & 1) : 64 * cgp_ + 16 * ct; \
                bfr[sI][ct] = *(const bf16x8*)(t.Bt + (size_t)(brow + fr) * K + kk); } } } } while (0)
#define TG_MMA(s0) do { _Pragma("unroll") for (int sI = 0; sI < 4; ++sI) { if ((s0) + sI < nks) { _Pragma("unroll") for (int rt = 0; rt < 3; ++rt) _Pragma("unroll") for (int ct = 0; ct < 4; ++ct) \
            acc[rt][ct] = __builtin_amdgcn_mfma_f32_16x16x32_bf16(af[sI][rt], bfr[sI][ct], acc[rt][ct], 0, 0, 0); } } } while (0)
#pragma unroll 1
    for (int u = u0; u < nu; u += G) {
        const int rg = u & 7, cgp = u >> 3, rowb0 = TROW0 + 48 * rg;
        f32x4 acc[3][4];
#pragma unroll
        for (int rt = 0; rt < 3; ++rt)
#pragma unroll
            for (int ct = 0; ct < 4; ++ct) acc[rt][ct] = (f32x4){0.f, 0.f, 0.f, 0.f};
#pragma unroll 1
        for (int s0 = 0; s0 < nks; s0 += 4) { TG_LOAD(u, s0); TG_MMA(s0); }
#pragma unroll
        for (int rt = 0; rt < 3; ++rt)
#pragma unroll
            for (int ct = 0; ct < 4; ++ct) *(LAS f32x4*)(part + ((w * 12 + rt * 4 + ct) * 64 + lane) * 4) = acc[rt][ct];
        __syncthreads();
        if (w < 3) {
            const int rowb = rowb0 + 16 * w;
            f32x4 sum[4], tot[4];
#pragma unroll
            for (int ct = 0; ct < 4; ++ct) {
                f32x4 p[8];
#pragma unroll
                for (int q = 0; q < 8; ++q) p[q] = *(const LAS f32x4*)(part + ((q * 12 + w * 4 + ct) * 64 + lane) * 4);
                if (MODE == TM_BRANCH) {
                    const f32x4 pa = (p[0] + p[1]) + p[2], pb = (p[3] + p[4]) + p[5], pc = p[6] + p[7];
#pragma unroll
                    for (int i = 0; i < 4; ++i) { const bf16_t* gp = t.GT + (size_t)(rowb + 4 * fq + i) * 3072 + 64 * cgp + 16 * ct + fr; tot[ct][i] = pa[i] * bf2f(gp[0]) + pb[i] * bf2f(gp[1024]) + pc[i] * bf2f(gp[2048]); }
                } else sum[ct] = ((p[0] + p[1]) + (p[2] + p[3])) + ((p[4] + p[5]) + (p[6] + p[7]));
            }
            (void)sum; (void)tot;
            if (MODE == TM_SWIGLU) {
#pragma unroll
                for (int i = 0; i < 4; ++i) {
                    const int row = rowb + 4 * fq + i; const float rs = t.ss[row];
#pragma unroll
                    for (int c2 = 0; c2 < 2; ++c2) t.O1[(size_t)row * 2048 + 128 * (cgp >> 2) + 32 * (cgp & 3) + 16 * c2 + fr] = f2bf(fsilu(sum[c2][i] * rs) * (sum[2 + c2][i] * rs));
                }
            } else if (MODE == TM_RESID) {
#pragma unroll
                for (int i = 0; i < 4; ++i) {
                    const int row = rowb + 4 * fq + i; float sq = 0.f;
#pragma unroll
                    for (int ct = 0; ct < 4; ++ct) {
                        const size_t off = (size_t)row * 1024 + 64 * cgp + 16 * ct + fr;
                        const float x = t.X[off] + sum[ct][i] * t.scale; t.X[off] = x; t.O1[off] = f2bf(x); sq += x * x;
                    }
                    sq += __shfl_xor(sq, 1); sq += __shfl_xor(sq, 2); sq += __shfl_xor(sq, 4); sq += __shfl_xor(sq, 8);
                    if (fr == 0) t.ssn[(size_t)row * 16 + cgp] = sq;
                }
            } else if (MODE == TM_PROJ) {
                const bool gate = 64 * cgp >= PAW;
#pragma unroll
                for (int i = 0; i < 4; ++i) {
                    const int row = rowb + 4 * fq + i; const float rs = t.ss[row];
#pragma unroll
                    for (int ct = 0; ct < 4; ++ct) {
                        const int col = 64 * cgp + 16 * ct + fr; const float v = sum[ct][i] * rs;
                        if (gate) t.O2[(size_t)row * GTW + (col - PAW)] = f2bf(fsigmoid(v)); else t.O1[(size_t)row * PAW + col] = f2bf(v);
                    }
                }
            } else {
#pragma unroll
                for (int i = 0; i < 4; ++i)
#pragma unroll
                    for (int ct = 0; ct < 4; ++ct) t.O1[(size_t)(rowb + 4 * fq + i) * 1024 + 64 * cgp + 16 * ct + fr] = f2bf(tot[ct][i]);
            }
        }
        __syncthreads();
    }
#undef TG_LOAD
#undef TG_MMA
}

__device__ __forceinline__ void carry_item(CArgs* a, int l, int it, const float* LSUM, float* LCAR, const float* U, bf16_t* ST) {
    const int tid = tid_opaque();
    if (it < 2) {
        const int b = it, ch = tid; float h = 0.f;
#pragma unroll 1
        for (int n0 = 0; n0 < NT; n0 += 13) {
            float p[13], q[13];
#pragma unroll
            for (int k = 0; k < 13; ++k) { const size_t o = (size_t)(b * NT + n0 + k) * 512 + ch; p[k] = LSUM[o * 2]; q[k] = LSUM[o * 2 + 1]; }
#pragma unroll
            for (int k = 0; k < 13; ++k) { LCAR[(size_t)(b * NT + n0 + k) * 512 + ch] = h; h = p[k] * h + q[k]; }
        }
        a->out[O_PL + (l * 2 + b) * 512 + ch] = h;
    } else {
        const int eid = (it - 2) * 512 + tid; const int b = eid >> 15, hh = (eid >> 13) & 3, de = eid & 8191, e = de >> 6, d = de & 63;
        const float g128 = exp2f(128.0f * log2_gamma(hh)); float s = 0.f;
#pragma unroll 1
        for (int c0 = 0; c0 < NT; c0 += 13) {
            float u[13];
#pragma unroll
            for (int k = 0; k < 13; ++k) u[k] = U[(size_t)((b * NT + c0 + k) * 4 + hh) * 8192 + de];
#pragma unroll
            for (int k = 0; k < 13; ++k) { ST[(size_t)((b * NT + c0 + k) * 4 + hh) * 8192 + de] = f2bf(s); s = g128 * s + u[k]; }
        }
        a->out[O_PR + ((size_t)(l * 2 + b) * 4 + hh) * 8192 + d * 128 + e] = s;
    }
}

__device__ __forceinline__ void sample_item(CArgs* a, int l, int j, const bf16_t* PA, bf16_t* OB1, bf16_t* OB2, LAS unsigned char* lds) {
    const int tid = tid_opaque(), lane = tid & 63, w = tid >> 6; const int row = SROW0 + j;
    LAS float* q_s = (LAS float*)lds;
    LAS float* p_s = q_s + 512;
    LAS float* rq_s = p_s + 8 * 132;
    LAS float* rk_s = rq_s + 256;
    LAS float* red_s = rk_s + 256;
    const float* ck = a->in[I_CK] + (size_t)(l * 128 + j) * 16384; const float* cv = a->in[I_CV] + (size_t)(l * 128 + j) * 16384;
    const bf16_t* pr = PA + (size_t)row * PAW;
    q_s[tid] = bf2f(pr[C_QS + tid]);
    if (tid < 128) {
        const int hh = tid >> 5, i = tid & 31; float s, co; sincos_rev(8192.0f * rope_inv(i), s, co);
        const float q1 = bf2f(pr[C_QR + hh * 64 + i]), q2 = bf2f(pr[C_QR + hh * 64 + i + 32]), k1 = bf2f(pr[C_KR + hh * 64 + i]), k2 = bf2f(pr[C_KR + hh * 64 + i + 32]);
        rq_s[hh * 64 + i] = q1 * co - q2 * s; rq_s[hh * 64 + i + 32] = q1 * s + q2 * co;
        rk_s[hh * 64 + i] = (k1 * co - k2 * s) * 0.125f; rk_s[hh * 64 + i + 32] = (k1 * s + k2 * co) * 0.125f;
    }
    {
        float* ok = a->out + O_SK + (size_t)(l * 128 + j) * 16384; float* ov = a->out + O_SV + (size_t)(l * 128 + j) * 16384;
        f32x4 ckv[8], cvv[8];
#pragma unroll
        for (int k = 0; k < 8; ++k) { const int i = tid + k * NTHR; if (i < 127 * 32) { ckv[k] = __builtin_nontemporal_load((const f32x4*)ck + 32 + i); cvv[k] = __builtin_nontemporal_load((const f32x4*)cv + 32 + i); } }
#pragma unroll
        for (int k = 0; k < 8; ++k) { const int i = tid + k * NTHR; if (i < 127 * 32) { __builtin_nontemporal_store(ckv[k], (f32x4*)ok + i); __builtin_nontemporal_store(cvv[k], (f32x4*)ov + i); } }
        if (tid < 128) { ok[127 * 128 + tid] = bf2f(pr[C_KS + tid]); ov[127 * 128 + tid] = bf2f(pr[C_VS + tid]); }
    }
    __syncthreads();
    {
        const int h = w, kvh = h >> 2; const float sink = a->in[I_SINK][l * 8 + h];
        float sc[3]; sc[2] = -INFINITY;
#pragma unroll
        for (int t = 0; t < 2; ++t) {
            const int s = lane + 64 * t; const f32x4* kp = (const f32x4*)(ck + (size_t)s * 128 + kvh * 64); float d = 0.f;
#pragma unroll
            for (int q = 0; q < 16; ++q) { const f32x4 k = kp[q]; const f32x4 qq = *(const LAS f32x4*)(q_s + h * 64 + q * 4); d += (k[0] * qq[0] + k[1] * qq[1]) + (k[2] * qq[2] + k[3] * qq[3]); }
            sc[t] = (s == 0) ? -INFINITY : d * 0.125f;
        }
        {
            sc[2] = wave_sum(bf2f(pr[C_KS + kvh * 64 + lane]) * q_s[h * 64 + lane]) * 0.125f;
        }
        float mx = fmaxf(fmaxf(sc[0], sc[1]), sc[2]);
#pragma unroll
        for (int o = 1; o < 64; o <<= 1) mx = fmaxf(mx, __shfl_xor(mx, o));
        const float mm = fmaxf(mx, sink);
        const float e0 = __expf(sc[0] - mm), e1 = __expf(sc[1] - mm), e2 = __expf(sc[2] - mm);
        const float sum = wave_sum(e0 + e1) + e2; const float inv = 1.0f / (sum + __expf(sink - mm));
        p_s[h * 132 + lane] = e0 * inv; p_s[h * 132 + 64 + lane] = e1 * inv; if (lane == 0) p_s[h * 132 + 128] = e2 * inv;
        LDSW();
        float o = p_s[h * 132 + 128] * bf2f(pr[C_VS + kvh * 64 + lane]);
#pragma unroll 32
        for (int s = 0; s < 128; ++s) o += p_s[h * 132 + s] * cv[(size_t)s * 128 + kvh * 64 + lane];
        OB1[(size_t)row * OBS + h * 64 + lane] = f2bf(o);
    }
    {
        const int hh = tid >> 7, e = tid & 127; const float gam = 1.0f - exp2f(-5.0f - (float)hh);
        const float* S = a->in[I_SRET] + ((size_t)(l * 128 + j) * 4 + hh) * 8192; float* So = a->out + O_SR + ((size_t)(l * 128 + j) * 4 + hh) * 8192;
        const float v = bf2f(pr[C_VR + hh * 128 + e]); float acc = 0.f, qk = 0.f;
#pragma unroll 32
        for (int d = 0; d < 64; ++d) { const float s = __builtin_nontemporal_load(&S[d * 128 + e]); const float q = rq_s[hh * 64 + d], k = rk_s[hh * 64 + d]; acc += q * s; qk += q * k; __builtin_nontemporal_store(gam * s + k * v, &So[d * 128 + e]); }
        const float o = qk * v + gam * acc;
        float sm = wave_sum(o); if (lane == 0) red_s[w * 2] = sm;
        __syncthreads();
        const float mu = (red_s[(w & ~1) * 2] + red_s[(w | 1) * 2]) * (1.0f / 128.0f); const float dv = o - mu;
        float vs = wave_sum(dv * dv); if (lane == 0) red_s[w * 2 + 1] = vs;
        __syncthreads();
        const float var = (red_s[(w & ~1) * 2 + 1] + red_s[(w | 1) * 2 + 1]) * (1.0f / 128.0f);
        const float y = dv * (1.0f / sqrtf(var + 1e-5f)) * a->in[I_RETN][l * 512 + hh * 128 + e] * fsilu(bf2f(pr[C_GR + hh * 128 + e]));
        OB2[(size_t)row * OBS + hh * 128 + e] = f2bf(y);
    }
    __syncthreads();
}

#define GAS __attribute__((address_space(1)))
#define XB_TMO      128
#define XB_XCNT(j)  (256  + 64 * (j))
#define XB_XSUB(j)  (1280 + 64 * (j))
#define XB_XGEN(j)  (2304 + 64 * (j))
#define XB_TOP      3328
#define XB_TOPGEN   3392
#define XCD_BAR_WORDS 3456
#define XB_SPIN_CAP (1u << 18)

__device__ __forceinline__ unsigned xb_ld(unsigned* p)              { return __hip_atomic_load(p, __ATOMIC_RELAXED, __HIP_MEMORY_SCOPE_AGENT); }
__device__ __forceinline__ unsigned xb_add(unsigned* p, unsigned v) { return __hip_atomic_fetch_add(p, v, __ATOMIC_RELAXED, __HIP_MEMORY_SCOPE_AGENT); }
__device__ __forceinline__ unsigned xb_xcc_id() { return (unsigned)__builtin_amdgcn_s_getreg((3 << 11) | 20) & 0xFu; }
#define XB_SPIN(cond, bar) do { unsigned _sp = 0; while (cond) { __builtin_amdgcn_s_sleep(1); \
    if ((++_sp & 255u) == 0u) { if (xb_ld(&(bar)[XB_TMO])) break; if (_sp > XB_SPIN_CAP) { atomicAdd(&(bar)[XB_TMO], 1u); break; } } } } while (0)

struct XcdBarrier {
    unsigned* bar; unsigned x;
    volatile LAS unsigned* st;
};

__device__ __forceinline__ XcdBarrier xcd_barrier_post(unsigned* bar, volatile LAS unsigned* st) {
    XcdBarrier b; b.bar = bar; b.x = xb_xcc_id(); b.st = st;
    if (threadIdx.x == 0) (void)xb_add(&bar[XB_XCNT(b.x)], 1u);
    return b;
}
__device__ __forceinline__ void xcd_barrier_complete(unsigned* bar, unsigned x, unsigned& nloc, unsigned& nx) {
    const unsigned G = gridDim.x * gridDim.y * gridDim.z;
    unsigned sum, cnt, mine, sp = 0u;
    for (;;) {
        sum = 0u; cnt = 0u; mine = 0u;
#pragma unroll
        for (unsigned j = 0; j < 16; ++j) { const unsigned c = xb_ld(&bar[XB_XCNT(j)]); sum += c; cnt += (c > 0u) ? 1u : 0u; mine = (j == x) ? c : mine; }
        if (sum == G) break;
        __builtin_amdgcn_s_sleep(1);
        if ((++sp & 255u) == 0u) { if (xb_ld(&bar[XB_TMO])) break; if (sp > XB_SPIN_CAP) { atomicAdd(&bar[XB_TMO], 1u); break; } }
    }
    nloc = mine > 0u ? mine : 1u; nx = cnt > 0u ? cnt : 1u;
}

__device__ __forceinline__ void xcd_barrier(const XcdBarrier& b) {
    asm volatile("s_waitcnt vmcnt(0)" ::: "memory");
    __syncthreads();
    if (threadIdx.x == 0) {
        unsigned* bar = b.bar;
        __builtin_amdgcn_s_waitcnt(0);
        unsigned nloc = b.st[0], nx = b.st[1];
        if (nloc == 0u) { xcd_barrier_complete(bar, b.x, nloc, nx); b.st[0] = nloc; b.st[1] = nx; }
        const unsigned old = xb_add(&bar[XB_XSUB(b.x)], 1u);
        const unsigned gen = old / nloc;
        if (old + 1u == (gen + 1u) * nloc) {
            __builtin_amdgcn_fence(__ATOMIC_RELEASE, "agent");
            asm volatile("s_waitcnt vmcnt(0)" ::: "memory");
            const unsigned og = xb_add(&bar[XB_TOP], 1u);
            const unsigned tg = og / nx;
            if (og + 1u == (tg + 1u) * nx) xb_add(&bar[XB_TOPGEN], 1u);
            else XB_SPIN(xb_ld(&bar[XB_TOPGEN]) == tg, bar);
            __builtin_amdgcn_fence(__ATOMIC_ACQUIRE, "agent");
            xb_add(&bar[XB_XGEN(b.x)], 1u);
            asm volatile("s_waitcnt vmcnt(0)" ::: "memory");
        } else {
            XB_SPIN(xb_ld(&bar[XB_XGEN(b.x)]) == gen, bar);
            __builtin_amdgcn_fence(__ATOMIC_ACQUIRE, "agent");
            asm volatile("s_waitcnt vmcnt(0)" ::: "memory");
        }
    }
    __syncthreads();
}


template <class Sched> __device__ __forceinline__ void rs_prestep(const Sched& S, const float* ss, float* rs) {
    const int tid = tid_opaque();
    int pmv[8];
#pragma unroll
    for (int i = 0; i < 8; ++i) { pg8::Unit u; pmv[i] = S.next(i, u) ? u.pm : -1; }
    const int r0 = (tid < 256) ? tid : TROW0 + (tid - 256);
    float v[9];
#pragma unroll
    for (int i = 0; i < 8; ++i) { v[i] = 0.f; if (tid < 256 && pmv[i] >= 0) v[i] = pg8::row_ss(ss, pmv[i] * 256 + tid); }
    v[8] = 0.f; if (tid >= 256) v[8] = pg8::row_ss(ss, r0);
    float v9 = 0.f; if (tid < 128) v9 = pg8::row_ss(ss, TROW0 + 256 + tid);
#pragma unroll
    for (int i = 0; i < 8; ++i) if (tid < 256 && pmv[i] >= 0) rs[pmv[i] * 256 + tid] = __builtin_amdgcn_rsqf(v[i] * (1.0f / 1024.0f) + 1e-6f);
    if (tid >= 256) rs[r0] = __builtin_amdgcn_rsqf(v[8] * (1.0f / 1024.0f) + 1e-6f);
    if (tid < 128) rs[TROW0 + 256 + tid] = __builtin_amdgcn_rsqf(v9 * (1.0f / 1024.0f) + 1e-6f);
    asm volatile("s_waitcnt vmcnt(0)" ::: "memory");
    __syncthreads();
}

#define R_GU 1
#define R_WIN 1
#define R_MIX1 1
#define R_CARRY 1
#define R_MIX2 1
#define R_XSYNC 0
__global__ void __launch_bounds__(NTHR, 2) mk_fwd(Args a_unused) {
    extern __shared__ __attribute__((aligned(16))) unsigned char lds_raw[];
    LAS unsigned char* lds = (LAS unsigned char*)lds_raw;
    cg::grid_group grid = cg::this_grid();
    CArgs* kp0 = (CArgs*)__builtin_amdgcn_kernarg_segment_ptr();
    if (threadIdx.x < 64) ((LAS unsigned*)(lds + 131072))[threadIdx.x] = 0u;
    __syncthreads();
    XcdBarrier xbar; xbar.bar = (unsigned*)(kp0->ws + WS_BAR); xbar.x = 0; xbar.st = (volatile LAS unsigned*)(lds + 131072);
    const int lo = kp0->ph_lo, hi = kp0->ph_hi; int ph = 0;
#define PH_PTRS int tid = threadIdx.x; asm volatile("" : "+v"(tid)); const int lane = tid & 63, wave = __builtin_amdgcn_readfirstlane(tid >> 6); \
    int bid_ = blockIdx.x; asm volatile("" : "+s"(bid_)); const int G = gridDim.x, bid = bid_, gw = bid * 8 + wave, ngw = G * 8; (void)lane; (void)gw; (void)ngw; CArgs* a = kp0; asm volatile("" : "+s"(a)); unsigned char* ws = a->ws; \
    float* SS = (float*)(ws + WS_SS16); float* LSUM = (float*)(ws + WS_LSUM); float* LCAR = (float*)(ws + WS_LCAR); \
    float* X = (float*)(ws + WS_X); bf16_t* XB = (bf16_t*)(ws + WS_XB); bf16_t* PA = (bf16_t*)(ws + WS_PA); bf16_t* HB = PA; bf16_t* MB = (bf16_t*)(ws + WS_PA); \
    bf16_t* GT = (bf16_t*)(ws + WS_GT); bf16_t* OB = (bf16_t*)(ws + WS_OB); float* U = (float*)(ws + WS_U); float* AG = (float*)(ws + WS_XB); float* BG = (float*)(ws + WS_BG); (void)AG; (void)BG; bf16_t* ST = (bf16_t*)(ws + WS_ST); \
    unsigned char* wb = ws + WS_W0 + (size_t)(l & 1) * WSZ; \
    float* RS = (float*)(ws + WS_RS); const float* rs0 = RS + (size_t)(3 * l) * MP; float* rs1 = RS + (size_t)(3 * l + 1) * MP; float* rs2 = RS + (size_t)(3 * l + 2) * MP; float* rs3 = RS + (size_t)(3 * l + 3) * MP; (void)rs0; (void)rs1; (void)rs2; (void)rs3; \
    const float* ss0 = SS + (size_t)(3 * l) * MP * 16; float* ss1 = SS + (size_t)(3 * l + 1) * MP * 16; float* ss2 = SS + (size_t)(3 * l + 2) * MP * 16; float* ss3 = SS + (size_t)(3 * l + 3) * MP * 16; \
    (void)SS; (void)LSUM; (void)LCAR; (void)X; (void)XB; (void)PA; (void)HB; (void)MB; (void)GT; (void)OB; (void)U; (void)ST; (void)wb; (void)ss0; (void)ss1; (void)ss2; (void)ss3;
#define PH_BEGIN(n) if (ph >= lo && ph < hi) { PH_PTRS for (int rep_ = 0; rep_ < (n); ++rep_) {
#define PH_END if (ph + 1 < hi) { if (ph == 0) { asm volatile("s_waitcnt vmcnt(0)" ::: "memory"); grid.sync(); xbar = xcd_barrier_post((unsigned*)(kp0->ws + WS_BAR), (volatile LAS unsigned*)(lds + 131072)); } else xcd_barrier(xbar); } } } ++ph;

    { const int l = 0;
    PH_BEGIN(1)
        if (bid == 0) { for (int i = tid; i < XCD_BAR_WORDS; i += NTHR) ((unsigned*)(ws + WS_BAR))[i] = 0u; }
        init_rows(a, X, XB, SS, RS, OB, gw, ngw, lane);
        convert_layer(a, 0, ws + WS_W0, lds, gw, ngw, wave, lane);
    PH_END
    }

#pragma unroll 1
    for (int l = 0; l < DEPTH; ++l) {
        PH_BEGIN(R_GU)
            pg8::Gemm g{XB, (const bf16_t*)(wb + W_GU1), TROW0, 4096, DM, 1, 0}; pg8::StaticOrder S; S.init(TROW0, 4096, G, bid);
            rs_prestep(S, ss0, RS + (size_t)(3 * l) * MP);
            pg8::EpiSwiGLU E{HB, rs0}; pg8::gemm_phase<pg8::EpiSwiGLU, pg8::StaticOrder, true, true>(lds, g, S, E);
            { const TailArgs ta{XB, (const bf16_t*)(wb + W_GU1), DM, 4096, HB, nullptr, nullptr, rs0, nullptr, nullptr, 0.f}; tail_gemm<TM_SWIGLU>(ta, bid, G, lds); }
        PH_END
        PH_BEGIN(1)
            pg8::Gemm g{HB, (const bf16_t*)(wb + W_D1), TROW0, DM, FF, 1, 0}; pg8::StaticOrder S; S.init(TROW0, DM, G, bid);
            pg8::EpiResid E{X, XB, ss1, 0.5f}; pg8::gemm_phase<pg8::EpiResid, pg8::StaticOrder, true, true>(lds, g, S, E);
            { const TailArgs ta{HB, (const bf16_t*)(wb + W_D1), FF, DM, XB, nullptr, X, nullptr, ss1, nullptr, 0.5f}; tail_gemm<TM_RESID>(ta, bid, G, lds); }
        PH_END
        PH_BEGIN(R_WIN)
            pg8::Gemm g{XB, (const bf16_t*)(wb + W_IN), TROW0, NIN, DM, 1, 0}; pg8::StaticOrder S; S.init(TROW0, NIN, G, bid);
            rs_prestep(S, ss1, rs1);
            pg8::EpiProj E{PA, GT, rs1}; pg8::gemm_phase<pg8::EpiProj, pg8::StaticOrder, true, true>(lds, g, S, E);
            { const TailArgs ta{XB, (const bf16_t*)(wb + W_IN), DM, NIN, PA, GT, nullptr, rs1, nullptr, nullptr, 0.f}; if (G == 256) { if (bid >= 64) tail_gemm<TM_PROJ>(ta, bid - 64, 192, lds); } else tail_gemm<TM_PROJ>(ta, bid, G, lds); }
        PH_END
        PH_BEGIN(R_MIX1)
            for (int it = bid; it < 1048 + 520 + 260; it += G) {
                if (it < 1048) lru1_item(a, l, it >> 3, it & 7, PA, OB, LSUM, AG, BG, lds);
                else if (it < 1048 + 520) ret_u_item(it - 1048, PA, U, lds);
                else swa_item(a, l, it - (1048 + 520), PA, OB + 512, lds);
            }
        PH_END
        PH_BEGIN(R_CARRY)
            for (int it = bid; it < 130; it += G) carry_item(a, l, it, LSUM, LCAR, U, ST);
            if (G == 256) { if (bid >= 128) sample_item(a, l, bid - 128, PA, OB + 512, OB + 1024, lds); } else { for (int it = bid; it < 128; it += G) sample_item(a, l, it, PA, OB + 512, OB + 1024, lds); }
            if (l + 1 < DEPTH) {
                __syncthreads();
                const int nsh = (G == 256) ? (bid < 128 ? 3 : 1) : 1, sh0 = (G == 256) ? (bid < 128 ? bid * 3 : 384 + (bid - 128)) : bid, nshares = (G == 256) ? 512 : G;
#pragma unroll 1
                for (int v = 0; v < nsh; ++v) convert_layer(a, l + 1, ws + WS_W0 + (size_t)((l + 1) & 1) * WSZ, lds, (sh0 + v) * 8 + wave, nshares * 8, wave, lane);
            }
        PH_END
        PH_BEGIN(R_MIX2)
            for (int it = bid; it < 520 + 1040; it += G) {
                if (it < 520) ret_out_item(a, l, it, PA, ST, OB + 1024, lds);
                else { const int q = it - 520; lru2_item(q >> 3, q & 7, PA, OB, LCAR, AG, BG, lds); }
            }
        PH_END
        PH_BEGIN(1)
            pg8::Gemm g{OB, (const bf16_t*)(wb + W_BR), TROW0, DM, OBS, 1, 0}; pg8::StaticOrder S; S.init(TROW0, DM, G, bid);
            pg8::EpiBranch E{MB, GT}; pg8::gemm_phase<pg8::EpiBranch, pg8::StaticOrder, true, true>(lds, g, S, E);
            { const TailArgs ta{OB, (const bf16_t*)(wb + W_BR), OBS, DM, MB, nullptr, nullptr, nullptr, nullptr, GT, 0.f}; tail_gemm<TM_BRANCH>(ta, bid, G, lds); }
        PH_END
        PH_BEGIN(1)
            pg8::Gemm g{MB, (const bf16_t*)(wb + W_OUT), TROW0, DM, DM, 1, 0}; pg8::StaticOrder S; S.init(TROW0, DM, G, bid);
            pg8::EpiResid E{X, XB, ss2, 1.0f}; pg8::gemm_phase<pg8::EpiResid, pg8::StaticOrder, true, true>(lds, g, S, E);
            { const TailArgs ta{MB, (const bf16_t*)(wb + W_OUT), DM, DM, XB, nullptr, X, nullptr, ss2, nullptr, 1.0f}; tail_gemm<TM_RESID>(ta, bid, G, lds); }
        PH_END
        PH_BEGIN(1)
            for (int xs_ = 0; xs_ < R_XSYNC; ++xs_) grid.sync();
            pg8::Gemm g{XB, (const bf16_t*)(wb + W_GU2), TROW0, 4096, DM, 1, 0}; pg8::StaticOrder S; S.init(TROW0, 4096, G, bid);
            rs_prestep(S, ss2, rs2);
            pg8::EpiSwiGLU E{HB, rs2}; pg8::gemm_phase<pg8::EpiSwiGLU, pg8::StaticOrder, true, true>(lds, g, S, E);
            { const TailArgs ta{XB, (const bf16_t*)(wb + W_GU2), DM, 4096, HB, nullptr, nullptr, rs2, nullptr, nullptr, 0.f}; tail_gemm<TM_SWIGLU>(ta, bid, G, lds); }
        PH_END
        PH_BEGIN(1)
            pg8::Gemm g{HB, (const bf16_t*)(wb + W_D2), TROW0, DM, FF, 1, 0}; pg8::StaticOrder S; S.init(TROW0, DM, G, bid);
            pg8::EpiResid E{X, XB, ss3, 0.5f}; pg8::gemm_phase<pg8::EpiResid, pg8::StaticOrder, true, true>(lds, g, S, E);
            { const TailArgs ta{HB, (const bf16_t*)(wb + W_D2), FF, DM, XB, nullptr, X, nullptr, ss3, nullptr, 0.5f}; tail_gemm<TM_RESID>(ta, bid, G, lds); }
        PH_END
    }
    { const int l = 0;
    PH_BEGIN(1)
        const float* ssf = SS + (size_t)12 * MP * 16; const float* gf = a->in[I_FINN];
        for (int r = gw; r < MREAL; r += ngw) {
            float* dst = nullptr;
            if (r < 2 * BROWS) { const int b = r / BROWS, pr = r % BROWS; if (pr >= PADR + 16) dst = a->out + O_YP + ((size_t)b * 8192 + (pr - PADR - 16)) * DM; }
            else dst = a->out + O_YS + (size_t)(r - SROW0) * DM;
            if (dst) {
                const float rs = __builtin_amdgcn_rsqf(pg8::row_ss(ssf, r) * (1.0f / 1024.0f) + 1e-6f);
#pragma unroll
                for (int j = 0; j < 4; ++j) { const f32x4 v = *((const f32x4*)(X + (size_t)r * DM) + lane + 64 * j); const f32x4 gg = *((const f32x4*)gf + lane + 64 * j); __builtin_nontemporal_store(v * rs * gg, (f32x4*)dst + lane + 64 * j); }
            }
        }
    PH_END
    }
#undef PH_BEGIN
#undef PH_END
}
constexpr int NPHASES = 2 + 10 * DEPTH;

#ifndef MK_MULTI
#define MK_MULTI 0
#endif
extern "C" void kernel_launch(void* const* d_in, const int* in_sizes, int n_in, void* d_out, int out_size, void* d_ws, size_t ws_size, hipStream_t stream) {
    static int grid = 0;
    if (grid == 0) {
        if (n_in != 30 || ws_size < WS_END) { fprintf(stderr, "kernel_launch: unexpected inputs (n_in %d, ws %zu < %zu)\n", n_in, ws_size, (size_t)WS_END); grid = -1; return; }
        int dev = 0, cus = 0, per_cu = 0;
        (void)hipGetDevice(&dev); (void)hipDeviceGetAttribute(&cus, hipDeviceAttributeMultiprocessorCount, dev);
        if (hipFuncSetAttribute((const void*)mk_fwd, hipFuncAttributeMaxDynamicSharedMemorySize, LDS_BYTES) != hipSuccess) { fprintf(stderr, "kernel_launch: hipFuncSetAttribute failed\n"); grid = -1; return; }
        if (hipOccupancyMaxActiveBlocksPerMultiprocessor(&per_cu, (const void*)mk_fwd, NTHR, LDS_BYTES) != hipSuccess || per_cu < 1) { fprintf(stderr, "kernel_launch: occupancy query says %d\n", per_cu); per_cu = 1; }
        (void)hipGetLastError();
        grid = cus * 1;
        if (grid <= 0) grid = 256;
    }
    if (grid < 0) return;
    Args a{};
    for (int i = 0; i < 30; ++i) a.in[i] = (const float*)d_in[i];
    a.out = (float*)d_out; a.ws = (unsigned char*)d_ws;
#if MK_MULTI
    for (int p = 0; p < NPHASES; ++p) { a.ph_lo = p; a.ph_hi = p + 1; hipLaunchKernelGGL(mk_fwd, dim3(grid), dim3(NTHR), LDS_BYTES, stream, a); }
#else
    a.ph_lo = 0; a.ph_hi = NPHASES;
    void* args[] = {&a};
    hipError_t e = hipLaunchCooperativeKernel((const void*)mk_fwd, dim3(grid), dim3(NTHR), args, LDS_BYTES, stream);
    if (e != hipSuccess) fprintf(stderr, "cooperative launch failed: %s (grid %d)\n", hipGetErrorString(e), grid);
#endif
}
```

```cpp
#include <hip/hip_runtime.h>
#include <hip/hip_cooperative_groups.h>
#include <cstdio>
#include <cstdint>
#include <cmath>
namespace cg = cooperative_groups;

namespace pg8 {
#define PG8_LAS __attribute__((address_space(3)))
typedef unsigned short bf16_t;
typedef short bf16x8 __attribute__((ext_vector_type(8)));
typedef float f32x4 __attribute__((ext_vector_type(4)));
typedef unsigned u32x4 __attribute__((ext_vector_type(4)));
constexpr int BM = 256, BK = 64, HALF = 128, HTB = HALF * BK * 2  , STAGE_BYTES = 8 * HTB, NXCD = 8, WGM = 8;

__host__ __device__ __forceinline__ int lds_byte(int r, int c) { const int st = (r >> 4) * 2 + (c >> 5), rr = r & 15, cc = c & 31, ob = rr * 64 + cc * 2; return st * 1024 + (ob ^ (((ob >> 9) & 1) << 5)); }
__host__ __device__ __forceinline__ void stage_rc(int b, int& R, int& C) { const int st = b / 1024, sb = b % 1024, swz = sb ^ (((sb >> 9) & 1) << 5); R = (st >> 1) * 16 + swz / 64; C = (st & 1) * 32 + (swz % 64) / 2; }
__host__ __device__ __forceinline__ int perm32(int rho) { const int n = rho >> 4, i = rho & 15; return 8 * (i >> 2) + 4 * n + (i & 3); }

struct Unit { int pm, pn; };
struct Gemm { const bf16_t* A; const bf16_t* Bt; int M, N, K; int agdiv; size_t agstride; };

struct StaticOrder {
    int nM, nN, nwg, G, c;
    __host__ __device__ void init(int M, int N, int G_, int c_) { nM = M / BM; nN = N / BM; nwg = nM * nN; G = G_; c = c_; }
    __host__ __device__ bool next(int i, Unit& u) const {
        const long L = (long)i * G + c; if (L >= nwg) return false;
        int wgid = (int)L; { const int q = nwg / NXCD, r = nwg % NXCD, xcd = wgid % NXCD, off = wgid / NXCD; wgid = (xcd < r ? xcd * (q + 1) : r * (q + 1) + (xcd - r) * q) + off; }
        const int nig = WGM * nN, gid = wgid / nig, fm = gid * WGM, gsz = (nM - fm) < WGM ? (nM - fm) : WGM;
        u.pm = fm + ((wgid % nig) % gsz); u.pn = (wgid % nig) / gsz; return true;
    }
    __device__ __forceinline__ void a_ready(const Unit&) const {}
    __device__ __forceinline__ void done(const Unit&) const {}
};

__device__ __forceinline__ unsigned cvt_pk_bf16(float lo, float hi) { unsigned r; asm volatile("v_cvt_pk_bf16_f32 %0, %1, %2" : "=v"(r) : "v"(lo), "v"(hi)); return r; }
typedef unsigned u32x2 __attribute__((ext_vector_type(2)));
__device__ __forceinline__ float fsigmoid(float x) { return __builtin_amdgcn_rcpf(1.0f + __expf(-x)); }
__device__ __forceinline__ float fsilu(float x) { return x * fsigmoid(x); }
__device__ __forceinline__ float bflo(unsigned w) { return __uint_as_float(w << 16); }
__device__ __forceinline__ float bfhi(unsigned w) { return __uint_as_float(w & 0xffff0000u); }

__device__ __forceinline__ float row_ss(const float* ss, int row) {
    const f32x4* p = (const f32x4*)(ss + (size_t)row * 16); const f32x4 a = p[0], b = p[1], c = p[2], d = p[3];
    return (((a[0] + a[1]) + (a[2] + a[3])) + ((b[0] + b[1]) + (b[2] + b[3]))) + (((c[0] + c[1]) + (c[2] + c[3])) + ((d[0] + d[1]) + (d[2] + d[3])));
}
struct EpiSwiGLU {
    static constexpr bool PERM = true, AFTER_DRAIN = false, HAS_MID = false, HAS_PRE = true;
    bf16_t* H; const float* ss;
    __device__ __forceinline__ void pre(float (&rsv)[8], const Unit& u, int wr, int fr) const {
#pragma unroll
        for (int q = 0; q < 8; ++q) rsv[q] = ss[u.pm * BM + wr * 64 + fr + (q >> 2) * HALF + (q & 3) * 16];
    }
    __device__ __forceinline__ void operator()(const f32x4 (&acc)[2][2][4][2], const Unit& u, int wr, int wc, int fr, int fq, const float (&rsv)[8]) const {
        const int row0 = u.pm * BM + wr * 64 + fr, col0 = u.pn * 128 + wc * 32 + 8 * fq;
#pragma unroll
        for (int ai = 0; ai < 2; ++ai)
#pragma unroll
            for (int m = 0; m < 4; ++m) {
                const int row = row0 + ai * HALF + m * 16;
                const float rs = rsv[ai * 4 + m];
                const f32x4 g0 = acc[ai][0][m][0] * rs, g1 = acc[ai][0][m][1] * rs, u0 = acc[ai][1][m][0] * rs, u1 = acc[ai][1][m][1] * rs;
                u32x4 w;
                w.x = cvt_pk_bf16(fsilu(g0[0]) * u0[0], fsilu(g0[1]) * u0[1]); w.y = cvt_pk_bf16(fsilu(g0[2]) * u0[2], fsilu(g0[3]) * u0[3]);
                w.z = cvt_pk_bf16(fsilu(g1[0]) * u1[0], fsilu(g1[1]) * u1[1]); w.w = cvt_pk_bf16(fsilu(g1[2]) * u1[2], fsilu(g1[3]) * u1[3]);
                *(u32x4*)(H + (size_t)row * 2048 + col0) = w;
            }
    }
};
struct EpiResid {
    static constexpr bool PERM = false, AFTER_DRAIN = false, HAS_MID = false, HAS_PRE = false;
    float* X; bf16_t* XB; float* ssn; float scale;
    __device__ __forceinline__ void operator()(const f32x4 (&acc)[2][2][4][2], const Unit& u, int wr, int wc, int fr, int fq, const float (&)[8]) const {
        const int row0 = u.pm * BM + wr * 64 + fr, col0 = u.pn * BM + wc * 32 + 4 * fq;
#pragma unroll
        for (int ai = 0; ai < 2; ++ai)
#pragma unroll
            for (int m = 0; m < 4; ++m) {
                const int row = row0 + ai * HALF + m * 16; float sq = 0.f;
#pragma unroll
                for (int bj = 0; bj < 2; ++bj)
#pragma unroll
                    for (int n = 0; n < 2; ++n) {
                        const size_t off = (size_t)row * 1024 + col0 + bj * HALF + n * 16;
                        f32x4 x = *(const f32x4*)(X + off); x = x + acc[ai][bj][m][n] * scale; *(f32x4*)(X + off) = x;
                        u32x2 w; w.x = cvt_pk_bf16(x[0], x[1]); w.y = cvt_pk_bf16(x[2], x[3]); *(u32x2*)(XB + off) = w;
                        sq += (x[0] * x[0] + x[1] * x[1]) + (x[2] * x[2] + x[3] * x[3]);
                    }
                sq += __shfl_xor(sq, 16); sq += __shfl_xor(sq, 32);
                if (fq == 0) ssn[(size_t)row * 16 + u.pn * 4 + wc] = sq;
            }
    }
};
struct EpiProj {
    static constexpr bool PERM = true, AFTER_DRAIN = false, HAS_MID = false, HAS_PRE = true;
    bf16_t* PA; bf16_t* GT; const float* ss;
    __device__ __forceinline__ void pre(float (&rsv)[8], const Unit& u, int wr, int fr) const {
#pragma unroll
        for (int q = 0; q < 8; ++q) rsv[q] = ss[u.pm * BM + wr * 64 + fr + (q >> 2) * HALF + (q & 3) * 16];
    }
    __device__ __forceinline__ void operator()(const f32x4 (&acc)[2][2][4][2], const Unit& u, int wr, int wc, int fr, int fq, const float (&rsv)[8]) const {
        const int row0 = u.pm * BM + wr * 64 + fr; const bool gate = u.pn >= 13;
        const int col0 = (gate ? (u.pn - 13) : u.pn) * BM + wc * 32 + 8 * fq;
        bf16_t* base = gate ? GT : PA; const int ld = gate ? 3072 : 3328;
#pragma unroll
        for (int ai = 0; ai < 2; ++ai)
#pragma unroll
            for (int m = 0; m < 4; ++m) {
                const int row = row0 + ai * HALF + m * 16;
                const float rs = rsv[ai * 4 + m];
#pragma unroll
                for (int bj = 0; bj < 2; ++bj) {
                    f32x4 v0 = acc[ai][bj][m][0] * rs, v1 = acc[ai][bj][m][1] * rs;
                    if (gate) {
#pragma unroll
                        for (int k = 0; k < 4; ++k) { v0[k] = fsigmoid(v0[k]); v1[k] = fsigmoid(v1[k]); }
                    }
                    u32x4 w; w.x = cvt_pk_bf16(v0[0], v0[1]); w.y = cvt_pk_bf16(v0[2], v0[3]); w.z = cvt_pk_bf16(v1[0], v1[1]); w.w = cvt_pk_bf16(v1[2], v1[3]);
                    *(u32x4*)(base + (size_t)row * ld + col0 + bj * HALF) = w;
                }
            }
    }
};
struct EpiBranch {
    static constexpr bool PERM = true, AFTER_DRAIN = false, HAS_MID = true, HAS_PRE = false;
    bf16_t* MB; const bf16_t* GT;
    __device__ __forceinline__ void mid(f32x4 (&acc)[2][2][4][2], const Unit& u, int seg, int wr, int wc, int fr, int fq) const {
        int fr_ = fr; asm volatile("" : "+v"(fr_));
        const int row0 = u.pm * BM + wr * 64 + fr_, col0 = u.pn * BM + wc * 32 + 8 * fq;
#pragma unroll
        for (int ai = 0; ai < 2; ++ai)
#pragma unroll
            for (int m = 0; m < 4; ++m) {
                const int row = row0 + ai * HALF + m * 16;
#pragma unroll
                for (int bj = 0; bj < 2; ++bj) {
                    const bf16_t* gp = GT + (size_t)row * 3072 + (seg - 1) * 1024 + col0 + bj * HALF;
                    const u32x4 g0 = *(const u32x4*)gp, g1 = *(const u32x4*)(gp + 1024);
                    f32x4 r0, r1;
                    r0[0] = bflo(g0.x) * __builtin_amdgcn_rcpf(fmaxf(bflo(g1.x), 1e-30f)); r0[1] = bfhi(g0.x) * __builtin_amdgcn_rcpf(fmaxf(bfhi(g1.x), 1e-30f));
                    r0[2] = bflo(g0.y) * __builtin_amdgcn_rcpf(fmaxf(bflo(g1.y), 1e-30f)); r0[3] = bfhi(g0.y) * __builtin_amdgcn_rcpf(fmaxf(bfhi(g1.y), 1e-30f));
                    r1[0] = bflo(g0.z) * __builtin_amdgcn_rcpf(fmaxf(bflo(g1.z), 1e-30f)); r1[1] = bfhi(g0.z) * __builtin_amdgcn_rcpf(fmaxf(bfhi(g1.z), 1e-30f));
                    r1[2] = bflo(g0.w) * __builtin_amdgcn_rcpf(fmaxf(bflo(g1.w), 1e-30f)); r1[3] = bfhi(g0.w) * __builtin_amdgcn_rcpf(fmaxf(bfhi(g1.w), 1e-30f));
                    acc[ai][bj][m][0] = acc[ai][bj][m][0] * r0; acc[ai][bj][m][1] = acc[ai][bj][m][1] * r1;
                }
                if (m == 3) asm volatile("" ::: "memory");
            }
    }
    __device__ __forceinline__ void operator()(const f32x4 (&acc)[2][2][4][2], const Unit& u, int wr, int wc, int fr, int fq, const float (&)[8]) const {
        const int row0 = u.pm * BM + wr * 64 + fr, col0 = u.pn * BM + wc * 32 + 8 * fq;
#pragma unroll
        for (int ai = 0; ai < 2; ++ai)
#pragma unroll
            for (int m = 0; m < 4; ++m) {
                const int row = row0 + ai * HALF + m * 16;
#pragma unroll
                for (int bj = 0; bj < 2; ++bj) {
                    const u32x4 gt = *(const u32x4*)(GT + (size_t)row * 3072 + 2048 + col0 + bj * HALF);
                    const f32x4 v0 = acc[ai][bj][m][0], v1 = acc[ai][bj][m][1];
                    u32x4 w;
                    w.x = cvt_pk_bf16(v0[0] * bflo(gt.x), v0[1] * bfhi(gt.x)); w.y = cvt_pk_bf16(v0[2] * bflo(gt.y), v0[3] * bfhi(gt.y));
                    w.z = cvt_pk_bf16(v1[0] * bflo(gt.z), v1[1] * bfhi(gt.z)); w.w = cvt_pk_bf16(v1[2] * bflo(gt.w), v1[3] * bfhi(gt.w));
                    *(u32x4*)(MB + (size_t)row * 1024 + col0 + bj * HALF) = w;
                }
            }
    }
};


template <class Epi, class Sched, bool ALIGN_EPI = false, bool SP2 = false>
__device__ __forceinline__ void gemm_phase(PG8_LAS unsigned char* lds, const Gemm g, const Sched& S, const Epi& E) {
    int tid_ = threadIdx.x; asm volatile("" : "+v"(tid_));
    const int tid = tid_, wid = __builtin_amdgcn_readfirstlane(tid >> 6), lane = tid & 63, wr = wid >> 2, wc = wid & 3, fr = lane & 15, fq = lane >> 4;
    const int K = g.K, nt = K / BK;
    unsigned voffA[2], voffB[2];
#pragma unroll
    for (int i = 0; i < 2; ++i) { int R, C; stage_rc(tid * 16 + i * 8192, R, C); const int Rb = Epi::PERM ? ((R & ~31) + perm32(R & 31)) : R;
        voffA[i] = (unsigned)(R * K + C) * 2u; voffB[i] = (unsigned)(Rb * K + C) * 2u; }
    const size_t kstep = (size_t)(BK * 2);
    const size_t hstep = (size_t)HALF * K * 2;
    const size_t tstep = 2 * hstep;
    const unsigned ldsw = (unsigned)wid * 1024u;
    const int aoff = lds_byte(wr * 64 + fr, fq * 8), boff = lds_byte(wc * 32 + fr, fq * 8);
#define PG8_SA(b, h) (((b) * 2 + (h)) * HTB)
#define PG8_SB(b, h) ((4 + (b) * 2 + (h)) * HTB)
#define PG8_STAGE(bufoff, gbase, voff) do { _Pragma("unroll") for (int _i = 0; _i < 2; ++_i) \
        __builtin_amdgcn_global_load_lds((const unsigned*)((const char*)(gbase) + (voff)[_i]), (PG8_LAS unsigned*)(lds + (bufoff) + ldsw + _i * 8192), 16, 0, 0); } while (0)
#define PG8_LDA(dst, b, h) do { _Pragma("unroll") for (int m = 0; m < 4; ++m) _Pragma("unroll") for (int k = 0; k < 2; ++k) dst[m][k] = *(const PG8_LAS bf16x8*)(lds + PG8_SA(b, h) + aoff + m * 2048 + k * 1024); } while (0)
#define PG8_LDB(dst, b, h) do { _Pragma("unroll") for (int n = 0; n < 2; ++n) _Pragma("unroll") for (int k = 0; k < 2; ++k) dst[n][k] = *(const PG8_LAS bf16x8*)(lds + PG8_SB(b, h) + boff + n * 2048 + k * 1024); } while (0)
#define PG8_MMA(ai, bj, At, Bt) do { __builtin_amdgcn_s_setprio(1); _Pragma("unroll") for (int m = 0; m < 4; ++m) _Pragma("unroll") for (int n = 0; n < 2; ++n) _Pragma("unroll") for (int k = 0; k < 2; ++k) \
        acc[ai][bj][m][n] = __builtin_amdgcn_mfma_f32_16x16x32_bf16(Bt[n][k], At[m][k], acc[ai][bj][m][n], 0, 0, 0); __builtin_amdgcn_s_setprio(0); } while (0)
#define PG8_WAIT_V(n) asm volatile("s_waitcnt vmcnt(" #n ")" ::: "memory")
#define PG8_WAIT_L(n) asm volatile("s_waitcnt lgkmcnt(" #n ")" ::: "memory")
#define PG8_BAR __builtin_amdgcn_s_barrier()
#define PG8_SCHED __builtin_amdgcn_sched_barrier(0)
    Unit cur, nxt; int ui = 0;
    if (!S.next(0, cur)) return;
    float rsv[8] = {0.f, 0.f, 0.f, 0.f, 0.f, 0.f, 0.f, 0.f};
    f32x4 acc[2][2][4][2];
#pragma unroll
    for (int a = 0; a < 2; ++a)
#pragma unroll
        for (int b = 0; b < 2; ++b)
#pragma unroll
            for (int m = 0; m < 4; ++m)
#pragma unroll
                for (int n = 0; n < 2; ++n) acc[a][b][m][n] = (f32x4){0.f, 0.f, 0.f, 0.f};
    bf16x8 At[4][2], B0[2][2], B1[2][2];
    const char* cA = (const char*)g.A + (size_t)cur.pm * tstep + (size_t)(cur.pn / g.agdiv) * g.agstride; const char* cB = (const char*)g.Bt + (size_t)cur.pn * tstep;
    S.a_ready(cur);
    if constexpr (SP2) {
        PG8_STAGE(PG8_SB(0, 0), cB, voffB); PG8_STAGE(PG8_SB(0, 1), cB + hstep, voffB); PG8_STAGE(PG8_SA(0, 0), cA, voffA); PG8_STAGE(PG8_SA(0, 1), cA + hstep, voffA);
        if (wr == 1) PG8_BAR;
        PG8_WAIT_V(2); PG8_BAR;
        PG8_STAGE(PG8_SB(1, 0), cB + kstep, voffB); PG8_STAGE(PG8_SA(1, 0), cA + kstep, voffA); PG8_STAGE(PG8_SB(1, 1), cB + hstep + kstep, voffB);
        PG8_WAIT_V(6); PG8_BAR;
    } else {
        PG8_STAGE(PG8_SB(0, 0), cB, voffB); PG8_STAGE(PG8_SA(0, 0), cA, voffA); PG8_STAGE(PG8_SB(0, 1), cB + hstep, voffB); PG8_STAGE(PG8_SA(0, 1), cA + hstep, voffA);
        if (wr == 1) PG8_BAR;
        PG8_WAIT_V(4); PG8_BAR;
        PG8_STAGE(PG8_SB(1, 0), cB + kstep, voffB); PG8_STAGE(PG8_SA(1, 0), cA + kstep, voffA); PG8_STAGE(PG8_SB(1, 1), cB + hstep + kstep, voffB);
        PG8_WAIT_V(6); PG8_BAR;
    }
    for (;;) {
        const bool has_next = S.next(ui + 1, nxt);
        const char* nA = has_next ? (const char*)g.A + (size_t)nxt.pm * tstep + (size_t)(nxt.pn / g.agdiv) * g.agstride : cA; const char* nB = has_next ? (const char*)g.Bt + (size_t)nxt.pn * tstep : cB;
        for (int t = 0; t < nt; t += 2) {
            if constexpr (Epi::HAS_MID) { if (t == 8 || t == 16) E.mid(acc, cur, t >> 3, wr, wc, fr, fq); }
            const bool last = (t == nt - 2);
            const char* a1 = cA + (size_t)(t + 1) * kstep;
            const char* a2 = last ? nA : cA + (size_t)(t + 2) * kstep; const char* b2 = last ? nB : cB + (size_t)(t + 2) * kstep;
            const char* a3 = a2 + kstep; const char* b3 = b2 + kstep;
            if (last && has_next) S.a_ready(nxt);
            if constexpr (Epi::HAS_PRE) { if (last) E.pre(rsv, cur, wr, fr); }
            if constexpr (SP2) {
            PG8_LDB(B0, 0, 0); PG8_LDB(B1, 0, 1); PG8_SCHED; PG8_LDA(At, 0, 0); PG8_STAGE(PG8_SA(1, 1), a1 + hstep, voffA);
            PG8_WAIT_V(8); PG8_WAIT_L(0); PG8_BAR; PG8_MMA(0, 0, At, B0); PG8_MMA(0, 1, At, B1); PG8_BAR; PG8_SCHED;
            PG8_LDA(At, 0, 1); PG8_STAGE(PG8_SB(0, 0), b2, voffB); PG8_STAGE(PG8_SB(0, 1), b2 + hstep, voffB); PG8_STAGE(PG8_SA(0, 0), a2, voffA);
            PG8_WAIT_V(8); PG8_WAIT_L(0); PG8_BAR; PG8_MMA(1, 0, At, B0); PG8_MMA(1, 1, At, B1); PG8_BAR; PG8_SCHED;
            PG8_LDB(B0, 1, 0); PG8_LDB(B1, 1, 1); PG8_SCHED; PG8_LDA(At, 1, 0); PG8_STAGE(PG8_SA(0, 1), a2 + hstep, voffA);
            PG8_WAIT_V(8); PG8_WAIT_L(0); PG8_BAR; PG8_MMA(0, 0, At, B0); PG8_MMA(0, 1, At, B1); PG8_BAR; PG8_SCHED;
            PG8_LDA(At, 1, 1); PG8_STAGE(PG8_SB(1, 0), b3, voffB); PG8_STAGE(PG8_SB(1, 1), b3 + hstep, voffB); PG8_STAGE(PG8_SA(1, 0), a3, voffA);
            PG8_WAIT_V(8); PG8_WAIT_L(0); PG8_BAR; PG8_MMA(1, 0, At, B0); PG8_MMA(1, 1, At, B1); PG8_BAR; PG8_SCHED;
            } else {
            PG8_LDB(B0, 0, 0); PG8_SCHED; PG8_LDA(At, 0, 0); PG8_STAGE(PG8_SA(1, 1), a1 + hstep, voffA);
            PG8_WAIT_L(8); PG8_BAR; PG8_WAIT_L(0); PG8_MMA(0, 0, At, B0); PG8_BAR; PG8_SCHED;
            PG8_LDB(B1, 0, 1); PG8_STAGE(PG8_SB(0, 0), b2, voffB);
            PG8_BAR; PG8_WAIT_L(0); PG8_MMA(0, 1, At, B1); PG8_BAR;
            PG8_LDA(At, 0, 1); PG8_STAGE(PG8_SA(0, 0), a2, voffA);
            PG8_BAR; PG8_WAIT_L(0); PG8_MMA(1, 0, At, B0); PG8_BAR; PG8_SCHED;
            PG8_STAGE(PG8_SB(0, 1), b2 + hstep, voffB);
            PG8_WAIT_V(6); PG8_BAR; PG8_MMA(1, 1, At, B1); PG8_BAR;
            PG8_LDB(B0, 1, 0); PG8_SCHED; PG8_LDA(At, 1, 0); PG8_STAGE(PG8_SA(0, 1), a2 + hstep, voffA);
            PG8_WAIT_L(8); PG8_BAR; PG8_WAIT_L(0); PG8_MMA(0, 0, At, B0); PG8_BAR; PG8_SCHED;
            PG8_LDB(B1, 1, 1); PG8_STAGE(PG8_SB(1, 0), b3, voffB);
            PG8_BAR; PG8_WAIT_L(0); PG8_MMA(0, 1, At, B1); PG8_BAR;
            PG8_LDA(At, 1, 1); PG8_STAGE(PG8_SA(1, 0), a3, voffA);
            PG8_BAR; PG8_WAIT_L(0); PG8_MMA(1, 0, At, B0); PG8_BAR; PG8_SCHED;
            PG8_STAGE(PG8_SB(1, 1), b3 + hstep, voffB);
            PG8_WAIT_V(6); PG8_BAR; PG8_MMA(1, 1, At, B1); PG8_BAR;
            }
        }
        if constexpr (ALIGN_EPI) { if (wr == 0) PG8_BAR; }
        if constexpr (!Epi::AFTER_DRAIN) { E(acc, cur, wr, wc, fr, fq, rsv); S.done(cur); }
        if (!has_next) break;
#pragma unroll
        for (int a = 0; a < 2; ++a)
#pragma unroll
            for (int b = 0; b < 2; ++b)
#pragma unroll
                for (int m = 0; m < 4; ++m)
#pragma unroll
                    for (int n = 0; n < 2; ++n) acc[a][b][m][n] = (f32x4){0.f, 0.f, 0.f, 0.f};
        cur = nxt; cA = nA; cB = nB; ++ui;
        if constexpr (ALIGN_EPI) { if (wr == 1) PG8_BAR; }
    }
    PG8_WAIT_V(0);
    if constexpr (!ALIGN_EPI) { if (wr == 0) PG8_BAR; }
    PG8_BAR;
    if constexpr (Epi::AFTER_DRAIN) { E.fused(acc, cur, wr, wc, fr, fq, lds, wid, lane); S.done(cur); }
#undef PG8_SA
#undef PG8_SB
#undef PG8_STAGE
#undef PG8_LDA
#undef PG8_LDB
#undef PG8_MMA
#undef PG8_WAIT_V
#undef PG8_WAIT_L
#undef PG8_BAR
#undef PG8_SCHED
}
}

#define LAS __attribute__((address_space(3)))
typedef unsigned short bf16_t;
typedef short bf16x8 __attribute__((ext_vector_type(8)));
typedef short s16x4 __attribute__((ext_vector_type(4)));
typedef float f32x4 __attribute__((ext_vector_type(4)));
typedef unsigned u32x4 __attribute__((ext_vector_type(4)));
typedef unsigned u32x2 __attribute__((ext_vector_type(2)));
using pg8::cvt_pk_bf16; using pg8::fsigmoid; using pg8::fsilu; using pg8::bflo; using pg8::bfhi;

constexpr int DM = 1024, FF = 2048, NIN = 6400, DEPTH = 4;
constexpr int MP = 16896;
constexpr int BROWS = 8320;
constexpr int PADR = 112, TPB = 8208, NT = 65;
constexpr int SROW0 = 16640;
constexpr int MREAL = 16768;
constexpr int PAW = 3328, GTW = 3072;
constexpr int C_XA = 0, C_YA = 512, C_QS = 1024, C_KS = 1536, C_VS = 1664, C_QR = 1792, C_KR = 2048, C_VR = 2304, C_GR = 2816;
constexpr int NTHR = 512;
constexpr int OBS = 1536;
constexpr int LDS_BYTES = 131072 + 256;

constexpr size_t MiB = 1u << 20;
constexpr size_t WS_BAR = 0;
constexpr size_t WS_LSUM = 1 * MiB;
constexpr size_t WS_LCAR = WS_LSUM + 1 * MiB;
constexpr size_t WS_W0 = 3 * MiB;
constexpr size_t WSZ = 46 * MiB;
constexpr size_t W_GU1 = 0, W_D1 = 8 * MiB, W_IN = 12 * MiB, W_BR = 25 * MiB, W_OUT = 28 * MiB, W_GU2 = 34 * MiB, W_D2 = 42 * MiB;
constexpr size_t WS_X = WS_W0 + 2 * WSZ;
constexpr size_t WS_XB = WS_X + 66 * MiB;
constexpr size_t WS_PA = WS_XB + 33 * MiB;
constexpr size_t WS_GT = WS_PA + 108 * MiB;
constexpr size_t WS_OB = WS_GT + 99 * MiB;
constexpr size_t WS_U = WS_OB + 50 * MiB;
constexpr size_t WS_ST = WS_U + 17 * MiB;
constexpr size_t WS_SS16 = WS_ST + 9 * MiB;
constexpr size_t WS_BG = WS_SS16 + 14 * MiB;
constexpr size_t WS_RS = WS_BG + 33 * MiB;
constexpr size_t WS_END = WS_RS + 1 * MiB;

constexpr int O_YP = 0, O_YS = 16777216, O_PK = 16908288, O_PV = 17039360, O_PC = 17170432, O_PL = 17182720, O_PR = 17186816,
              O_SK = 17448960, O_SV = 25837568, O_SC = 34226176, O_SL = 35012608, O_SR = 35274752;

enum { I_XP = 0, I_XS, I_CK, I_CV, I_SCONV, I_SLRU, I_SRET, I_META, I_F1N, I_F1GU, I_F1D, I_MIXN, I_WIN, I_CONVW, I_CONVB, I_LWA, I_LBA, I_LWX, I_LBX, I_LAM,
       I_SINK, I_RETN, I_WBA, I_WBB, I_WBC, I_WOUT, I_F2N, I_F2GU, I_F2D, I_FINN };

struct Args { const float* in[30]; float* out; unsigned char* ws; int ph_lo, ph_hi; };
typedef const __attribute__((address_space(4))) Args CArgs;

__device__ __forceinline__ float bf2f(bf16_t v) { return __uint_as_float((unsigned)v << 16); }
__device__ __forceinline__ bf16_t f2bf(float f) { return (bf16_t)(cvt_pk_bf16(f, 0.f) & 0xffffu); }
__device__ __forceinline__ float gelu_tanh(float x) { const float t = 0.7978845608028654f * (x + 0.044715f * x * x * x); const float e = __expf(2.0f * t); const float th = 1.0f - 2.0f * __builtin_amdgcn_rcpf(e + 1.0f); return 0.5f * x * (1.0f + th); }
__device__ __forceinline__ void sincos_rev(float ang, float& s, float& c) {
    const double rv = (double)ang * 0.15915494309189535; const float fr = (float)(rv - __builtin_rint(rv));
    s = __builtin_amdgcn_sinf(fr); c = __builtin_amdgcn_cosf(fr);
}
__device__ __forceinline__ float rope_inv(int i) { return exp2f(-(float)i * (13.287712379549449f / 32.0f)); }
__device__ __forceinline__ float log2_gamma(int h) { return log2f(1.0f - exp2f(-5.0f - (float)h)); }
__device__ __forceinline__ int tid_opaque() { int t = threadIdx.x; asm volatile("" : "+v"(t)); return t; }
#define LDSW() asm volatile("s_waitcnt lgkmcnt(0)" ::: "memory")

__device__ __forceinline__ void cvt_item(const float* W, int K, int N, bf16_t* WT, int ldk, int rep, const float* g, int mode, LAS float* scr, int item, int lane) {
    const int nblk = N / 32, kb = item / nblk, nb = item % nblk, k0 = 64 * kb, n0 = 32 * nb;
    float wv[32];
#pragma unroll
    for (int i = 0; i < 32; ++i) { const int kk = 2 * i + (lane >> 5); wv[i] = __builtin_nontemporal_load(&W[(size_t)(k0 + kk) * N + n0 + (lane & 31)]); }
#pragma unroll
    for (int i = 0; i < 32; ++i) { const int kk = 2 * i + (lane >> 5); float w = wv[i]; if (g) w *= g[k0 + kk]; scr[kk * 33 + (lane & 31)] = w; }
    LDSW();
    const int c = lane & 7;
#pragma unroll
    for (int j = 0; j < 4; ++j) {
        const int n = (lane >> 3) + 8 * j; const LAS float* s = scr + (8 * c) * 33 + n;
        u32x4 o; o.x = cvt_pk_bf16(s[0 * 33], s[1 * 33]); o.y = cvt_pk_bf16(s[2 * 33], s[3 * 33]); o.z = cvt_pk_bf16(s[4 * 33], s[5 * 33]); o.w = cvt_pk_bf16(s[6 * 33], s[7 * 33]);
        const int nn = n0 + n; const int drow = mode ? (256 * ((nn & 2047) >> 7) + 128 * (nn >> 11) + (nn & 127)) : nn;
        for (int r = 0; r < rep; ++r) *(u32x4*)(WT + (size_t)drow * ldk + r * K + k0 + 8 * c) = o;
    }
    LDSW();
}
__device__ __forceinline__ void convert_layer(CArgs* a, int l, unsigned char* wbuf, LAS unsigned char* lds, int gw, int ngw, int wave, int lane) {
    LAS float* scr = (LAS float*)(lds + wave * 8448);
    constexpr int I_GU = 16 * 128, I_D = 32 * 32, I_W = 16 * 200, I_B = 8 * 32, I_O = 16 * 32;
    constexpr int NITEMS = 2 * I_GU + 2 * I_D + I_W + 3 * I_B + I_O;
    for (int it = gw; it < NITEMS; it += ngw) {
        int r = it;
        if (r < I_GU) { cvt_item(a->in[I_F1GU] + (size_t)l * DM * 4096, DM, 4096, (bf16_t*)(wbuf + W_GU1), DM, 1, a->in[I_F1N] + l * DM, 1, scr, r, lane); continue; } r -= I_GU;
        if (r < I_GU) { cvt_item(a->in[I_F2GU] + (size_t)l * DM * 4096, DM, 4096, (bf16_t*)(wbuf + W_GU2), DM, 1, a->in[I_F2N] + l * DM, 1, scr, r, lane); continue; } r -= I_GU;
        if (r < I_D) { cvt_item(a->in[I_F1D] + (size_t)l * FF * DM, FF, DM, (bf16_t*)(wbuf + W_D1), FF, 1, nullptr, 0, scr, r, lane); continue; } r -= I_D;
        if (r < I_D) { cvt_item(a->in[I_F2D] + (size_t)l * FF * DM, FF, DM, (bf16_t*)(wbuf + W_D2), FF, 1, nullptr, 0, scr, r, lane); continue; } r -= I_D;
        if (r < I_W) { cvt_item(a->in[I_WIN] + (size_t)l * DM * NIN, DM, NIN, (bf16_t*)(wbuf + W_IN), DM, 1, a->in[I_MIXN] + l * DM, 0, scr, r, lane); continue; } r -= I_W;
        if (r < 3 * I_B) { const int br = r / I_B; cvt_item((br == 0 ? a->in[I_WBA] : (br == 1 ? a->in[I_WBB] : a->in[I_WBC])) + (size_t)l * 512 * DM, 512, DM, (bf16_t*)(wbuf + W_BR) + br * 512, OBS, 1, nullptr, 0, scr, r % I_B, lane); continue; } r -= 3 * I_B;
        cvt_item(a->in[I_WOUT] + (size_t)l * DM * DM, DM, DM, (bf16_t*)(wbuf + W_OUT), DM, 1, nullptr, 0, scr, r, lane);
    }
}

__device__ __forceinline__ float wave_sum(float v) {
#pragma unroll
    for (int o = 1; o < 64; o <<= 1) v += __shfl_xor(v, o);
    return v;
}
__device__ __forceinline__ void init_rows(CArgs* a, float* X, bf16_t* XB, float* SS, float* RS0, bf16_t* OB, int gw, int ngw, int lane) {
    for (int r = gw; r < MP; r += ngw) {
        const float* src = nullptr;
        if (r < 2 * BROWS) { const int b = r / BROWS, pr = r % BROWS; if (pr >= PADR) { const int t = pr - PADR; src = (t < 16) ? a->in[I_META] + (size_t)t * DM : a->in[I_XP] + ((size_t)b * 8192 + (t - 16)) * DM; } }
        else if (r < MREAL) src = a->in[I_XS] + (size_t)(r - SROW0) * DM;
        float sq = 0.f;
#pragma unroll
        for (int j = 0; j < 4; ++j) {
            f32x4 v = (f32x4){0.f, 0.f, 0.f, 0.f};
            if (src) v = __builtin_nontemporal_load((const f32x4*)src + lane + 64 * j);
            *((f32x4*)(X + (size_t)r * DM) + lane + 64 * j) = v;
            u32x2 w; w.x = cvt_pk_bf16(v[0], v[1]); w.y = cvt_pk_bf16(v[2], v[3]); *((u32x2*)(XB + (size_t)r * DM) + lane + 64 * j) = w;
            sq += (v[0] * v[0] + v[1] * v[1]) + (v[2] * v[2] + v[3] * v[3]);
        }
        sq = wave_sum(sq);
        if (lane < 16) SS[(size_t)r * 16 + lane] = (lane == 0) ? sq : 0.f;
        if (lane == 0) RS0[r] = __builtin_amdgcn_rsqf(sq * (1.0f / 1024.0f) + 1e-6f);
        if (r >= MREAL) {
#pragma unroll
            for (int br = 0; br < 3; ++br) *((u32x4*)(OB + (size_t)r * OBS + br * 512) + lane) = (u32x4){0u, 0u, 0u, 0u};
        }
    }
}

__device__ __forceinline__ void lru1_item(CArgs* a, int l, int tt, int chblk, const bf16_t* PA, bf16_t* OB0, float* LSUM, float* AG, float* BG, LAS unsigned char* lds) {
    LAS float* xa_s = (LAS float*)lds;
    LAS float* xc_s = xa_s + 131 * 64;
    LAS bf16_t* wt_s = (LAS bf16_t*)(xc_s + 128 * 64);
    LAS float* seg_s = (LAS float*)(wt_s + 128 * 72);
    const int tid = tid_opaque(), lane = tid & 63, w = tid >> 6, fr = lane & 15, fq = lane >> 4;
    const int ch0 = chblk * 64, ch = ch0 + lane;
    const bool sample = (tt == 130);
    const int b = tt / NT, n = tt % NT;
    const int row0 = sample ? SROW0 : b * BROWS + n * 128;
    {
        const float* wa = a->in[I_LWA] + ((size_t)l * 8 + chblk) * 4096; const float* wx = a->in[I_LWX] + ((size_t)l * 8 + chblk) * 4096;
        float wv[16];
#pragma unroll
        for (int k = 0; k < 16; ++k) { const int i = tid + k * NTHR; wv[k] = (i < 4096) ? wa[i] : wx[i - 4096]; }
#pragma unroll
        for (int k = 0; k < 16; ++k) { const int i = tid + k * NTHR; const int m = i >> 12, c = (i >> 6) & 63, d = i & 63; wt_s[(m * 64 + d) * 72 + c] = f2bf(wv[k]); }
    }
    const float cw0 = a->in[I_CONVW][(l * 4 + 0) * 512 + ch], cw1 = a->in[I_CONVW][(l * 4 + 1) * 512 + ch], cw2 = a->in[I_CONVW][(l * 4 + 2) * 512 + ch], cw3 = a->in[I_CONVW][(l * 4 + 3) * 512 + ch];
    const float cb = a->in[I_CONVB][l * 512 + ch];
    if (!sample) {
        float xv[17];
#pragma unroll
        for (int k = 0; k < 17; ++k) {
            const int rr = w + 8 * k; const int grow = row0 - 3 + rr; xv[k] = 0.f;
            if (rr < 131 && !(n == 0 && rr < 3)) xv[k] = bf2f(PA[(size_t)grow * PAW + C_XA + ch]);
        }
#pragma unroll
        for (int k = 0; k < 17; ++k) { const int rr = w + 8 * k; if (rr < 131) xa_s[rr * 64 + lane] = xv[k]; }
        __syncthreads();
#pragma unroll 4
        for (int r = w; r < 128; r += 8) xc_s[r * 64 + lane] = cb + cw0 * xa_s[r * 64 + lane] + cw1 * xa_s[(r + 1) * 64 + lane] + cw2 * xa_s[(r + 2) * 64 + lane] + cw3 * xa_s[(r + 3) * 64 + lane];
        if (n == NT - 1 && w < 3) a->out[O_PC + ((l * 2 + b) * 3 + w) * 512 + ch] = xa_s[(128 + w) * 64 + lane];
    } else {
#pragma unroll
        for (int k = 0; k < 16; ++k) { const int r = w + 8 * k;
            const float* sc = a->in[I_SCONV] + ((size_t)(l * 128 + r) * 3) * 512 + ch; const float s0 = sc[0], s1 = sc[512], s2 = sc[1024];
            const float xa = bf2f(PA[(size_t)(SROW0 + r) * PAW + C_XA + ch]);
            xc_s[r * 64 + lane] = cb + cw0 * s0 + cw1 * s1 + cw2 * s2 + cw3 * xa;
            float* oc = a->out + O_SC + ((size_t)(l * 128 + r) * 3) * 512 + ch; oc[0] = s1; oc[512] = s2; oc[1024] = xa;
        }
    }
    __syncthreads();
    f32x4 acc[8];
    {
        bf16x8 af[2];
#pragma unroll
        for (int ks = 0; ks < 2; ++ks) {
            const f32x4 x0 = *(const LAS f32x4*)(xc_s + (16 * w + fr) * 64 + 32 * ks + 8 * fq), x1 = *(const LAS f32x4*)(xc_s + (16 * w + fr) * 64 + 32 * ks + 8 * fq + 4);
            u32x4 p; p.x = cvt_pk_bf16(x0[0], x0[1]); p.y = cvt_pk_bf16(x0[2], x0[3]); p.z = cvt_pk_bf16(x1[0], x1[1]); p.w = cvt_pk_bf16(x1[2], x1[3]); af[ks] = __builtin_bit_cast(bf16x8, p);
        }
#pragma unroll
        for (int t = 0; t < 8; ++t) {
            acc[t] = (f32x4){0.f, 0.f, 0.f, 0.f};
#pragma unroll
            for (int ks = 0; ks < 2; ++ks) { const bf16x8 bfr = *(const LAS bf16x8*)(wt_s + (t * 16 + fr) * 72 + 32 * ks + 8 * fq); acc[t] = __builtin_amdgcn_mfma_f32_16x16x32_bf16(af[ks], bfr, acc[t], 0, 0, 0); }
        }
    }
    LAS float* a_s = xa_s;
#pragma unroll
    for (int dt = 0; dt < 4; ++dt) {
        const int d = 16 * dt + fr, cch = ch0 + d;
        const float ba = a->in[I_LBA][l * 512 + cch], bx = a->in[I_LBX][l * 512 + cch];
        const float sp = log1pf(__expf(-a->in[I_LAM][l * 512 + cch]));
#pragma unroll
        for (int i = 0; i < 4; ++i) {
            const int r = 16 * w + 4 * fq + i;
            const float rg = fsigmoid(acc[dt][i] + ba), ig = fsigmoid(acc[4 + dt][i] + bx);
            const float la = -8.0f * rg * sp; float av = __expf(la);
            const float t2 = 2.0f * la;
            const float om = (t2 > -0.0625f) ? -t2 * (1.0f + t2 * (0.5f + t2 * (0.16666667f + t2 * (0.041666667f + t2 * 0.0083333333f)))) : 1.0f - av * av;
            float bv = __builtin_amdgcn_sqrtf(om) * (ig * xc_s[r * 64 + d]);
            if (!sample && n == 0 && r < PADR) { av = 1.0f; bv = 0.0f; }
            a_s[r * 64 + d] = av; xc_s[r * 64 + d] = bv;
        }
    }
    __syncthreads();
    if (sample) {
#pragma unroll
        for (int i = 0; i < 16; ++i) {
            const int r = w * 16 + i;
            const float hs = a_s[r * 64 + lane] * a->in[I_SLRU][(size_t)(l * 128 + r) * 512 + ch] + xc_s[r * 64 + lane];
            a->out[O_SL + (size_t)(l * 128 + r) * 512 + ch] = hs;
            const float ya = bf2f(PA[(size_t)(SROW0 + r) * PAW + C_YA + ch]);
            OB0[(size_t)(SROW0 + r) * OBS + ch] = f2bf(hs * gelu_tanh(ya));
        }
        __syncthreads();
        return;
    }
    float P = 1.0f, h = 0.0f;
#pragma unroll 4
    for (int i = 0; i < 16; ++i) {
        const int r = w * 16 + i; const float av = a_s[r * 64 + lane], bv = xc_s[r * 64 + lane];
        AG[(size_t)(row0 + r) * 512 + ch] = av; BG[(size_t)(row0 + r) * 512 + ch] = bv;
        h = av * h + bv; P *= av;
    }
    seg_s[(w * 64 + lane) * 2] = P; seg_s[(w * 64 + lane) * 2 + 1] = h;
    __syncthreads();
    if (w == 0) {
        float Pt = 1.0f, ht = 0.0f;
#pragma unroll
        for (int q = 0; q < 8; ++q) { const float p = seg_s[(q * 64 + lane) * 2], hh = seg_s[(q * 64 + lane) * 2 + 1]; ht = p * ht + hh; Pt *= p; }
        LSUM[((size_t)tt * 512 + ch) * 2] = Pt; LSUM[((size_t)tt * 512 + ch) * 2 + 1] = ht;
    }
    __syncthreads();
}
__device__ __forceinline__ void lru2_item(int tt, int chblk, const bf16_t* PA, bf16_t* OB0, const float* LCAR, const float* AG, const float* BG, LAS unsigned char* lds) {
    LAS float* seg_s = (LAS float*)lds;
    const int tid = tid_opaque(), lane = tid & 63, w = tid >> 6; const int ch = chblk * 64 + lane;
    const int b = tt / NT, n = tt % NT, row0 = b * BROWS + n * 128 + w * 16;
    float av[16], bv[16], yv[16];
#pragma unroll
    for (int i = 0; i < 16; ++i) { av[i] = AG[(size_t)(row0 + i) * 512 + ch]; bv[i] = BG[(size_t)(row0 + i) * 512 + ch]; yv[i] = bf2f(PA[(size_t)(row0 + i) * PAW + C_YA + ch]); }
    float hc = LCAR[(size_t)tt * 512 + ch];
    float P = 1.0f, h = 0.0f;
#pragma unroll
    for (int i = 0; i < 16; ++i) { h = av[i] * h + bv[i]; P *= av[i]; }
    seg_s[(w * 64 + lane) * 2] = P; seg_s[(w * 64 + lane) * 2 + 1] = h;
    __syncthreads();
    for (int q = 0; q < w; ++q) { const float p = seg_s[(q * 64 + lane) * 2], hh = seg_s[(q * 64 + lane) * 2 + 1]; hc = p * hc + hh; }
#pragma unroll
    for (int i = 0; i < 16; ++i) { hc = av[i] * hc + bv[i]; OB0[(size_t)(row0 + i) * OBS + ch] = f2bf(hc * gelu_tanh(yv[i])); }
    __syncthreads();
}

__device__ __forceinline__ void swa_item(CArgs* a, int l, int item, const bf16_t* PA, bf16_t* OB1, LAS unsigned char* lds) {
    const int kvh = item & 1, bn = item >> 1, b = bn / NT, n = bn % NT, row0 = b * BROWS + n * 128;
    LAS bf16_t* Ks = (LAS bf16_t*)lds;
    LAS bf16_t* Vt = Ks + 256 * 72;
    const int tid = tid_opaque(), lane = tid & 63, w = tid >> 6, fr = lane & 15, fq = lane >> 4;
    const int g = w >> 1, h = kvh * 4 + g;
    const float sink = a->in[I_SINK][l * 8 + h];
    bf16x8 qfa[4][2];
#pragma unroll
    for (int qb = 0; qb < 4; ++qb) { const int row = row0 + (w & 1) * 64 + qb * 16 + fr; qfa[qb][0] = *(const bf16x8*)(PA + (size_t)row * PAW + C_QS + h * 64 + fq * 8); qfa[qb][1] = *(const bf16x8*)(PA + (size_t)row * PAW + C_QS + h * 64 + 32 + fq * 8); }
    {
        const int key = tid >> 1, hf = tid & 1; const int grow = row0 - 128 + key; const bool valid = (n > 0) || (key >= 128);
        u32x4 kk[4], vv[4];
#pragma unroll
        for (int j = 0; j < 4; ++j) { kk[j] = (u32x4){0u, 0u, 0u, 0u}; vv[j] = (u32x4){0u, 0u, 0u, 0u}; }
        if (valid) {
            const u32x4* kp = (const u32x4*)(PA + (size_t)grow * PAW + C_KS + kvh * 64 + hf * 32); const u32x4* vp = (const u32x4*)(PA + (size_t)grow * PAW + C_VS + kvh * 64 + hf * 32);
#pragma unroll
            for (int j = 0; j < 4; ++j) { kk[j] = kp[j]; vv[j] = vp[j]; }
        }
#pragma unroll
        for (int j = 0; j < 4; ++j) *(LAS u32x4*)(Ks + key * 72 + hf * 32 + j * 8) = kk[j];
#pragma unroll
        for (int j = 0; j < 4; ++j) {
            const unsigned ws4[4] = {vv[j].x, vv[j].y, vv[j].z, vv[j].w};
#pragma unroll
            for (int q = 0; q < 4; ++q) { const int d = hf * 32 + j * 8 + q * 2; Vt[d * 280 + key] = (bf16_t)(ws4[q] & 0xffffu); Vt[(d + 1) * 280 + key] = (bf16_t)(ws4[q] >> 16); }
        }
        if (tid < 64) {
#pragma unroll
            for (int e = 256; e < 280; ++e) Vt[tid * 280 + e] = 0;
        }
        if (n == NT - 1 && key >= 128) {
            float* ok = a->out + O_PK + ((size_t)(l * 2 + b) * 128 + (key - 128)) * 128 + kvh * 64 + hf * 32; float* ov = a->out + O_PV + ((size_t)(l * 2 + b) * 128 + (key - 128)) * 128 + kvh * 64 + hf * 32;
#pragma unroll
            for (int j = 0; j < 4; ++j) {
                *(f32x4*)(ok + j * 8) = (f32x4){bflo(kk[j].x), bfhi(kk[j].x), bflo(kk[j].y), bfhi(kk[j].y)}; *(f32x4*)(ok + j * 8 + 4) = (f32x4){bflo(kk[j].z), bfhi(kk[j].z), bflo(kk[j].w), bfhi(kk[j].w)};
                *(f32x4*)(ov + j * 8) = (f32x4){bflo(vv[j].x), bfhi(vv[j].x), bflo(vv[j].y), bfhi(vv[j].y)}; *(f32x4*)(ov + j * 8 + 4) = (f32x4){bflo(vv[j].z), bfhi(vv[j].z), bflo(vv[j].w), bfhi(vv[j].w)};
            }
        }
    }
    __syncthreads();
#pragma unroll
    for (int qb = 0; qb < 4; ++qb) {
        const int r0 = (w & 1) * 64 + qb * 16, jt0 = r0 >> 4, r = r0 + fr, row = row0 + r;
        const bf16x8 qf[2] = {qfa[qb][0], qfa[qb][1]};
        f32x4 sacc[10];
#pragma unroll
        for (int t = 0; t < 9; ++t) {
            sacc[t] = (f32x4){0.f, 0.f, 0.f, 0.f};
#pragma unroll
            for (int ks = 0; ks < 2; ++ks) { const bf16x8 kf = *(const LAS bf16x8*)(Ks + ((jt0 + t) * 16 + fr) * 72 + ks * 32 + fq * 8); sacc[t] = __builtin_amdgcn_mfma_f32_16x16x32_bf16(kf, qf[ks], sacc[t], 0, 0, 0); }
        }
        sacc[9] = (f32x4){0.f, 0.f, 0.f, 0.f};
        float mx = -INFINITY;
#pragma unroll
        for (int t = 0; t < 9; ++t)
#pragma unroll
            for (int i = 0; i < 4; ++i) {
                const int kj = (jt0 + t) * 16 + 4 * fq + i;
                const bool valid = (kj > r) && (kj <= r + 128) && (n * 128 - 128 + kj >= PADR);
                const float s = valid ? sacc[t][i] * 0.125f : -INFINITY; sacc[t][i] = s; mx = fmaxf(mx, s);
            }
        mx = fmaxf(mx, __shfl_xor(mx, 16)); mx = fmaxf(mx, __shfl_xor(mx, 32));
        const float mm = fmaxf(mx, sink);
        float sum = 0.f;
#pragma unroll
        for (int t = 0; t < 9; ++t)
#pragma unroll
            for (int i = 0; i < 4; ++i) { const float e = __expf(sacc[t][i] - mm); sacc[t][i] = e; sum += e; }
        sum += __shfl_xor(sum, 16); sum += __shfl_xor(sum, 32);
        const float inv = 1.0f / (sum + __expf(sink - mm));
        f32x4 oacc[4];
#pragma unroll
        for (int dt = 0; dt < 4; ++dt) oacc[dt] = (f32x4){0.f, 0.f, 0.f, 0.f};
#pragma unroll
        for (int p = 0; p < 5; ++p) {
            const f32x4 ea = sacc[2 * p] * inv, eb = sacc[2 * p + 1] * inv;
            u32x4 pw; pw.x = cvt_pk_bf16(ea[0], ea[1]); pw.y = cvt_pk_bf16(ea[2], ea[3]); pw.z = cvt_pk_bf16(eb[0], eb[1]); pw.w = cvt_pk_bf16(eb[2], eb[3]);
            const bf16x8 pb = __builtin_bit_cast(bf16x8, pw);
            const int ja = jt0 + 2 * p;
#pragma unroll
            for (int dt = 0; dt < 4; ++dt) {
                const u32x2 va = *(const LAS u32x2*)(Vt + (dt * 16 + fr) * 280 + ja * 16 + 4 * fq), vb = *(const LAS u32x2*)(Vt + (dt * 16 + fr) * 280 + (ja + 1) * 16 + 4 * fq);
                const u32x4 vw = (u32x4){va.x, va.y, vb.x, vb.y};
                oacc[dt] = __builtin_amdgcn_mfma_f32_16x16x32_bf16(__builtin_bit_cast(bf16x8, vw), pb, oacc[dt], 0, 0, 0);
            }
        }
#pragma unroll
        for (int dt = 0; dt < 4; ++dt) { u32x2 o; o.x = cvt_pk_bf16(oacc[dt][0], oacc[dt][1]); o.y = cvt_pk_bf16(oacc[dt][2], oacc[dt][3]); *(u32x2*)(OB1 + (size_t)row * OBS + h * 64 + dt * 16 + 4 * fq) = o; }
    }
    __syncthreads();
}

__device__ __forceinline__ void ret_u_item(int item, const bf16_t* PA, float* U, LAS unsigned char* lds) {
    const int hh = item & 3, bc = item >> 2, b = bc / NT, c = bc % NT, row0 = b * BROWS + c * 128;
    LAS bf16_t* Kt = (LAS bf16_t*)lds;
    LAS bf16_t* Vt = Kt + 64 * 136;
    const int tid = tid_opaque(), lane = tid & 63, w = tid >> 6, fr = lane & 15, fq = lane >> 4; const float l2g = log2_gamma(hh);
    {
        const int j = tid >> 2, q = tid & 3; const bf16_t* rowp = PA + (size_t)(row0 + j) * PAW;
        const u32x4* vp = (const u32x4*)(rowp + C_VR + hh * 128 + q * 32);
        u32x4 vv[4];
#pragma unroll
        for (int t = 0; t < 4; ++t) vv[t] = vp[t];
        const u32x4 k1 = *(const u32x4*)(rowp + C_KR + hh * 64 + q * 8), k2 = *(const u32x4*)(rowp + C_KR + hh * 64 + 32 + q * 8);
#pragma unroll
        for (int t = 0; t < 4; ++t) {
            const unsigned ws4[4] = {vv[t].x, vv[t].y, vv[t].z, vv[t].w};
#pragma unroll
            for (int k = 0; k < 4; ++k) { const int e = q * 32 + t * 8 + k * 2; Vt[e * 136 + j] = (bf16_t)(ws4[k] & 0xffffu); Vt[(e + 1) * 136 + j] = (bf16_t)(ws4[k] >> 16); }
        }
        const unsigned w1[4] = {k1.x, k1.y, k1.z, k1.w}, w2[4] = {k2.x, k2.y, k2.z, k2.w};
        const int pos = c * 128 + j - PADR; const float dec = exp2f((float)(127 - j) * l2g) * 0.125f;
#pragma unroll
        for (int k = 0; k < 4; ++k) {
            float sa, ca, sb, cb; sincos_rev((float)pos * rope_inv(q * 8 + 2 * k), sa, ca); sincos_rev((float)pos * rope_inv(q * 8 + 2 * k + 1), sb, cb);
            const float x1a = bflo(w1[k]), x1b = bfhi(w1[k]), x2a = bflo(w2[k]), x2b = bfhi(w2[k]);
            const int d = q * 8 + 2 * k;
            Kt[d * 136 + j] = f2bf((x1a * ca - x2a * sa) * dec); Kt[(d + 32) * 136 + j] = f2bf((x1a * sa + x2a * ca) * dec);
            Kt[(d + 1) * 136 + j] = f2bf((x1b * cb - x2b * sb) * dec); Kt[(d + 33) * 136 + j] = f2bf((x1b * sb + x2b * cb) * dec);
        }
    }
    __syncthreads();
    const int dt = w >> 1;
    f32x4 acc[4];
#pragma unroll
    for (int t = 0; t < 4; ++t) acc[t] = (f32x4){0.f, 0.f, 0.f, 0.f};
#pragma unroll
    for (int ks = 0; ks < 4; ++ks) {
        const bf16x8 kf = *(const LAS bf16x8*)(Kt + (dt * 16 + fr) * 136 + 32 * ks + 8 * fq);
#pragma unroll
        for (int t = 0; t < 4; ++t) { const bf16x8 vf = *(const LAS bf16x8*)(Vt + ((4 * (w & 1) + t) * 16 + fr) * 136 + 32 * ks + 8 * fq); acc[t] = __builtin_amdgcn_mfma_f32_16x16x32_bf16(vf, kf, acc[t], 0, 0, 0); }
    }
#pragma unroll
    for (int t = 0; t < 4; ++t)
#pragma unroll
        for (int i = 0; i < 4; ++i) U[(size_t)item * 8192 + ((4 * (w & 1) + t) * 16 + 4 * fq + i) * 64 + dt * 16 + fr] = acc[t][i];
    __syncthreads();
}
__device__ __forceinline__ void ret_out_item(CArgs* a, int l, int item, const bf16_t* PA, const bf16_t* ST, bf16_t* OB2, LAS unsigned char* lds) {
    const int hh = item & 3, bc = item >> 2, b = bc / NT, c = bc % NT, row0 = b * BROWS + c * 128;
    LAS bf16_t* Kr = (LAS bf16_t*)lds;
    LAS bf16_t* Vt = Kr + 128 * 72;
    const int tid = tid_opaque(), lane = tid & 63, w = tid >> 6, fr = lane & 15, fq = lane >> 4; const float l2g = log2_gamma(hh);
    {
        const int j = tid >> 2, q = tid & 3; const bf16_t* rowp = PA + (size_t)(row0 + j) * PAW;
        const u32x4* vp = (const u32x4*)(rowp + C_VR + hh * 128 + q * 32);
        u32x4 vv[4];
#pragma unroll
        for (int t = 0; t < 4; ++t) vv[t] = vp[t];
        const u32x4 k1 = *(const u32x4*)(rowp + C_KR + hh * 64 + q * 8), k2 = *(const u32x4*)(rowp + C_KR + hh * 64 + 32 + q * 8);
#pragma unroll
        for (int t = 0; t < 4; ++t) {
            const unsigned ws4[4] = {vv[t].x, vv[t].y, vv[t].z, vv[t].w};
#pragma unroll
            for (int k = 0; k < 4; ++k) { const int e = q * 32 + t * 8 + k * 2; Vt[e * 136 + j] = (bf16_t)(ws4[k] & 0xffffu); Vt[(e + 1) * 136 + j] = (bf16_t)(ws4[k] >> 16); }
        }
        const unsigned w1[4] = {k1.x, k1.y, k1.z, k1.w}, w2[4] = {k2.x, k2.y, k2.z, k2.w};
        const int pos = c * 128 + j - PADR; unsigned o1[4], o2[4];
#pragma unroll
        for (int k = 0; k < 4; ++k) {
            float sa, ca, sb, cb; sincos_rev((float)pos * rope_inv(q * 8 + 2 * k), sa, ca); sincos_rev((float)pos * rope_inv(q * 8 + 2 * k + 1), sb, cb);
            const float x1a = bflo(w1[k]), x1b = bfhi(w1[k]), x2a = bflo(w2[k]), x2b = bfhi(w2[k]);
            o1[k] = cvt_pk_bf16((x1a * ca - x2a * sa) * 0.125f, (x1b * cb - x2b * sb) * 0.125f); o2[k] = cvt_pk_bf16((x1a * sa + x2a * ca) * 0.125f, (x1b * sb + x2b * cb) * 0.125f);
        }
        *(LAS u32x4*)(Kr + j * 72 + q * 8) = (u32x4){o1[0], o1[1], o1[2], o1[3]}; *(LAS u32x4*)(Kr + j * 72 + 32 + q * 8) = (u32x4){o2[0], o2[1], o2[2], o2[3]};
    }
    __syncthreads();
    const int il = 16 * w + fr, row = row0 + il, pos = c * 128 + il - PADR;
    bf16x8 qf[2], qs[2];
    {
        const u32x4 q1 = *(const u32x4*)(PA + (size_t)row * PAW + C_QR + hh * 64 + fq * 8), q2 = *(const u32x4*)(PA + (size_t)row * PAW + C_QR + hh * 64 + 32 + fq * 8);
        const unsigned w1[4] = {q1.x, q1.y, q1.z, q1.w}, w2[4] = {q2.x, q2.y, q2.z, q2.w};
        const float dsc = exp2f((float)(il + 1) * l2g);
        u32x4 o1, o2, s1, s2; unsigned r1[4], r2[4], t1[4], t2[4];
#pragma unroll
        for (int k = 0; k < 4; ++k) {
            float sa, ca, sb, cb; sincos_rev((float)pos * rope_inv(fq * 8 + 2 * k), sa, ca); sincos_rev((float)pos * rope_inv(fq * 8 + 2 * k + 1), sb, cb);
            const float x1a = bflo(w1[k]), x1b = bfhi(w1[k]), x2a = bflo(w2[k]), x2b = bfhi(w2[k]);
            const float y1a = x1a * ca - x2a * sa, y2a = x1a * sa + x2a * ca, y1b = x1b * cb - x2b * sb, y2b = x1b * sb + x2b * cb;
            r1[k] = cvt_pk_bf16(y1a, y1b); r2[k] = cvt_pk_bf16(y2a, y2b); t1[k] = cvt_pk_bf16(y1a * dsc, y1b * dsc); t2[k] = cvt_pk_bf16(y2a * dsc, y2b * dsc);
        }
        o1 = (u32x4){r1[0], r1[1], r1[2], r1[3]}; o2 = (u32x4){r2[0], r2[1], r2[2], r2[3]}; s1 = (u32x4){t1[0], t1[1], t1[2], t1[3]}; s2 = (u32x4){t2[0], t2[1], t2[2], t2[3]};
        qf[0] = __builtin_bit_cast(bf16x8, o1); qf[1] = __builtin_bit_cast(bf16x8, o2); qs[0] = __builtin_bit_cast(bf16x8, s1); qs[1] = __builtin_bit_cast(bf16x8, s2);
    }
    f32x4 sacc[8];
#pragma unroll
    for (int jt = 0; jt < 8; ++jt) {
        sacc[jt] = (f32x4){0.f, 0.f, 0.f, 0.f};
        if (jt <= w) {
#pragma unroll
            for (int ks = 0; ks < 2; ++ks) { const bf16x8 kf = *(const LAS bf16x8*)(Kr + (jt * 16 + fr) * 72 + ks * 32 + fq * 8); sacc[jt] = __builtin_amdgcn_mfma_f32_16x16x32_bf16(kf, qf[ks], sacc[jt], 0, 0, 0); }
        }
#pragma unroll
        for (int i = 0; i < 4; ++i) { const int dl = il - (jt * 16 + 4 * fq + i); sacc[jt][i] = (dl >= 0) ? sacc[jt][i] * exp2f((float)dl * l2g) : 0.f; }
    }
    f32x4 oacc[8];
#pragma unroll
    for (int et = 0; et < 8; ++et) oacc[et] = (f32x4){0.f, 0.f, 0.f, 0.f};
#pragma unroll
    for (int p = 0; p < 4; ++p) {
        if (2 * p <= w) {
            u32x4 pw; pw.x = cvt_pk_bf16(sacc[2 * p][0], sacc[2 * p][1]); pw.y = cvt_pk_bf16(sacc[2 * p][2], sacc[2 * p][3]); pw.z = cvt_pk_bf16(sacc[2 * p + 1][0], sacc[2 * p + 1][1]); pw.w = cvt_pk_bf16(sacc[2 * p + 1][2], sacc[2 * p + 1][3]);
            const bf16x8 pb = __builtin_bit_cast(bf16x8, pw);
#pragma unroll
            for (int et = 0; et < 8; ++et) {
                const u32x2 va = *(const LAS u32x2*)(Vt + (et * 16 + fr) * 136 + 32 * p + 4 * fq), vb = *(const LAS u32x2*)(Vt + (et * 16 + fr) * 136 + 32 * p + 16 + 4 * fq);
                const u32x4 vw = (u32x4){va.x, va.y, vb.x, vb.y};
                oacc[et] = __builtin_amdgcn_mfma_f32_16x16x32_bf16(__builtin_bit_cast(bf16x8, vw), pb, oacc[et], 0, 0, 0);
            }
        }
    }
    {
        const bf16_t* sb = ST + (size_t)item * 8192;
#pragma unroll
        for (int et = 0; et < 8; ++et)
#pragma unroll
            for (int ks = 0; ks < 2; ++ks) { const bf16x8 sf = *(const bf16x8*)(sb + (et * 16 + fr) * 64 + ks * 32 + fq * 8); oacc[et] = __builtin_amdgcn_mfma_f32_16x16x32_bf16(sf, qs[ks], oacc[et], 0, 0, 0); }
    }
    float sm = 0.f;
#pragma unroll
    for (int et = 0; et < 8; ++et) sm += (oacc[et][0] + oacc[et][1]) + (oacc[et][2] + oacc[et][3]);
    sm += __shfl_xor(sm, 16); sm += __shfl_xor(sm, 32);
    const float mu = sm * (1.0f / 128.0f); float vr = 0.f;
#pragma unroll
    for (int et = 0; et < 8; ++et) { const f32x4 d = oacc[et] - mu; vr += (d[0] * d[0] + d[1] * d[1]) + (d[2] * d[2] + d[3] * d[3]); }
    vr += __shfl_xor(vr, 16); vr += __shfl_xor(vr, 32);
    const float rstd = 1.0f / sqrtf(vr * (1.0f / 128.0f) + 1e-5f);
#pragma unroll
    for (int et = 0; et < 8; ++et) {
        const int e = et * 16 + 4 * fq; const f32x4 gn = *(const f32x4*)(a->in[I_RETN] + l * 512 + hh * 128 + e);
        const u32x2 gr = *(const u32x2*)(PA + (size_t)row * PAW + C_GR + hh * 128 + e);
        const f32x4 y = (oacc[et] - mu) * rstd * gn;
        u32x2 o; o.x = cvt_pk_bf16(y[0] * fsilu(bflo(gr.x)), y[1] * fsilu(bfhi(gr.x))); o.y = cvt_pk_bf16(y[2] * fsilu(bflo(gr.y)), y[3] * fsilu(bfhi(gr.y)));
        *(u32x2*)(OB2 + (size_t)row * OBS + hh * 128 + e) = o;
    }
    __syncthreads();
}


enum { TM_SWIGLU = 0, TM_RESID = 1, TM_PROJ = 2, TM_BRANCH = 3 };
constexpr int TROW0 = 16384;
struct TailArgs { const bf16_t* A; const bf16_t* Bt; int K, N; bf16_t* O1; bf16_t* O2; float* X; const float* ss; float* ssn; const bf16_t* GT; float scale; };
template <int MODE> __device__ __forceinline__ void tail_gemm(const TailArgs& t, int u0, int G, LAS unsigned char* lds) {
    const int tid = tid_opaque(), lane = tid & 63, w = __builtin_amdgcn_readfirstlane(tid >> 6), fr = lane & 15, fq = lane >> 4;
    LAS float* part = (LAS float*)lds;
    const int K = t.K, nu = 8 * (t.N / 64);
    int ks0, nks;
    if (MODE == TM_BRANCH) { if (w < 6) { const int q = w % 3; ks0 = 16 * (w / 3) + (q == 0 ? 0 : (q == 1 ? 6 : 11)); nks = (q == 0) ? 6 : 5; } else { ks0 = 32 + 8 * (w - 6); nks = 8; } }
    else { nks = K / 256; ks0 = w * nks; }
    bf16x8 af[4][3], bfr[4][4];
#define TG_LOAD(uu, s0) do { const bool xm_ = (MODE != TM_PROJ) && ((t.N / 64) % 8 == 0); const int rowb_ = TROW0 + 48 * (xm_ ? (((uu) >> 3) & 7) : ((uu) & 7)), cgp_ = xm_ ? (((uu) & 7) + 8 * ((uu) >> 6)) : ((uu) >> 3); \
        _Pragma("unroll") for (int sI = 0; sI < 4; ++sI) { if ((s0) + sI < nks) { const int kk = (ks0 + (s0) + sI) * 32 + 8 * fq; \
            _Pragma("unroll") for (int rt = 0; rt < 3; ++rt) af[sI][rt] = *(const bf16x8*)(t.A + (size_t)(rowb_ + 16 * rt + fr) * K + kk); \
            _Pragma("unroll") for (int ct = 0; ct < 4; ++ct) { const int brow = (MODE == TM_SWIGLU) ? 256 * (cgp_ >> 2) + (ct >> 1) * 128 + 32 * (cgp_ & 3) + 16 * (ct & 1) : 64 * cgp_ + 16 * ct; \
                bfr[sI][ct] = *(const bf16x8*)(t.Bt + (size_t)(brow + fr) * K + kk); } } } } while (0)
#define TG_MMA(s0) do { _Pragma("unroll") for (int sI = 0; sI < 4; ++sI) { if ((s0) + sI < nks) { _Pragma("unroll") for (int rt = 0; rt < 3; ++rt) _Pragma("unroll") for (int ct = 0; ct < 4; ++ct) \
            acc[rt][ct] = __builtin_amdgcn_mfma_f32_16x16x32_bf16(af[sI][rt], bfr[sI][ct], acc[rt][ct], 0, 0, 0); } } } while (0)
#pragma unroll 1
    for (int u = u0; u < nu; u += G) {
        const bool xmap = (MODE != TM_PROJ) && ((t.N / 64) % 8 == 0);
        const int rg = xmap ? ((u >> 3) & 7) : (u & 7), cgp = xmap ? ((u & 7) + 8 * (u >> 6)) : (u >> 3), rowb0 = TROW0 + 48 * rg;
        f32x4 acc[3][4];
#pragma unroll
        for (int rt = 0; rt < 3; ++rt)
#pragma unroll
            for (int ct = 0; ct < 4; ++ct) acc[rt][ct] = (f32x4){0.f, 0.f, 0.f, 0.f};
#pragma unroll 1
        for (int s0 = 0; s0 < nks; s0 += 4) { TG_LOAD(u, s0); TG_MMA(s0); }
#pragma unroll
        for (int rt = 0; rt < 3; ++rt)
#pragma unroll
            for (int ct = 0; ct < 4; ++ct) *(LAS f32x4*)(part + ((w * 12 + rt * 4 + ct) * 64 + lane) * 4) = acc[rt][ct];
        __syncthreads();
        if (w < 3) {
            const int rowb = rowb0 + 16 * w;
            f32x4 sum[4], tot[4];
#pragma unroll
            for (int ct = 0; ct < 4; ++ct) {
                f32x4 p[8];
#pragma unroll
                for (int q = 0; q < 8; ++q) p[q] = *(const LAS f32x4*)(part + ((q * 12 + w * 4 + ct) * 64 + lane) * 4);
                if (MODE == TM_BRANCH) {
                    const f32x4 pa = (p[0] + p[1]) + p[2], pb = (p[3] + p[4]) + p[5], pc = p[6] + p[7];
#pragma unroll
                    for (int i = 0; i < 4; ++i) { const bf16_t* gp = t.GT + (size_t)(rowb + 4 * fq + i) * 3072 + 64 * cgp + 16 * ct + fr; tot[ct][i] = pa[i] * bf2f(gp[0]) + pb[i] * bf2f(gp[1024]) + pc[i] * bf2f(gp[2048]); }
                } else sum[ct] = ((p[0] + p[1]) + (p[2] + p[3])) + ((p[4] + p[5]) + (p[6] + p[7]));
            }
            (void)sum; (void)tot;
            if (MODE == TM_SWIGLU) {
#pragma unroll
                for (int i = 0; i < 4; ++i) {
                    const int row = rowb + 4 * fq + i; const float rs = t.ss[row];
#pragma unroll
                    for (int c2 = 0; c2 < 2; ++c2) t.O1[(size_t)row * 2048 + 128 * (cgp >> 2) + 32 * (cgp & 3) + 16 * c2 + fr] = f2bf(fsilu(sum[c2][i] * rs) * (sum[2 + c2][i] * rs));
                }
            } else if (MODE == TM_RESID) {
#pragma unroll
                for (int i = 0; i < 4; ++i) {
                    const int row = rowb + 4 * fq + i; float sq = 0.f;
#pragma unroll
                    for (int ct = 0; ct < 4; ++ct) {
                        const size_t off = (size_t)row * 1024 + 64 * cgp + 16 * ct + fr;
                        const float x = t.X[off] + sum[ct][i] * t.scale; t.X[off] = x; t.O1[off] = f2bf(x); sq += x * x;
                    }
                    sq += __shfl_xor(sq, 1); sq += __shfl_xor(sq, 2); sq += __shfl_xor(sq, 4); sq += __shfl_xor(sq, 8);
                    if (fr == 0) t.ssn[(size_t)row * 16 + cgp] = sq;
                }
            } else if (MODE == TM_PROJ) {
                const bool gate = 64 * cgp >= PAW;
#pragma unroll
                for (int i = 0; i < 4; ++i) {
                    const int row = rowb + 4 * fq + i; const float rs = t.ss[row];
#pragma unroll
                    for (int ct = 0; ct < 4; ++ct) {
                        const int col = 64 * cgp + 16 * ct + fr; const float v = sum[ct][i] * rs;
                        if (gate) t.O2[(size_t)row * GTW + (col - PAW)] = f2bf(fsigmoid(v)); else t.O1[(size_t)row * PAW + col] = f2bf(v);
                    }
                }
            } else {
#pragma unroll
                for (int i = 0; i < 4; ++i)
#pragma unroll
                    for (int ct = 0; ct < 4; ++ct) t.O1[(size_t)(rowb + 4 * fq + i) * 1024 + 64 * cgp + 16 * ct + fr] = f2bf(tot[ct][i]);
            }
        }
        __syncthreads();
    }
#undef TG_LOAD
#undef TG_MMA
}

__device__ __forceinline__ void carry_item(CArgs* a, int l, int it, const float* LSUM, float* LCAR, const float* U, bf16_t* ST) {
    const int tid = tid_opaque();
    if (it < 2) {
        const int b = it, ch = tid; float h = 0.f;
#pragma unroll 1
        for (int n0 = 0; n0 < NT; n0 += 13) {
            float p[13], q[13];
#pragma unroll
            for (int k = 0; k < 13; ++k) { const size_t o = (size_t)(b * NT + n0 + k) * 512 + ch; p[k] = LSUM[o * 2]; q[k] = LSUM[o * 2 + 1]; }
#pragma unroll
            for (int k = 0; k < 13; ++k) { LCAR[(size_t)(b * NT + n0 + k) * 512 + ch] = h; h = p[k] * h + q[k]; }
        }
        a->out[O_PL + (l * 2 + b) * 512 + ch] = h;
    } else {
        const int eid = (it - 2) * 512 + tid; const int b = eid >> 15, hh = (eid >> 13) & 3, de = eid & 8191, e = de >> 6, d = de & 63;
        const float g128 = exp2f(128.0f * log2_gamma(hh)); float s = 0.f;
#pragma unroll 1
        for (int c0 = 0; c0 < NT; c0 += 13) {
            float u[13];
#pragma unroll
            for (int k = 0; k < 13; ++k) u[k] = U[(size_t)((b * NT + c0 + k) * 4 + hh) * 8192 + de];
#pragma unroll
            for (int k = 0; k < 13; ++k) { ST[(size_t)((b * NT + c0 + k) * 4 + hh) * 8192 + de] = f2bf(s); s = g128 * s + u[k]; }
        }
        a->out[O_PR + ((size_t)(l * 2 + b) * 4 + hh) * 8192 + d * 128 + e] = s;
    }
}

__device__ __forceinline__ void sample_item(CArgs* a, int l, int j, const bf16_t* PA, bf16_t* OB1, bf16_t* OB2, LAS unsigned char* lds) {
    const int tid = tid_opaque(), lane = tid & 63, w = tid >> 6; const int row = SROW0 + j;
    LAS float* q_s = (LAS float*)lds;
    LAS float* p_s = q_s + 512;
    LAS float* rq_s = p_s + 8 * 132;
    LAS float* rk_s = rq_s + 256;
    LAS float* red_s = rk_s + 256;
    const float* ck = a->in[I_CK] + (size_t)(l * 128 + j) * 16384; const float* cv = a->in[I_CV] + (size_t)(l * 128 + j) * 16384;
    const bf16_t* pr = PA + (size_t)row * PAW;
    q_s[tid] = bf2f(pr[C_QS + tid]);
    if (tid < 128) {
        const int hh = tid >> 5, i = tid & 31; float s, co; sincos_rev(8192.0f * rope_inv(i), s, co);
        const float q1 = bf2f(pr[C_QR + hh * 64 + i]), q2 = bf2f(pr[C_QR + hh * 64 + i + 32]), k1 = bf2f(pr[C_KR + hh * 64 + i]), k2 = bf2f(pr[C_KR + hh * 64 + i + 32]);
        rq_s[hh * 64 + i] = q1 * co - q2 * s; rq_s[hh * 64 + i + 32] = q1 * s + q2 * co;
        rk_s[hh * 64 + i] = (k1 * co - k2 * s) * 0.125f; rk_s[hh * 64 + i + 32] = (k1 * s + k2 * co) * 0.125f;
    }
    {
        float* ok = a->out + O_SK + (size_t)(l * 128 + j) * 16384; float* ov = a->out + O_SV + (size_t)(l * 128 + j) * 16384;
        f32x4 ckv[8], cvv[8];
#pragma unroll
        for (int k = 0; k < 8; ++k) { const int i = tid + k * NTHR; if (i < 127 * 32) { ckv[k] = __builtin_nontemporal_load((const f32x4*)ck + 32 + i); cvv[k] = __builtin_nontemporal_load((const f32x4*)cv + 32 + i); } }
#pragma unroll
        for (int k = 0; k < 8; ++k) { const int i = tid + k * NTHR; if (i < 127 * 32) { __builtin_nontemporal_store(ckv[k], (f32x4*)ok + i); __builtin_nontemporal_store(cvv[k], (f32x4*)ov + i); } }
        if (tid < 128) { ok[127 * 128 + tid] = bf2f(pr[C_KS + tid]); ov[127 * 128 + tid] = bf2f(pr[C_VS + tid]); }
    }
    __syncthreads();
    {
        const int h = w, kvh = h >> 2; const float sink = a->in[I_SINK][l * 8 + h];
        float sc[3]; sc[2] = -INFINITY;
#pragma unroll
        for (int t = 0; t < 2; ++t) {
            const int s = lane + 64 * t; const f32x4* kp = (const f32x4*)(ck + (size_t)s * 128 + kvh * 64); float d = 0.f;
#pragma unroll
            for (int q = 0; q < 16; ++q) { const f32x4 k = kp[q]; const f32x4 qq = *(const LAS f32x4*)(q_s + h * 64 + q * 4); d += (k[0] * qq[0] + k[1] * qq[1]) + (k[2] * qq[2] + k[3] * qq[3]); }
            sc[t] = (s == 0) ? -INFINITY : d * 0.125f;
        }
        {
            sc[2] = wave_sum(bf2f(pr[C_KS + kvh * 64 + lane]) * q_s[h * 64 + lane]) * 0.125f;
        }
        float mx = fmaxf(fmaxf(sc[0], sc[1]), sc[2]);
#pragma unroll
        for (int o = 1; o < 64; o <<= 1) mx = fmaxf(mx, __shfl_xor(mx, o));
        const float mm = fmaxf(mx, sink);
        const float e0 = __expf(sc[0] - mm), e1 = __expf(sc[1] - mm), e2 = __expf(sc[2] - mm);
        const float sum = wave_sum(e0 + e1) + e2; const float inv = 1.0f / (sum + __expf(sink - mm));
        p_s[h * 132 + lane] = e0 * inv; p_s[h * 132 + 64 + lane] = e1 * inv; if (lane == 0) p_s[h * 132 + 128] = e2 * inv;
        LDSW();
        float o = p_s[h * 132 + 128] * bf2f(pr[C_VS + kvh * 64 + lane]);
#pragma unroll 32
        for (int s = 0; s < 128; ++s) o += p_s[h * 132 + s] * cv[(size_t)s * 128 + kvh * 64 + lane];
        OB1[(size_t)row * OBS + h * 64 + lane] = f2bf(o);
    }
    {
        const int hh = tid >> 7, e = tid & 127; const float gam = 1.0f - exp2f(-5.0f - (float)hh);
        const float* S = a->in[I_SRET] + ((size_t)(l * 128 + j) * 4 + hh) * 8192; float* So = a->out + O_SR + ((size_t)(l * 128 + j) * 4 + hh) * 8192;
        const float v = bf2f(pr[C_VR + hh * 128 + e]); float acc = 0.f, qk = 0.f;
#pragma unroll 32
        for (int d = 0; d < 64; ++d) { const float s = __builtin_nontemporal_load(&S[d * 128 + e]); const float q = rq_s[hh * 64 + d], k = rk_s[hh * 64 + d]; acc += q * s; qk += q * k; __builtin_nontemporal_store(gam * s + k * v, &So[d * 128 + e]); }
        const float o = qk * v + gam * acc;
        float sm = wave_sum(o); if (lane == 0) red_s[w * 2] = sm;
        __syncthreads();
        const float mu = (red_s[(w & ~1) * 2] + red_s[(w | 1) * 2]) * (1.0f / 128.0f); const float dv = o - mu;
        float vs = wave_sum(dv * dv); if (lane == 0) red_s[w * 2 + 1] = vs;
        __syncthreads();
        const float var = (red_s[(w & ~1) * 2 + 1] + red_s[(w | 1) * 2 + 1]) * (1.0f / 128.0f);
        const float y = dv * (1.0f / sqrtf(var + 1e-5f)) * a->in[I_RETN][l * 512 + hh * 128 + e] * fsilu(bf2f(pr[C_GR + hh * 128 + e]));
        OB2[(size_t)row * OBS + hh * 128 + e] = f2bf(y);
    }
    __syncthreads();
}

#define GAS __attribute__((address_space(1)))
#define XB_TMO      128
#define XB_XCNT(j)  (256  + 64 * (j))
#define XB_XSUB(j)  (1280 + 64 * (j))
#define XB_XGEN(j)  (2304 + 64 * (j))
#define XB_TOP      3328
#define XB_TOPGEN   3392
#define XCD_BAR_WORDS 3456
#define XB_SPIN_CAP (1u << 18)

__device__ __forceinline__ unsigned xb_ld(unsigned* p)              { return __hip_atomic_load(p, __ATOMIC_RELAXED, __HIP_MEMORY_SCOPE_AGENT); }
__device__ __forceinline__ unsigned xb_add(unsigned* p, unsigned v) { return __hip_atomic_fetch_add(p, v, __ATOMIC_RELAXED, __HIP_MEMORY_SCOPE_AGENT); }
__device__ __forceinline__ unsigned xb_xcc_id() { return (unsigned)__builtin_amdgcn_s_getreg((3 << 11) | 20) & 0xFu; }
#define XB_SPIN(cond, bar) do { unsigned _sp = 0; while (cond) { __builtin_amdgcn_s_sleep(1); \
    if ((++_sp & 255u) == 0u) { if (xb_ld(&(bar)[XB_TMO])) break; if (_sp > XB_SPIN_CAP) { atomicAdd(&(bar)[XB_TMO], 1u); break; } } } } while (0)

struct XcdBarrier {
    unsigned* bar; unsigned x;
    volatile LAS unsigned* st;
};

__device__ __forceinline__ XcdBarrier xcd_barrier_post(unsigned* bar, volatile LAS unsigned* st) {
    XcdBarrier b; b.bar = bar; b.x = xb_xcc_id(); b.st = st;
    if (threadIdx.x == 0) (void)xb_add(&bar[XB_XCNT(b.x)], 1u);
    return b;
}
__device__ __forceinline__ void xcd_barrier_complete(unsigned* bar, unsigned x, unsigned& nloc, unsigned& nx) {
    const unsigned G = gridDim.x * gridDim.y * gridDim.z;
    unsigned sum, cnt, mine, sp = 0u;
    for (;;) {
        sum = 0u; cnt = 0u; mine = 0u;
#pragma unroll
        for (unsigned j = 0; j < 16; ++j) { const unsigned c = xb_ld(&bar[XB_XCNT(j)]); sum += c; cnt += (c > 0u) ? 1u : 0u; mine = (j == x) ? c : mine; }
        if (sum == G) break;
        __builtin_amdgcn_s_sleep(1);
        if ((++sp & 255u) == 0u) { if (xb_ld(&bar[XB_TMO])) break; if (sp > XB_SPIN_CAP) { atomicAdd(&bar[XB_TMO], 1u); break; } }
    }
    nloc = mine > 0u ? mine : 1u; nx = cnt > 0u ? cnt : 1u;
}

__device__ __forceinline__ void xcd_barrier(const XcdBarrier& b) {
    asm volatile("s_waitcnt vmcnt(0)" ::: "memory");
    __syncthreads();
    if (threadIdx.x == 0) {
        unsigned* bar = b.bar;
        __builtin_amdgcn_s_waitcnt(0);
        unsigned nloc = b.st[0], nx = b.st[1];
        if (nloc == 0u) { xcd_barrier_complete(bar, b.x, nloc, nx); b.st[0] = nloc; b.st[1] = nx; }
        const unsigned old = xb_add(&bar[XB_XSUB(b.x)], 1u);
        const unsigned gen = old / nloc;
        if (old + 1u == (gen + 1u) * nloc) {
            __builtin_amdgcn_fence(__ATOMIC_RELEASE, "agent");
            asm volatile("s_waitcnt vmcnt(0)" ::: "memory");
            const unsigned og = xb_add(&bar[XB_TOP], 1u);
            const unsigned tg = og / nx;
            if (og + 1u == (tg + 1u) * nx) xb_add(&bar[XB_TOPGEN], 1u);
            else XB_SPIN(xb_ld(&bar[XB_TOPGEN]) == tg, bar);
            __builtin_amdgcn_fence(__ATOMIC_ACQUIRE, "agent");
            xb_add(&bar[XB_XGEN(b.x)], 1u);
            asm volatile("s_waitcnt vmcnt(0)" ::: "memory");
        } else {
            XB_SPIN(xb_ld(&bar[XB_XGEN(b.x)]) == gen, bar);
            __builtin_amdgcn_fence(__ATOMIC_ACQUIRE, "agent");
            asm volatile("s_waitcnt vmcnt(0)" ::: "memory");
        }
    }
    __syncthreads();
}


template <class Sched> __device__ __forceinline__ void rs_prestep(const Sched& S, const float* ss, float* rs) {
    const int tid = tid_opaque();
    int pmv[8];
#pragma unroll
    for (int i = 0; i < 8; ++i) { pg8::Unit u; pmv[i] = S.next(i, u) ? u.pm : -1; }
    const int r0 = (tid < 256) ? tid : TROW0 + (tid - 256);
    float v[9];
#pragma unroll
    for (int i = 0; i < 8; ++i) { v[i] = 0.f; if (tid < 256 && pmv[i] >= 0) v[i] = pg8::row_ss(ss, pmv[i] * 256 + tid); }
    v[8] = 0.f; if (tid >= 256) v[8] = pg8::row_ss(ss, r0);
    float v9 = 0.f; if (tid < 128) v9 = pg8::row_ss(ss, TROW0 + 256 + tid);
#pragma unroll
    for (int i = 0; i < 8; ++i) if (tid < 256 && pmv[i] >= 0) rs[pmv[i] * 256 + tid] = __builtin_amdgcn_rsqf(v[i] * (1.0f / 1024.0f) + 1e-6f);
    if (tid >= 256) rs[r0] = __builtin_amdgcn_rsqf(v[8] * (1.0f / 1024.0f) + 1e-6f);
    if (tid < 128) rs[TROW0 + 256 + tid] = __builtin_amdgcn_rsqf(v9 * (1.0f / 1024.0f) + 1e-6f);
    asm volatile("s_waitcnt vmcnt(0)" ::: "memory");
    __syncthreads();
}

#define R_GU 1
#define R_WIN 1
#define R_MIX1 1
#define R_CARRY 1
#define R_MIX2 1
#define R_XSYNC 0
__global__ void __launch_bounds__(NTHR, 2) mk_fwd(Args a_unused) {
    extern __shared__ __attribute__((aligned(16))) unsigned char lds_raw[];
    LAS unsigned char* lds = (LAS unsigned char*)lds_raw;
    cg::grid_group grid = cg::this_grid();
    CArgs* kp0 = (CArgs*)__builtin_amdgcn_kernarg_segment_ptr();
    if (threadIdx.x < 64) ((LAS unsigned*)(lds + 131072))[threadIdx.x] = 0u;
    __syncthreads();
    XcdBarrier xbar; xbar.bar = (unsigned*)(kp0->ws + WS_BAR); xbar.x = 0; xbar.st = (volatile LAS unsigned*)(lds + 131072);
    const int lo = kp0->ph_lo, hi = kp0->ph_hi; int ph = 0;
#define PH_PTRS int tid = threadIdx.x; asm volatile("" : "+v"(tid)); const int lane = tid & 63, wave = __builtin_amdgcn_readfirstlane(tid >> 6); \
    int bid_ = blockIdx.x; asm volatile("" : "+s"(bid_)); const int G = gridDim.x, bid = bid_, gw = bid * 8 + wave, ngw = G * 8; (void)lane; (void)gw; (void)ngw; CArgs* a = kp0; asm volatile("" : "+s"(a)); unsigned char* ws = a->ws; \
    float* SS = (float*)(ws + WS_SS16); float* LSUM = (float*)(ws + WS_LSUM); float* LCAR = (float*)(ws + WS_LCAR); \
    float* X = (float*)(ws + WS_X); bf16_t* XB = (bf16_t*)(ws + WS_XB); bf16_t* PA = (bf16_t*)(ws + WS_PA); bf16_t* HB = PA; bf16_t* MB = (bf16_t*)(ws + WS_PA); \
    bf16_t* GT = (bf16_t*)(ws + WS_GT); bf16_t* OB = (bf16_t*)(ws + WS_OB); float* U = (float*)(ws + WS_U); float* AG = (float*)(ws + WS_XB); float* BG = (float*)(ws + WS_BG); (void)AG; (void)BG; bf16_t* ST = (bf16_t*)(ws + WS_ST); \
    unsigned char* wb = ws + WS_W0 + (size_t)(l & 1) * WSZ; \
    float* RS = (float*)(ws + WS_RS); const float* rs0 = RS + (size_t)(3 * l) * MP; float* rs1 = RS + (size_t)(3 * l + 1) * MP; float* rs2 = RS + (size_t)(3 * l + 2) * MP; float* rs3 = RS + (size_t)(3 * l + 3) * MP; (void)rs0; (void)rs1; (void)rs2; (void)rs3; \
    const float* ss0 = SS + (size_t)(3 * l) * MP * 16; float* ss1 = SS + (size_t)(3 * l + 1) * MP * 16; float* ss2 = SS + (size_t)(3 * l + 2) * MP * 16; float* ss3 = SS + (size_t)(3 * l + 3) * MP * 16; \
    (void)SS; (void)LSUM; (void)LCAR; (void)X; (void)XB; (void)PA; (void)HB; (void)MB; (void)GT; (void)OB; (void)U; (void)ST; (void)wb; (void)ss0; (void)ss1; (void)ss2; (void)ss3;
#define PH_BEGIN(n) if (ph >= lo && ph < hi) { PH_PTRS for (int rep_ = 0; rep_ < (n); ++rep_) {
#define PH_END if (ph + 1 < hi) { if (ph == 0) { asm volatile("s_waitcnt vmcnt(0)" ::: "memory"); grid.sync(); xbar = xcd_barrier_post((unsigned*)(kp0->ws + WS_BAR), (volatile LAS unsigned*)(lds + 131072)); } else xcd_barrier(xbar); } } } ++ph;

    { const int l = 0;
    PH_BEGIN(1)
        if (bid == 0) { for (int i = tid; i < XCD_BAR_WORDS; i += NTHR) ((unsigned*)(ws + WS_BAR))[i] = 0u; }
        init_rows(a, X, XB, SS, RS, OB, gw, ngw, lane);
        convert_layer(a, 0, ws + WS_W0, lds, gw, ngw, wave, lane);
    PH_END
    }

#pragma unroll 1
    for (int l = 0; l < DEPTH; ++l) {
        PH_BEGIN(R_GU)
            pg8::Gemm g{XB, (const bf16_t*)(wb + W_GU1), TROW0, 4096, DM, 1, 0}; pg8::StaticOrder S; S.init(TROW0, 4096, G, bid);
            rs_prestep(S, ss0, RS + (size_t)(3 * l) * MP);
            pg8::EpiSwiGLU E{HB, rs0}; pg8::gemm_phase<pg8::EpiSwiGLU, pg8::StaticOrder, true, true>(lds, g, S, E);
            { const TailArgs ta{XB, (const bf16_t*)(wb + W_GU1), DM, 4096, HB, nullptr, nullptr, rs0, nullptr, nullptr, 0.f}; tail_gemm<TM_SWIGLU>(ta, bid, G, lds); }
        PH_END
        PH_BEGIN(1)
            pg8::Gemm g{HB, (const bf16_t*)(wb + W_D1), TROW0, DM, FF, 1, 0}; pg8::StaticOrder S; S.init(TROW0, DM, G, bid);
            pg8::EpiResid E{X, XB, ss1, 0.5f}; pg8::gemm_phase<pg8::EpiResid, pg8::StaticOrder, true, true>(lds, g, S, E);
            { const TailArgs ta{HB, (const bf16_t*)(wb + W_D1), FF, DM, XB, nullptr, X, nullptr, ss1, nullptr, 0.5f}; tail_gemm<TM_RESID>(ta, bid, G, lds); }
        PH_END
        PH_BEGIN(R_WIN)
            pg8::Gemm g{XB, (const bf16_t*)(wb + W_IN), TROW0, NIN, DM, 1, 0}; pg8::StaticOrder S; S.init(TROW0, NIN, G, bid);
            rs_prestep(S, ss1, rs1);
            pg8::EpiProj E{PA, GT, rs1}; pg8::gemm_phase<pg8::EpiProj, pg8::StaticOrder, true, true>(lds, g, S, E);
            { const TailArgs ta{XB, (const bf16_t*)(wb + W_IN), DM, NIN, PA, GT, nullptr, rs1, nullptr, nullptr, 0.f}; if (G == 256) { if (bid >= 64) tail_gemm<TM_PROJ>(ta, bid - 64, 192, lds); } else tail_gemm<TM_PROJ>(ta, bid, G, lds); }
        PH_END
        PH_BEGIN(R_MIX1)
            for (int it = bid; it < 1048 + 520 + 260; it += G) {
                if (it < 1048) lru1_item(a, l, it >> 3, it & 7, PA, OB, LSUM, AG, BG, lds);
                else if (it < 1048 + 520) ret_u_item(it - 1048, PA, U, lds);
                else swa_item(a, l, it - (1048 + 520), PA, OB + 512, lds);
            }
        PH_END
        PH_BEGIN(R_CARRY)
            for (int it = bid; it < 130; it += G) carry_item(a, l, it, LSUM, LCAR, U, ST);
            if (G == 256) { if (bid >= 128) sample_item(a, l, bid - 128, PA, OB + 512, OB + 1024, lds); } else { for (int it = bid; it < 128; it += G) sample_item(a, l, it, PA, OB + 512, OB + 1024, lds); }
            if (l + 1 < DEPTH) {
                __syncthreads();
                const int nsh = (G == 256) ? (bid < 128 ? 3 : 1) : 1, sh0 = (G == 256) ? (bid < 128 ? bid * 3 : 384 + (bid - 128)) : bid, nshares = (G == 256) ? 512 : G;
#pragma unroll 1
                for (int v = 0; v < nsh; ++v) convert_layer(a, l + 1, ws + WS_W0 + (size_t)((l + 1) & 1) * WSZ, lds, (sh0 + v) * 8 + wave, nshares * 8, wave, lane);
            }
        PH_END
        PH_BEGIN(R_MIX2)
            for (int it = bid; it < 520 + 1040; it += G) {
                if (it < 520) ret_out_item(a, l, it, PA, ST, OB + 1024, lds);
                else { const int q = it - 520; lru2_item(q >> 3, q & 7, PA, OB, LCAR, AG, BG, lds); }
            }
        PH_END
        PH_BEGIN(1)
            pg8::Gemm g{OB, (const bf16_t*)(wb + W_BR), TROW0, DM, OBS, 1, 0}; pg8::StaticOrder S; S.init(TROW0, DM, G, bid);
            pg8::EpiBranch E{MB, GT}; pg8::gemm_phase<pg8::EpiBranch, pg8::StaticOrder, true, true>(lds, g, S, E);
            { const TailArgs ta{OB, (const bf16_t*)(wb + W_BR), OBS, DM, MB, nullptr, nullptr, nullptr, nullptr, GT, 0.f}; tail_gemm<TM_BRANCH>(ta, bid, G, lds); }
        PH_END
        PH_BEGIN(1)
            pg8::Gemm g{MB, (const bf16_t*)(wb + W_OUT), TROW0, DM, DM, 1, 0}; pg8::StaticOrder S; S.init(TROW0, DM, G, bid);
            pg8::EpiResid E{X, XB, ss2, 1.0f}; pg8::gemm_phase<pg8::EpiResid, pg8::StaticOrder, true, true>(lds, g, S, E);
            { const TailArgs ta{MB, (const bf16_t*)(wb + W_OUT), DM, DM, XB, nullptr, X, nullptr, ss2, nullptr, 1.0f}; tail_gemm<TM_RESID>(ta, bid, G, lds); }
        PH_END
        PH_BEGIN(1)
            for (int xs_ = 0; xs_ < R_XSYNC; ++xs_) grid.sync();
            pg8::Gemm g{XB, (const bf16_t*)(wb + W_GU2), TROW0, 4096, DM, 1, 0}; pg8::StaticOrder S; S.init(TROW0, 4096, G, bid);
            rs_prestep(S, ss2, rs2);
            pg8::EpiSwiGLU E{HB, rs2}; pg8::gemm_phase<pg8::EpiSwiGLU, pg8::StaticOrder, true, true>(lds, g, S, E);
            { const TailArgs ta{XB, (const bf16_t*)(wb + W_GU2), DM, 4096, HB, nullptr, nullptr, rs2, nullptr, nullptr, 0.f}; tail_gemm<TM_SWIGLU>(ta, bid, G, lds); }
        PH_END
        PH_BEGIN(1)
            pg8::Gemm g{HB, (const bf16_t*)(wb + W_D2), TROW0, DM, FF, 1, 0}; pg8::StaticOrder S; S.init(TROW0, DM, G, bid);
            pg8::EpiResid E{X, XB, ss3, 0.5f}; pg8::gemm_phase<pg8::EpiResid, pg8::StaticOrder, true, true>(lds, g, S, E);
            { const TailArgs ta{HB, (const bf16_t*)(wb + W_D2), FF, DM, XB, nullptr, X, nullptr, ss3, nullptr, 0.5f}; tail_gemm<TM_RESID>(ta, bid, G, lds); }
        PH_END
    }
    { const int l = 0;
    PH_BEGIN(1)
        const float* ssf = SS + (size_t)12 * MP * 16; const float* gf = a->in[I_FINN];
        for (int r = gw; r < MREAL; r += ngw) {
            float* dst = nullptr;
            if (r < 2 * BROWS) { const int b = r / BROWS, pr = r % BROWS; if (pr >= PADR + 16) dst = a->out + O_YP + ((size_t)b * 8192 + (pr - PADR - 16)) * DM; }
            else dst = a->out + O_YS + (size_t)(r - SROW0) * DM;
            if (dst) {
                const float rs = __builtin_amdgcn_rsqf(pg8::row_ss(ssf, r) * (1.0f / 1024.0f) + 1e-6f);
#pragma unroll
                for (int j = 0; j < 4; ++j) { const f32x4 v = *((const f32x4*)(X + (size_t)r * DM) + lane + 64 * j); const f32x4 gg = *((const f32x4*)gf + lane + 64 * j); __builtin_nontemporal_store(v * rs * gg, (f32x4*)dst + lane + 64 * j); }
            }
        }
    PH_END
    }
#undef PH_BEGIN
#undef PH_END
}
constexpr int NPHASES = 2 + 10 * DEPTH;

#ifndef MK_MULTI
#define MK_MULTI 0
#endif
extern "C" void kernel_launch(void* const* d_in, const int* in_sizes, int n_in, void* d_out, int out_size, void* d_ws, size_t ws_size, hipStream_t stream) {
    static int grid = 0;
    if (grid == 0) {
        if (n_in != 30 || ws_size < WS_END) { fprintf(stderr, "kernel_launch: unexpected inputs (n_in %d, ws %zu < %zu)\n", n_in, ws_size, (size_t)WS_END); grid = -1; return; }
        int dev = 0, cus = 0, per_cu = 0;
        (void)hipGetDevice(&dev); (void)hipDeviceGetAttribute(&cus, hipDeviceAttributeMultiprocessorCount, dev);
        if (hipFuncSetAttribute((const void*)mk_fwd, hipFuncAttributeMaxDynamicSharedMemorySize, LDS_BYTES) != hipSuccess) { fprintf(stderr, "kernel_launch: hipFuncSetAttribute failed\n"); grid = -1; return; }
        if (hipOccupancyMaxActiveBlocksPerMultiprocessor(&per_cu, (const void*)mk_fwd, NTHR, LDS_BYTES) != hipSuccess || per_cu < 1) { fprintf(stderr, "kernel_launch: occupancy query says %d\n", per_cu); per_cu = 1; }
        (void)hipGetLastError();
        grid = cus * 1;
        if (grid <= 0) grid = 256;
    }
    if (grid < 0) return;
    Args a{};
    for (int i = 0; i < 30; ++i) a.in[i] = (const float*)d_in[i];
    a.out = (float*)d_out; a.ws = (unsigned char*)d_ws;
#if MK_MULTI
    for (int p = 0; p < NPHASES; ++p) { a.ph_lo = p; a.ph_hi = p + 1; hipLaunchKernelGGL(mk_fwd, dim3(grid), dim3(NTHR), LDS_BYTES, stream, a); }
#else
    a.ph_lo = 0; a.ph_hi = NPHASES;
    void* args[] = {&a};
    hipError_t e = hipLaunchCooperativeKernel((const void*)mk_fwd, dim3(grid), dim3(NTHR), args, LDS_BYTES, stream);
    if (e != hipSuccess) fprintf(stderr, "cooperative launch failed: %s (grid %d)\n", hipGetErrorString(e), grid);
#endif
}
```

```cpp
#include <hip/hip_runtime.h>
#include <hip/hip_cooperative_groups.h>
#include <cstdio>
#include <cstdint>
#include <cmath>
namespace cg = cooperative_groups;

namespace pg8 {
#define PG8_LAS __attribute__((address_space(3)))
typedef unsigned short bf16_t;
typedef short bf16x8 __attribute__((ext_vector_type(8)));
typedef float f32x4 __attribute__((ext_vector_type(4)));
typedef unsigned u32x4 __attribute__((ext_vector_type(4)));
constexpr int BM = 256, BK = 64, HALF = 128, HTB = HALF * BK * 2  , STAGE_BYTES = 8 * HTB, NXCD = 8, WGM = 8;

__host__ __device__ __forceinline__ int lds_byte(int r, int c) { const int st = (r >> 4) * 2 + (c >> 5), rr = r & 15, cc = c & 31, ob = rr * 64 + cc * 2; return st * 1024 + (ob ^ (((ob >> 9) & 1) << 5)); }
__host__ __device__ __forceinline__ void stage_rc(int b, int& R, int& C) { const int st = b / 1024, sb = b % 1024, swz = sb ^ (((sb >> 9) & 1) << 5); R = (st >> 1) * 16 + swz / 64; C = (st & 1) * 32 + (swz % 64) / 2; }
__host__ __device__ __forceinline__ int perm32(int rho) { const int n = rho >> 4, i = rho & 15; return 8 * (i >> 2) + 4 * n + (i & 3); }

struct Unit { int pm, pn; };
struct Gemm { const bf16_t* A; const bf16_t* Bt; int M, N, K; int agdiv; size_t agstride; };

struct StaticOrder {
    int nM, nN, nwg, G, c;
    __host__ __device__ void init(int M, int N, int G_, int c_) { nM = M / BM; nN = N / BM; nwg = nM * nN; G = G_; c = c_; }
    __host__ __device__ bool next(int i, Unit& u) const {
        const long L = (long)i * G + c; if (L >= nwg) return false;
        int wgid = (int)L; { const int q = nwg / NXCD, r = nwg % NXCD, xcd = wgid % NXCD, off = wgid / NXCD; wgid = (xcd < r ? xcd * (q + 1) : r * (q + 1) + (xcd - r) * q) + off; }
        const int nig = WGM * nN, gid = wgid / nig, fm = gid * WGM, gsz = (nM - fm) < WGM ? (nM - fm) : WGM;
        u.pm = fm + ((wgid % nig) % gsz); u.pn = (wgid % nig) / gsz; return true;
    }
    __device__ __forceinline__ void a_ready(const Unit&) const {}
    __device__ __forceinline__ void done(const Unit&) const {}
};

__device__ __forceinline__ unsigned cvt_pk_bf16(float lo, float hi) { unsigned r; asm volatile("v_cvt_pk_bf16_f32 %0, %1, %2" : "=v"(r) : "v"(lo), "v"(hi)); return r; }
typedef unsigned u32x2 __attribute__((ext_vector_type(2)));
__device__ __forceinline__ float fsigmoid(float x) { return __builtin_amdgcn_rcpf(1.0f + __expf(-x)); }
__device__ __forceinline__ float fsilu(float x) { return x * fsigmoid(x); }
__device__ __forceinline__ float bflo(unsigned w) { return __uint_as_float(w << 16); }
__device__ __forceinline__ float bfhi(unsigned w) { return __uint_as_float(w & 0xffff0000u); }

__device__ __forceinline__ float row_ss(const float* ss, int row) {
    const f32x4* p = (const f32x4*)(ss + (size_t)row * 16); const f32x4 a = p[0], b = p[1], c = p[2], d = p[3];
    return (((a[0] + a[1]) + (a[2] + a[3])) + ((b[0] + b[1]) + (b[2] + b[3]))) + (((c[0] + c[1]) + (c[2] + c[3])) + ((d[0] + d[1]) + (d[2] + d[3])));
}
struct EpiSwiGLU {
    static constexpr bool PERM = true, AFTER_DRAIN = false, HAS_MID = false, HAS_PRE = true;
    bf16_t* H; const float* ss;
    __device__ __forceinline__ void pre(float (&rsv)[8], const Unit& u, int wr, int fr) const {
#pragma unroll
        for (int q = 0; q < 8; ++q) rsv[q] = ss[u.pm * BM + wr * 64 + fr + (q >> 2) * HALF + (q & 3) * 16];
    }
    __device__ __forceinline__ void operator()(const f32x4 (&acc)[2][2][4][2], const Unit& u, int wr, int wc, int fr, int fq, const float (&rsv)[8]) const {
        const int row0 = u.pm * BM + wr * 64 + fr, col0 = u.pn * 128 + wc * 32 + 8 * fq;
#pragma unroll
        for (int ai = 0; ai < 2; ++ai)
#pragma unroll
            for (int m = 0; m < 4; ++m) {
                const int row = row0 + ai * HALF + m * 16;
                const float rs = rsv[ai * 4 + m];
                const f32x4 g0 = acc[ai][0][m][0] * rs, g1 = acc[ai][0][m][1] * rs, u0 = acc[ai][1][m][0] * rs, u1 = acc[ai][1][m][1] * rs;
                u32x4 w;
                w.x = cvt_pk_bf16(fsilu(g0[0]) * u0[0], fsilu(g0[1]) * u0[1]); w.y = cvt_pk_bf16(fsilu(g0[2]) * u0[2], fsilu(g0[3]) * u0[3]);
                w.z = cvt_pk_bf16(fsilu(g1[0]) * u1[0], fsilu(g1[1]) * u1[1]); w.w = cvt_pk_bf16(fsilu(g1[2]) * u1[2], fsilu(g1[3]) * u1[3]);
                *(u32x4*)(H + (size_t)row * 2048 + col0) = w;
            }
    }
};
struct EpiResid {
    static constexpr bool PERM = false, AFTER_DRAIN = false, HAS_MID = false, HAS_PRE = false;
    float* X; bf16_t* XB; float* ssn; float scale;
    __device__ __forceinline__ void operator()(const f32x4 (&acc)[2][2][4][2], const Unit& u, int wr, int wc, int fr, int fq, const float (&)[8]) const {
        const int row0 = u.pm * BM + wr * 64 + fr, col0 = u.pn * BM + wc * 32 + 4 * fq;
#pragma unroll
        for (int ai = 0; ai < 2; ++ai)
#pragma unroll
            for (int m = 0; m < 4; ++m) {
                const int row = row0 + ai * HALF + m * 16; float sq = 0.f;
#pragma unroll
                for (int bj = 0; bj < 2; ++bj)
#pragma unroll
                    for (int n = 0; n < 2; ++n) {
                        const size_t off = (size_t)row * 1024 + col0 + bj * HALF + n * 16;
                        f32x4 x = *(const f32x4*)(X + off); x = x + acc[ai][bj][m][n] * scale; *(f32x4*)(X + off) = x;
                        u32x2 w; w.x = cvt_pk_bf16(x[0], x[1]); w.y = cvt_pk_bf16(x[2], x[3]); *(u32x2*)(XB + off) = w;
                        sq += (x[0] * x[0] + x[1] * x[1]) + (x[2] * x[2] + x[3] * x[3]);
                    }
                sq += __shfl_xor(sq, 16); sq += __shfl_xor(sq, 32);
                if (fq == 0) ssn[(size_t)row * 16 + u.pn * 4 + wc] = sq;
            }
    }
};
struct EpiProj {
    static constexpr bool PERM = true, AFTER_DRAIN = false, HAS_MID = false, HAS_PRE = true;
    bf16_t* PA; bf16_t* GT; const float* ss;
    __device__ __forceinline__ void pre(float (&rsv)[8], const Unit& u, int wr, int fr) const {
#pragma unroll
        for (int q = 0; q < 8; ++q) rsv[q] = ss[u.pm * BM + wr * 64 + fr + (q >> 2) * HALF + (q & 3) * 16];
    }
    __device__ __forceinline__ void operator()(const f32x4 (&acc)[2][2][4][2], const Unit& u, int wr, int wc, int fr, int fq, const float (&rsv)[8]) const {
        const int row0 = u.pm * BM + wr * 64 + fr; const bool gate = u.pn >= 13;
        const int col0 = (gate ? (u.pn - 13) : u.pn) * BM + wc * 32 + 8 * fq;
        bf16_t* base = gate ? GT : PA; const int ld = gate ? 3072 : 3328;
#pragma unroll
        for (int ai = 0; ai < 2; ++ai)
#pragma unroll
            for (int m = 0; m < 4; ++m) {
                const int row = row0 + ai * HALF + m * 16;
                const float rs = rsv[ai * 4 + m];
#pragma unroll
                for (int bj = 0; bj < 2; ++bj) {
                    f32x4 v0 = acc[ai][bj][m][0] * rs, v1 = acc[ai][bj][m][1] * rs;
                    if (gate) {
#pragma unroll
                        for (int k = 0; k < 4; ++k) { v0[k] = fsigmoid(v0[k]); v1[k] = fsigmoid(v1[k]); }
                    }
                    u32x4 w; w.x = cvt_pk_bf16(v0[0], v0[1]); w.y = cvt_pk_bf16(v0[2], v0[3]); w.z = cvt_pk_bf16(v1[0], v1[1]); w.w = cvt_pk_bf16(v1[2], v1[3]);
                    *(u32x4*)(base + (size_t)row * ld + col0 + bj * HALF) = w;
                }
            }
    }
};
struct EpiBranch {
    static constexpr bool PERM = true, AFTER_DRAIN = false, HAS_MID = true, HAS_PRE = false;
    bf16_t* MB; const bf16_t* GT;
    __device__ __forceinline__ void mid(f32x4 (&acc)[2][2][4][2], const Unit& u, int seg, int wr, int wc, int fr, int fq) const {
        int fr_ = fr; asm volatile("" : "+v"(fr_));
        const int row0 = u.pm * BM + wr * 64 + fr_, col0 = u.pn * BM + wc * 32 + 8 * fq;
#pragma unroll
        for (int ai = 0; ai < 2; ++ai)
#pragma unroll
            for (int m = 0; m < 4; ++m) {
                const int row = row0 + ai * HALF + m * 16;
#pragma unroll
                for (int bj = 0; bj < 2; ++bj) {
                    const bf16_t* gp = GT + (size_t)row * 3072 + (seg - 1) * 1024 + col0 + bj * HALF;
                    const u32x4 g0 = *(const u32x4*)gp, g1 = *(const u32x4*)(gp + 1024);
                    f32x4 r0, r1;
                    r0[0] = bflo(g0.x) * __builtin_amdgcn_rcpf(fmaxf(bflo(g1.x), 1e-30f)); r0[1] = bfhi(g0.x) * __builtin_amdgcn_rcpf(fmaxf(bfhi(g1.x), 1e-30f));
                    r0[2] = bflo(g0.y) * __builtin_amdgcn_rcpf(fmaxf(bflo(g1.y), 1e-30f)); r0[3] = bfhi(g0.y) * __builtin_amdgcn_rcpf(fmaxf(bfhi(g1.y), 1e-30f));
                    r1[0] = bflo(g0.z) * __builtin_amdgcn_rcpf(fmaxf(bflo(g1.z), 1e-30f)); r1[1] = bfhi(g0.z) * __builtin_amdgcn_rcpf(fmaxf(bfhi(g1.z), 1e-30f));
                    r1[2] = bflo(g0.w) * __builtin_amdgcn_rcpf(fmaxf(bflo(g1.w), 1e-30f)); r1[3] = bfhi(g0.w) * __builtin_amdgcn_rcpf(fmaxf(bfhi(g1.w), 1e-30f));
                    acc[ai][bj][m][0] = acc[ai][bj][m][0] * r0; acc[ai][bj][m][1] = acc[ai][bj][m][1] * r1;
                }
                if (m == 3) asm volatile("" ::: "memory");
            }
    }
    __device__ __forceinline__ void operator()(const f32x4 (&acc)[2][2][4][2], const Unit& u, int wr, int wc, int fr, int fq, const float (&)[8]) const {
        const int row0 = u.pm * BM + wr * 64 + fr, col0 = u.pn * BM + wc * 32 + 8 * fq;
#pragma unroll
        for (int ai = 0; ai < 2; ++ai)
#pragma unroll
            for (int m = 0; m < 4; ++m) {
                const int row = row0 + ai * HALF + m * 16;
#pragma unroll
                for (int bj = 0; bj < 2; ++bj) {
                    const u32x4 gt = *(const u32x4*)(GT + (size_t)row * 3072 + 2048 + col0 + bj * HALF);
                    const f32x4 v0 = acc[ai][bj][m][0], v1 = acc[ai][bj][m][1];
                    u32x4 w;
                    w.x = cvt_pk_bf16(v0[0] * bflo(gt.x), v0[1] * bfhi(gt.x)); w.y = cvt_pk_bf16(v0[2] * bflo(gt.y), v0[3] * bfhi(gt.y));
                    w.z = cvt_pk_bf16(v1[0] * bflo(gt.z), v1[1] * bfhi(gt.z)); w.w = cvt_pk_bf16(v1[2] * bflo(gt.w), v1[3] * bfhi(gt.w));
                    *(u32x4*)(MB + (size_t)row * 1024 + col0 + bj * HALF) = w;
                }
            }
    }
};


template <class Epi, class Sched, bool ALIGN_EPI = false, bool SP2 = false>
__device__ __forceinline__ void gemm_phase(PG8_LAS unsigned char* lds, const Gemm g, const Sched& S, const Epi& E) {
    int tid_ = threadIdx.x; asm volatile("" : "+v"(tid_));
    const int tid = tid_, wid = __builtin_amdgcn_readfirstlane(tid >> 6), lane = tid & 63, wr = wid >> 2, wc = wid & 3, fr = lane & 15, fq = lane >> 4;
    const int K = g.K, nt = K / BK;
    unsigned voffA[2], voffB[2];
#pragma unroll
    for (int i = 0; i < 2; ++i) { int R, C; stage_rc(tid * 16 + i * 8192, R, C); const int Rb = Epi::PERM ? ((R & ~31) + perm32(R & 31)) : R;
        voffA[i] = (unsigned)(R * K + C) * 2u; voffB[i] = (unsigned)(Rb * K + C) * 2u; }
    const size_t kstep = (size_t)(BK * 2);
    const size_t hstep = (size_t)HALF * K * 2;
    const size_t tstep = 2 * hstep;
    const unsigned ldsw = (unsigned)wid * 1024u;
    const int aoff = lds_byte(wr * 64 + fr, fq * 8), boff = lds_byte(wc * 32 + fr, fq * 8);
#define PG8_SA(b, h) (((b) * 2 + (h)) * HTB)
#define PG8_SB(b, h) ((4 + (b) * 2 + (h)) * HTB)
#define PG8_STAGE(bufoff, gbase, voff) do { _Pragma("unroll") for (int _i = 0; _i < 2; ++_i) \
        __builtin_amdgcn_global_load_lds((const unsigned*)((const char*)(gbase) + (voff)[_i]), (PG8_LAS unsigned*)(lds + (bufoff) + ldsw + _i * 8192), 16, 0, 0); } while (0)
#define PG8_LDA(dst, b, h) do { _Pragma("unroll") for (int m = 0; m < 4; ++m) _Pragma("unroll") for (int k = 0; k < 2; ++k) dst[m][k] = *(const PG8_LAS bf16x8*)(lds + PG8_SA(b, h) + aoff + m * 2048 + k * 1024); } while (0)
#define PG8_LDB(dst, b, h) do { _Pragma("unroll") for (int n = 0; n < 2; ++n) _Pragma("unroll") for (int k = 0; k < 2; ++k) dst[n][k] = *(const PG8_LAS bf16x8*)(lds + PG8_SB(b, h) + boff + n * 2048 + k * 1024); } while (0)
#define PG8_MMA(ai, bj, At, Bt) do { __builtin_amdgcn_s_setprio(1); _Pragma("unroll") for (int m = 0; m < 4; ++m) _Pragma("unroll") for (int n = 0; n < 2; ++n) _Pragma("unroll") for (int k = 0; k < 2; ++k) \
        acc[ai][bj][m][n] = __builtin_amdgcn_mfma_f32_16x16x32_bf16(Bt[n][k], At[m][k], acc[ai][bj][m][n], 0, 0, 0); __builtin_amdgcn_s_setprio(0); } while (0)
#define PG8_WAIT_V(n) asm volatile("s_waitcnt vmcnt(" #n ")" ::: "memory")
#define PG8_WAIT_L(n) asm volatile("s_waitcnt lgkmcnt(" #n ")" ::: "memory")
#define PG8_BAR __builtin_amdgcn_s_barrier()
#define PG8_SCHED __builtin_amdgcn_sched_barrier(0)
    Unit cur, nxt; int ui = 0;
    if (!S.next(0, cur)) return;
    float rsv[8] = {0.f, 0.f, 0.f, 0.f, 0.f, 0.f, 0.f, 0.f};
    f32x4 acc[2][2][4][2];
#pragma unroll
    for (int a = 0; a < 2; ++a)
#pragma unroll
        for (int b = 0; b < 2; ++b)
#pragma unroll
            for (int m = 0; m < 4; ++m)
#pragma unroll
                for (int n = 0; n < 2; ++n) acc[a][b][m][n] = (f32x4){0.f, 0.f, 0.f, 0.f};
    bf16x8 At[4][2], B0[2][2], B1[2][2];
    const char* cA = (const char*)g.A + (size_t)cur.pm * tstep + (size_t)(cur.pn / g.agdiv) * g.agstride; const char* cB = (const char*)g.Bt + (size_t)cur.pn * tstep;
    S.a_ready(cur);
    if constexpr (SP2) {
        PG8_STAGE(PG8_SB(0, 0), cB, voffB); PG8_STAGE(PG8_SB(0, 1), cB + hstep, voffB); PG8_STAGE(PG8_SA(0, 0), cA, voffA); PG8_STAGE(PG8_SA(0, 1), cA + hstep, voffA);
        if (wr == 1) PG8_BAR;
        PG8_WAIT_V(2); PG8_BAR;
        PG8_STAGE(PG8_SB(1, 0), cB + kstep, voffB); PG8_STAGE(PG8_SA(1, 0), cA + kstep, voffA); PG8_STAGE(PG8_SB(1, 1), cB + hstep + kstep, voffB);
        PG8_WAIT_V(6); PG8_BAR;
    } else {
        PG8_STAGE(PG8_SB(0, 0), cB, voffB); PG8_STAGE(PG8_SA(0, 0), cA, voffA); PG8_STAGE(PG8_SB(0, 1), cB + hstep, voffB); PG8_STAGE(PG8_SA(0, 1), cA + hstep, voffA);
        if (wr == 1) PG8_BAR;
        PG8_WAIT_V(4); PG8_BAR;
        PG8_STAGE(PG8_SB(1, 0), cB + kstep, voffB); PG8_STAGE(PG8_SA(1, 0), cA + kstep, voffA); PG8_STAGE(PG8_SB(1, 1), cB + hstep + kstep, voffB);
        PG8_WAIT_V(6); PG8_BAR;
    }
    for (;;) {
        const bool has_next = S.next(ui + 1, nxt);
        const char* nA = has_next ? (const char*)g.A + (size_t)nxt.pm * tstep + (size_t)(nxt.pn / g.agdiv) * g.agstride : cA; const char* nB = has_next ? (const char*)g.Bt + (size_t)nxt.pn * tstep : cB;
        for (int t = 0; t < nt; t += 2) {
            if constexpr (Epi::HAS_MID) { if (t == 8 || t == 16) E.mid(acc, cur, t >> 3, wr, wc, fr, fq); }
            const bool last = (t == nt - 2);
            const char* a1 = cA + (size_t)(t + 1) * kstep;
            const char* a2 = last ? nA : cA + (size_t)(t + 2) * kstep; const char* b2 = last ? nB : cB + (size_t)(t + 2) * kstep;
            const char* a3 = a2 + kstep; const char* b3 = b2 + kstep;
            if (last && has_next) S.a_ready(nxt);
            if constexpr (Epi::HAS_PRE) { if (last) E.pre(rsv, cur, wr, fr); }
            if constexpr (SP2) {
            PG8_LDB(B0, 0, 0); PG8_LDB(B1, 0, 1); PG8_SCHED; PG8_LDA(At, 0, 0); PG8_STAGE(PG8_SA(1, 1), a1 + hstep, voffA);
            PG8_WAIT_V(8); PG8_WAIT_L(0); PG8_BAR; PG8_MMA(0, 0, At, B0); PG8_MMA(0, 1, At, B1); PG8_BAR; PG8_SCHED;
            PG8_LDA(At, 0, 1); PG8_STAGE(PG8_SB(0, 0), b2, voffB); PG8_STAGE(PG8_SB(0, 1), b2 + hstep, voffB); PG8_STAGE(PG8_SA(0, 0), a2, voffA);
            PG8_WAIT_V(8); PG8_WAIT_L(0); PG8_BAR; PG8_MMA(1, 0, At, B0); PG8_MMA(1, 1, At, B1); PG8_BAR; PG8_SCHED;
            PG8_LDB(B0, 1, 0); PG8_LDB(B1, 1, 1); PG8_SCHED; PG8_LDA(At, 1, 0); PG8_STAGE(PG8_SA(0, 1), a2 + hstep, voffA);
            PG8_WAIT_V(8); PG8_WAIT_L(0); PG8_BAR; PG8_MMA(0, 0, At, B0); PG8_MMA(0, 1, At, B1); PG8_BAR; PG8_SCHED;
            PG8_LDA(At, 1, 1); PG8_STAGE(PG8_SB(1, 0), b3, voffB); PG8_STAGE(PG8_SB(1, 1), b3 + hstep, voffB); PG8_STAGE(PG8_SA(1, 0), a3, voffA);
            PG8_WAIT_V(8); PG8_WAIT_L(0); PG8_BAR; PG8_MMA(1, 0, At, B0); PG8_MMA(1, 1, At, B1); PG8_BAR; PG8_SCHED;
            } else {
            PG8_LDB(B0, 0, 0); PG8_SCHED; PG8_LDA(At, 0, 0); PG8_STAGE(PG8_SA(1, 1), a1 + hstep, voffA);
            PG8_WAIT_L(8); PG8_BAR; PG8_WAIT_L(0); PG8_MMA(0, 0, At, B0); PG8_BAR; PG8_SCHED;
            PG8_LDB(B1, 0, 1); PG8_STAGE(PG8_SB(0, 0), b2, voffB);
            PG8_BAR; PG8_WAIT_L(0); PG8_MMA(0, 1, At, B1); PG8_BAR;
            PG8_LDA(At, 0, 1); PG8_STAGE(PG8_SA(0, 0), a2, voffA);
            PG8_BAR; PG8_WAIT_L(0); PG8_MMA(1, 0, At, B0); PG8_BAR; PG8_SCHED;
            PG8_STAGE(PG8_SB(0, 1), b2 + hstep, voffB);
            PG8_WAIT_V(6); PG8_BAR; PG8_MMA(1, 1, At, B1); PG8_BAR;
            PG8_LDB(B0, 1, 0); PG8_SCHED; PG8_LDA(At, 1, 0); PG8_STAGE(PG8_SA(0, 1), a2 + hstep, voffA);
            PG8_WAIT_L(8); PG8_BAR; PG8_WAIT_L(0); PG8_MMA(0, 0, At, B0); PG8_BAR; PG8_SCHED;
            PG8_LDB(B1, 1, 1); PG8_STAGE(PG8_SB(1, 0), b3, voffB);
            PG8_BAR; PG8_WAIT_L(0); PG8_MMA(0, 1, At, B1); PG8_BAR;
            PG8_LDA(At, 1, 1); PG8_STAGE(PG8_SA(1, 0), a3, voffA);
            PG8_BAR; PG8_WAIT_L(0); PG8_MMA(1, 0, At, B0); PG8_BAR; PG8_SCHED;
            PG8_STAGE(PG8_SB(1, 1), b3 + hstep, voffB);
            PG8_WAIT_V(6); PG8_BAR; PG8_MMA(1, 1, At, B1); PG8_BAR;
            }
        }
        if constexpr (ALIGN_EPI) { if (wr == 0) PG8_BAR; }
        if constexpr (!Epi::AFTER_DRAIN) { E(acc, cur, wr, wc, fr, fq, rsv); S.done(cur); }
        if (!has_next) break;
#pragma unroll
        for (int a = 0; a < 2; ++a)
#pragma unroll
            for (int b = 0; b < 2; ++b)
#pragma unroll
                for (int m = 0; m < 4; ++m)
#pragma unroll
                    for (int n = 0; n < 2; ++n) acc[a][b][m][n] = (f32x4){0.f, 0.f, 0.f, 0.f};
        cur = nxt; cA = nA; cB = nB; ++ui;
        if constexpr (ALIGN_EPI) { if (wr == 1) PG8_BAR; }
    }
    PG8_WAIT_V(0);
    if constexpr (!ALIGN_EPI) { if (wr == 0) PG8_BAR; }
    PG8_BAR;
    if constexpr (Epi::AFTER_DRAIN) { E.fused(acc, cur, wr, wc, fr, fq, lds, wid, lane); S.done(cur); }
#undef PG8_SA
#undef PG8_SB
#undef PG8_STAGE
#undef PG8_LDA
#undef PG8_LDB
#undef PG8_MMA
#undef PG8_WAIT_V
#undef PG8_WAIT_L
#undef PG8_BAR
#undef PG8_SCHED
}
}

#define LAS __attribute__((address_space(3)))
typedef unsigned short bf16_t;
typedef short bf16x8 __attribute__((ext_vector_type(8)));
typedef short s16x4 __attribute__((ext_vector_type(4)));
typedef float f32x4 __attribute__((ext_vector_type(4)));
typedef unsigned u32x4 __attribute__((ext_vector_type(4)));
typedef unsigned u32x2 __attribute__((ext_vector_type(2)));
using pg8::cvt_pk_bf16; using pg8::fsigmoid; using pg8::fsilu; using pg8::bflo; using pg8::bfhi;

constexpr int DM = 1024, FF = 2048, NIN = 6400, DEPTH = 4;
constexpr int MP = 16896;
constexpr int BROWS = 8320;
constexpr int PADR = 112, TPB = 8208, NT = 65;
constexpr int SROW0 = 16640;
constexpr int MREAL = 16768;
constexpr int PAW = 3328, GTW = 3072;
constexpr int C_XA = 0, C_YA = 512, C_QS = 1024, C_KS = 1536, C_VS = 1664, C_QR = 1792, C_KR = 2048, C_VR = 2304, C_GR = 2816;
constexpr int NTHR = 512;
constexpr int OBS = 1536;
constexpr int LDS_BYTES = 131072 + 256;

constexpr size_t MiB = 1u << 20;
constexpr size_t WS_BAR = 0;
constexpr size_t WS_LSUM = 1 * MiB;
constexpr size_t WS_LCAR = WS_LSUM + 1 * MiB;
constexpr size_t WS_W0 = 3 * MiB;
constexpr size_t WSZ = 46 * MiB;
constexpr size_t W_GU1 = 0, W_D1 = 8 * MiB, W_IN = 12 * MiB, W_BR = 25 * MiB, W_OUT = 28 * MiB, W_GU2 = 34 * MiB, W_D2 = 42 * MiB;
constexpr size_t WS_X = WS_W0 + 2 * WSZ;
constexpr size_t WS_XB = WS_X + 66 * MiB;
constexpr size_t WS_PA = WS_XB + 33 * MiB;
constexpr size_t WS_GT = WS_PA + 108 * MiB;
constexpr size_t WS_OB = WS_GT + 99 * MiB;
constexpr size_t WS_U = WS_OB + 50 * MiB;
constexpr size_t WS_ST = WS_U + 17 * MiB;
constexpr size_t WS_SS16 = WS_ST + 9 * MiB;
constexpr size_t WS_BG = WS_SS16 + 14 * MiB;
constexpr size_t WS_RS = WS_BG + 33 * MiB;
constexpr size_t WS_END = WS_RS + 1 * MiB;

constexpr int O_YP = 0, O_YS = 16777216, O_PK = 16908288, O_PV = 17039360, O_PC = 17170432, O_PL = 17182720, O_PR = 17186816,
              O_SK = 17448960, O_SV = 25837568, O_SC = 34226176, O_SL = 35012608, O_SR = 35274752;

enum { I_XP = 0, I_XS, I_CK, I_CV, I_SCONV, I_SLRU, I_SRET, I_META, I_F1N, I_F1GU, I_F1D, I_MIXN, I_WIN, I_CONVW, I_CONVB, I_LWA, I_LBA, I_LWX, I_LBX, I_LAM,
       I_SINK, I_RETN, I_WBA, I_WBB, I_WBC, I_WOUT, I_F2N, I_F2GU, I_F2D, I_FINN };

struct Args { const float* in[30]; float* out; unsigned char* ws; int ph_lo, ph_hi; };
typedef const __attribute__((address_space(4))) Args CArgs;

__device__ __forceinline__ float bf2f(bf16_t v) { return __uint_as_float((unsigned)v << 16); }
__device__ __forceinline__ bf16_t f2bf(float f) { return (bf16_t)(cvt_pk_bf16(f, 0.f) & 0xffffu); }
__device__ __forceinline__ float gelu_tanh(float x) { const float t = 0.7978845608028654f * (x + 0.044715f * x * x * x); const float e = __expf(2.0f * t); const float th = 1.0f - 2.0f * __builtin_amdgcn_rcpf(e + 1.0f); return 0.5f * x * (1.0f + th); }
__device__ __forceinline__ void sincos_rev(float ang, float& s, float& c) {
    const double rv = (double)ang * 0.15915494309189535; const float fr = (float)(rv - __builtin_rint(rv));
    s = __builtin_amdgcn_sinf(fr); c = __builtin_amdgcn_cosf(fr);
}
__device__ __forceinline__ float rope_inv(int i) { return exp2f(-(float)i * (13.287712379549449f / 32.0f)); }
__device__ __forceinline__ float log2_gamma(int h) { return log2f(1.0f - exp2f(-5.0f - (float)h)); }
__device__ __forceinline__ int tid_opaque() { int t = threadIdx.x; asm volatile("" : "+v"(t)); return t; }
#define LDSW() asm volatile("s_waitcnt lgkmcnt(0)" ::: "memory")

__device__ __forceinline__ void cvt_item(const float* W, int K, int N, bf16_t* WT, int ldk, int rep, const float* g, int mode, LAS float* scr, int item, int lane) {
    const int nblk = N / 32, kb = item / nblk, nb = item % nblk, k0 = 64 * kb, n0 = 32 * nb;
    float wv[32];
#pragma unroll
    for (int i = 0; i < 32; ++i) { const int kk = 2 * i + (lane >> 5); wv[i] = __builtin_nontemporal_load(&W[(size_t)(k0 + kk) * N + n0 + (lane & 31)]); }
#pragma unroll
    for (int i = 0; i < 32; ++i) { const int kk = 2 * i + (lane >> 5); float w = wv[i]; if (g) w *= g[k0 + kk]; scr[kk * 33 + (lane & 31)] = w; }
    LDSW();
    const int c = lane & 7;
#pragma unroll
    for (int j = 0; j < 4; ++j) {
        const int n = (lane >> 3) + 8 * j; const LAS float* s = scr + (8 * c) * 33 + n;
        u32x4 o; o.x = cvt_pk_bf16(s[0 * 33], s[1 * 33]); o.y = cvt_pk_bf16(s[2 * 33], s[3 * 33]); o.z = cvt_pk_bf16(s[4 * 33], s[5 * 33]); o.w = cvt_pk_bf16(s[6 * 33], s[7 * 33]);
        const int nn = n0 + n; const int drow = mode ? (256 * ((nn & 2047) >> 7) + 128 * (nn >> 11) + (nn & 127)) : nn;
        for (int r = 0; r < rep; ++r) *(u32x4*)(WT + (size_t)drow * ldk + r * K + k0 + 8 * c) = o;
    }
    LDSW();
}
__device__ __forceinline__ void convert_layer(CArgs* a, int l, unsigned char* wbuf, LAS unsigned char* lds, int gw, int ngw, int wave, int lane) {
    LAS float* scr = (LAS float*)(lds + wave * 8448);
    constexpr int I_GU = 16 * 128, I_D = 32 * 32, I_W = 16 * 200, I_B = 8 * 32, I_O = 16 * 32;
    constexpr int NITEMS = 2 * I_GU + 2 * I_D + I_W + 3 * I_B + I_O;
    for (int it = gw; it < NITEMS; it += ngw) {
        int r = it;
        if (r < I_GU) { cvt_item(a->in[I_F1GU] + (size_t)l * DM * 4096, DM, 4096, (bf16_t*)(wbuf + W_GU1), DM, 1, a->in[I_F1N] + l * DM, 1, scr, r, lane); continue; } r -= I_GU;
        if (r < I_GU) { cvt_item(a->in[I_F2GU] + (size_t)l * DM * 4096, DM, 4096, (bf16_t*)(wbuf + W_GU2), DM, 1, a->in[I_F2N] + l * DM, 1, scr, r, lane); continue; } r -= I_GU;
        if (r < I_D) { cvt_item(a->in[I_F1D] + (size_t)l * FF * DM, FF, DM, (bf16_t*)(wbuf + W_D1), FF, 1, nullptr, 0, scr, r, lane); continue; } r -= I_D;
        if (r < I_D) { cvt_item(a->in[I_F2D] + (size_t)l * FF * DM, FF, DM, (bf16_t*)(wbuf + W_D2), FF, 1, nullptr, 0, scr, r, lane); continue; } r -= I_D;
        if (r < I_W) { cvt_item(a->in[I_WIN] + (size_t)l * DM * NIN, DM, NIN, (bf16_t*)(wbuf + W_IN), DM, 1, a->in[I_MIXN] + l * DM, 0, scr, r, lane); continue; } r -= I_W;
        if (r < 3 * I_B) { const int br = r / I_B; cvt_item((br == 0 ? a->in[I_WBA] : (br == 1 ? a->in[I_WBB] : a->in[I_WBC])) + (size_t)l * 512 * DM, 512, DM, (bf16_t*)(wbuf + W_BR) + br * 512, OBS, 1, nullptr, 0, scr, r % I_B, lane); continue; } r -= 3 * I_B;
        cvt_item(a->in[I_WOUT] + (size_t)l * DM * DM, DM, DM, (bf16_t*)(wbuf + W_OUT), DM, 1, nullptr, 0, scr, r, lane);
    }
}

__device__ __forceinline__ float wave_sum(float v) {
#pragma unroll
    for (int o = 1; o < 64; o <<= 1) v += __shfl_xor(v, o);
    return v;
}
__device__ __forceinline__ void init_rows(CArgs* a, float* X, bf16_t* XB, float* SS, float* RS0, bf16_t* OB, int gw, int ngw, int lane) {
    for (int r = gw; r < MP; r += ngw) {
        const float* src = nullptr;
        if (r < 2 * BROWS) { const int b = r / BROWS, pr = r % BROWS; if (pr >= PADR) { const int t = pr - PADR; src = (t < 16) ? a->in[I_META] + (size_t)t * DM : a->in[I_XP] + ((size_t)b * 8192 + (t - 16)) * DM; } }
        else if (r < MREAL) src = a->in[I_XS] + (size_t)(r - SROW0) * DM;
        float sq = 0.f;
#pragma unroll
        for (int j = 0; j < 4; ++j) {
            f32x4 v = (f32x4){0.f, 0.f, 0.f, 0.f};
            if (src) v = __builtin_nontemporal_load((const f32x4*)src + lane + 64 * j);
            *((f32x4*)(X + (size_t)r * DM) + lane + 64 * j) = v;
            u32x2 w; w.x = cvt_pk_bf16(v[0], v[1]); w.y = cvt_pk_bf16(v[2], v[3]); *((u32x2*)(XB + (size_t)r * DM) + lane + 64 * j) = w;
            sq += (v[0] * v[0] + v[1] * v[1]) + (v[2] * v[2] + v[3] * v[3]);
        }
        sq = wave_sum(sq);
        if (lane < 16) SS[(size_t)r * 16 + lane] = (lane == 0) ? sq : 0.f;
        if (lane == 0) RS0[r] = __builtin_amdgcn_rsqf(sq * (1.0f / 1024.0f) + 1e-6f);
        if (r >= MREAL) {
#pragma unroll
            for (int br = 0; br < 3; ++br) *((u32x4*)(OB + (size_t)r * OBS + br * 512) + lane) = (u32x4){0u, 0u, 0u, 0u};
        }
    }
}

__device__ __forceinline__ void lru1_item(CArgs* a, int l, int tt, int chblk, const bf16_t* PA, bf16_t* OB0, float* LSUM, float* AG, float* BG, LAS unsigned char* lds) {
    LAS float* xa_s = (LAS float*)lds;
    LAS float* xc_s = xa_s + 131 * 64;
    LAS bf16_t* wt_s = (LAS bf16_t*)(xc_s + 128 * 64);
    LAS float* seg_s = (LAS float*)(wt_s + 128 * 72);
    const int tid = tid_opaque(), lane = tid & 63, w = tid >> 6, fr = lane & 15, fq = lane >> 4;
    const int ch0 = chblk * 64, ch = ch0 + lane;
    const bool sample = (tt == 130);
    const int b = tt / NT, n = tt % NT;
    const int row0 = sample ? SROW0 : b * BROWS + n * 128;
    {
        const float* wa = a->in[I_LWA] + ((size_t)l * 8 + chblk) * 4096; const float* wx = a->in[I_LWX] + ((size_t)l * 8 + chblk) * 4096;
        float wv[16];
#pragma unroll
        for (int k = 0; k < 16; ++k) { const int i = tid + k * NTHR; wv[k] = (i < 4096) ? wa[i] : wx[i - 4096]; }
#pragma unroll
        for (int k = 0; k < 16; ++k) { const int i = tid + k * NTHR; const int m = i >> 12, c = (i >> 6) & 63, d = i & 63; wt_s[(m * 64 + d) * 72 + c] = f2bf(wv[k]); }
    }
    const float cw0 = a->in[I_CONVW][(l * 4 + 0) * 512 + ch], cw1 = a->in[I_CONVW][(l * 4 + 1) * 512 + ch], cw2 = a->in[I_CONVW][(l * 4 + 2) * 512 + ch], cw3 = a->in[I_CONVW][(l * 4 + 3) * 512 + ch];
    const float cb = a->in[I_CONVB][l * 512 + ch];
    if (!sample) {
        float xv[17];
#pragma unroll
        for (int k = 0; k < 17; ++k) {
            const int rr = w + 8 * k; const int grow = row0 - 3 + rr; xv[k] = 0.f;
            if (rr < 131 && !(n == 0 && rr < 3)) xv[k] = bf2f(PA[(size_t)grow * PAW + C_XA + ch]);
        }
#pragma unroll
        for (int k = 0; k < 17; ++k) { const int rr = w + 8 * k; if (rr < 131) xa_s[rr * 64 + lane] = xv[k]; }
        __syncthreads();
#pragma unroll 4
        for (int r = w; r < 128; r += 8) xc_s[r * 64 + lane] = cb + cw0 * xa_s[r * 64 + lane] + cw1 * xa_s[(r + 1) * 64 + lane] + cw2 * xa_s[(r + 2) * 64 + lane] + cw3 * xa_s[(r + 3) * 64 + lane];
        if (n == NT - 1 && w < 3) a->out[O_PC + ((l * 2 + b) * 3 + w) * 512 + ch] = xa_s[(128 + w) * 64 + lane];
    } else {
#pragma unroll
        for (int k = 0; k < 16; ++k) { const int r = w + 8 * k;
            const float* sc = a->in[I_SCONV] + ((size_t)(l * 128 + r) * 3) * 512 + ch; const float s0 = sc[0], s1 = sc[512], s2 = sc[1024];
            const float xa = bf2f(PA[(size_t)(SROW0 + r) * PAW + C_XA + ch]);
            xc_s[r * 64 + lane] = cb + cw0 * s0 + cw1 * s1 + cw2 * s2 + cw3 * xa;
            float* oc = a->out + O_SC + ((size_t)(l * 128 + r) * 3) * 512 + ch; oc[0] = s1; oc[512] = s2; oc[1024] = xa;
        }
    }
    __syncthreads();
    f32x4 acc[8];
    {
        bf16x8 af[2];
#pragma unroll
        for (int ks = 0; ks < 2; ++ks) {
            const f32x4 x0 = *(const LAS f32x4*)(xc_s + (16 * w + fr) * 64 + 32 * ks + 8 * fq), x1 = *(const LAS f32x4*)(xc_s + (16 * w + fr) * 64 + 32 * ks + 8 * fq + 4);
            u32x4 p; p.x = cvt_pk_bf16(x0[0], x0[1]); p.y = cvt_pk_bf16(x0[2], x0[3]); p.z = cvt_pk_bf16(x1[0], x1[1]); p.w = cvt_pk_bf16(x1[2], x1[3]); af[ks] = __builtin_bit_cast(bf16x8, p);
        }
#pragma unroll
        for (int t = 0; t < 8; ++t) {
            acc[t] = (f32x4){0.f, 0.f, 0.f, 0.f};
#pragma unroll
            for (int ks = 0; ks < 2; ++ks) { const bf16x8 bfr = *(const LAS bf16x8*)(wt_s + (t * 16 + fr) * 72 + 32 * ks + 8 * fq); acc[t] = __builtin_amdgcn_mfma_f32_16x16x32_bf16(af[ks], bfr, acc[t], 0, 0, 0); }
        }
    }
    LAS float* a_s = xa_s;
#pragma unroll
    for (int dt = 0; dt < 4; ++dt) {
        const int d = 16 * dt + fr, cch = ch0 + d;
        const float ba = a->in[I_LBA][l * 512 + cch], bx = a->in[I_LBX][l * 512 + cch];
        const float sp = log1pf(__expf(-a->in[I_LAM][l * 512 + cch]));
#pragma unroll
        for (int i = 0; i < 4; ++i) {
            const int r = 16 * w + 4 * fq + i;
            const float rg = fsigmoid(acc[dt][i] + ba), ig = fsigmoid(acc[4 + dt][i] + bx);
            const float la = -8.0f * rg * sp; float av = __expf(la);
            const float t2 = 2.0f * la;
            const float om = (t2 > -0.0625f) ? -t2 * (1.0f + t2 * (0.5f + t2 * (0.16666667f + t2 * (0.041666667f + t2 * 0.0083333333f)))) : 1.0f - av * av;
            float bv = __builtin_amdgcn_sqrtf(om) * (ig * xc_s[r * 64 + d]);
            if (!sample && n == 0 && r < PADR) { av = 1.0f; bv = 0.0f; }
            a_s[r * 64 + d] = av; xc_s[r * 64 + d] = bv;
        }
    }
    __syncthreads();
    if (sample) {
#pragma unroll
        for (int i = 0; i < 16; ++i) {
            const int r = w * 16 + i;
            const float hs = a_s[r * 64 + lane] * a->in[I_SLRU][(size_t)(l * 128 + r) * 512 + ch] + xc_s[r * 64 + lane];
            a->out[O_SL + (size_t)(l * 128 + r) * 512 + ch] = hs;
            const float ya = bf2f(PA[(size_t)(SROW0 + r) * PAW + C_YA + ch]);
            OB0[(size_t)(SROW0 + r) * OBS + ch] = f2bf(hs * gelu_tanh(ya));
        }
        __syncthreads();
        return;
    }
    float P = 1.0f, h = 0.0f;
#pragma unroll 4
    for (int i = 0; i < 16; ++i) {
        const int r = w * 16 + i; const float av = a_s[r * 64 + lane], bv = xc_s[r * 64 + lane];
        AG[(size_t)(row0 + r) * 512 + ch] = av; BG[(size_t)(row0 + r) * 512 + ch] = bv;
        h = av * h + bv; P *= av;
    }
    seg_s[(w * 64 + lane) * 2] = P; seg_s[(w * 64 + lane) * 2 + 1] = h;
    __syncthreads();
    if (w == 0) {
        float Pt = 1.0f, ht = 0.0f;
#pragma unroll
        for (int q = 0; q < 8; ++q) { const float p = seg_s[(q * 64 + lane) * 2], hh = seg_s[(q * 64 + lane) * 2 + 1]; ht = p * ht + hh; Pt *= p; }
        LSUM[((size_t)tt * 512 + ch) * 2] = Pt; LSUM[((size_t)tt * 512 + ch) * 2 + 1] = ht;
    }
    __syncthreads();
}
__device__ __forceinline__ void lru2_item(int tt, int chblk, const bf16_t* PA, bf16_t* OB0, const float* LCAR, const float* AG, const float* BG, LAS unsigned char* lds) {
    LAS float* seg_s = (LAS float*)lds;
    const int tid = tid_opaque(), lane = tid & 63, w = tid >> 6; const int ch = chblk * 64 + lane;
    const int b = tt / NT, n = tt % NT, row0 = b * BROWS + n * 128 + w * 16;
    float av[16], bv[16], yv[16];
#pragma unroll
    for (int i = 0; i < 16; ++i) { av[i] = AG[(size_t)(row0 + i) * 512 + ch]; bv[i] = BG[(size_t)(row0 + i) * 512 + ch]; yv[i] = bf2f(PA[(size_t)(row0 + i) * PAW + C_YA + ch]); }
    float hc = LCAR[(size_t)tt * 512 + ch];
    float P = 1.0f, h = 0.0f;
#pragma unroll
    for (int i = 0; i < 16; ++i) { h = av[i] * h + bv[i]; P *= av[i]; }
    seg_s[(w * 64 + lane) * 2] = P; seg_s[(w * 64 + lane) * 2 + 1] = h;
    __syncthreads();
    for (int q = 0; q < w; ++q) { const float p = seg_s[(q * 64 + lane) * 2], hh = seg_s[(q * 64 + lane) * 2 + 1]; hc = p * hc + hh; }
#pragma unroll
    for (int i = 0; i < 16; ++i) { hc = av[i] * hc + bv[i]; OB0[(size_t)(row0 + i) * OBS + ch] = f2bf(hc * gelu_tanh(yv[i])); }
    __syncthreads();
}

__device__ __forceinline__ void swa_item(CArgs* a, int l, int item, const bf16_t* PA, bf16_t* OB1, LAS unsigned char* lds) {
    const int kvh = item & 1, bn = item >> 1, b = bn / NT, n = bn % NT, row0 = b * BROWS + n * 128;
    LAS bf16_t* Ks = (LAS bf16_t*)lds;
    LAS bf16_t* Vt = Ks + 256 * 72;
    const int tid = tid_opaque(), lane = tid & 63, w = tid >> 6, fr = lane & 15, fq = lane >> 4;
    const int g = w >> 1, h = kvh * 4 + g;
    const float sink = a->in[I_SINK][l * 8 + h];
    bf16x8 qfa[4][2];
#pragma unroll
    for (int qb = 0; qb < 4; ++qb) { const int row = row0 + (w & 1) * 64 + qb * 16 + fr; qfa[qb][0] = *(const bf16x8*)(PA + (size_t)row * PAW + C_QS + h * 64 + fq * 8); qfa[qb][1] = *(const bf16x8*)(PA + (size_t)row * PAW + C_QS + h * 64 + 32 + fq * 8); }
    {
        const int key = tid >> 1, hf = tid & 1; const int grow = row0 - 128 + key; const bool valid = (n > 0) || (key >= 128);
        u32x4 kk[4], vv[4];
#pragma unroll
        for (int j = 0; j < 4; ++j) { kk[j] = (u32x4){0u, 0u, 0u, 0u}; vv[j] = (u32x4){0u, 0u, 0u, 0u}; }
        if (valid) {
            const u32x4* kp = (const u32x4*)(PA + (size_t)grow * PAW + C_KS + kvh * 64 + hf * 32); const u32x4* vp = (const u32x4*)(PA + (size_t)grow * PAW + C_VS + kvh * 64 + hf * 32);
#pragma unroll
            for (int j = 0; j < 4; ++j) { kk[j] = kp[j]; vv[j] = vp[j]; }
        }
#pragma unroll
        for (int j = 0; j < 4; ++j) *(LAS u32x4*)(Ks + key * 72 + hf * 32 + j * 8) = kk[j];
#pragma unroll
        for (int j = 0; j < 4; ++j) {
            const unsigned ws4[4] = {vv[j].x, vv[j].y, vv[j].z, vv[j].w};
#pragma unroll
            for (int q = 0; q < 4; ++q) { const int d = hf * 32 + j * 8 + q * 2; Vt[d * 280 + key] = (bf16_t)(ws4[q] & 0xffffu); Vt[(d + 1) * 280 + key] = (bf16_t)(ws4[q] >> 16); }
        }
        if (tid < 64) {
#pragma unroll
            for (int e = 256; e < 280; ++e) Vt[tid * 280 + e] = 0;
        }
        if (n == NT - 1 && key >= 128) {
            float* ok = a->out + O_PK + ((size_t)(l * 2 + b) * 128 + (key - 128)) * 128 + kvh * 64 + hf * 32; float* ov = a->out + O_PV + ((size_t)(l * 2 + b) * 128 + (key - 128)) * 128 + kvh * 64 + hf * 32;
#pragma unroll
            for (int j = 0; j < 4; ++j) {
                *(f32x4*)(ok + j * 8) = (f32x4){bflo(kk[j].x), bfhi(kk[j].x), bflo(kk[j].y), bfhi(kk[j].y)}; *(f32x4*)(ok + j * 8 + 4) = (f32x4){bflo(kk[j].z), bfhi(kk[j].z), bflo(kk[j].w), bfhi(kk[j].w)};
                *(f32x4*)(ov + j * 8) = (f32x4){bflo(vv[j].x), bfhi(vv[j].x), bflo(vv[j].y), bfhi(vv[j].y)}; *(f32x4*)(ov + j * 8 + 4) = (f32x4){bflo(vv[j].z), bfhi(vv[j].z), bflo(vv[j].w), bfhi(vv[j].w)};
            }
        }
    }
    __syncthreads();
#pragma unroll
    for (int qb = 0; qb < 4; ++qb) {
        const int r0 = (w & 1) * 64 + qb * 16, jt0 = r0 >> 4, r = r0 + fr, row = row0 + r;
        const bf16x8 qf[2] = {qfa[qb][0], qfa[qb][1]};
        f32x4 sacc[10];
#pragma unroll
        for (int t = 0; t < 9; ++t) {
            sacc[t] = (f32x4){0.f, 0.f, 0.f, 0.f};
#pragma unroll
            for (int ks = 0; ks < 2; ++ks) { const bf16x8 kf = *(const LAS bf16x8*)(Ks + ((jt0 + t) * 16 + fr) * 72 + ks * 32 + fq * 8); sacc[t] = __builtin_amdgcn_mfma_f32_16x16x32_bf16(kf, qf[ks], sacc[t], 0, 0, 0); }
        }
        sacc[9] = (f32x4){0.f, 0.f, 0.f, 0.f};
        float mx = -INFINITY;
#pragma unroll
        for (int t = 0; t < 9; ++t)
#pragma unroll
            for (int i = 0; i < 4; ++i) {
                const int kj = (jt0 + t) * 16 + 4 * fq + i;
                const bool valid = (kj > r) && (kj <= r + 128) && (n * 128 - 128 + kj >= PADR);
                const float s = valid ? sacc[t][i] * 0.125f : -INFINITY; sacc[t][i] = s; mx = fmaxf(mx, s);
            }
        mx = fmaxf(mx, __shfl_xor(mx, 16)); mx = fmaxf(mx, __shfl_xor(mx, 32));
        const float mm = fmaxf(mx, sink);
        float sum = 0.f;
#pragma unroll
        for (int t = 0; t < 9; ++t)
#pragma unroll
            for (int i = 0; i < 4; ++i) { const float e = __expf(sacc[t][i] - mm); sacc[t][i] = e; sum += e; }
        sum += __shfl_xor(sum, 16); sum += __shfl_xor(sum, 32);
        const float inv = 1.0f / (sum + __expf(sink - mm));
        f32x4 oacc[4];
#pragma unroll
        for (int dt = 0; dt < 4; ++dt) oacc[dt] = (f32x4){0.f, 0.f, 0.f, 0.f};
#pragma unroll
        for (int p = 0; p < 5; ++p) {
            const f32x4 ea = sacc[2 * p] * inv, eb = sacc[2 * p + 1] * inv;
            u32x4 pw; pw.x = cvt_pk_bf16(ea[0], ea[1]); pw.y = cvt_pk_bf16(ea[2], ea[3]); pw.z = cvt_pk_bf16(eb[0], eb[1]); pw.w = cvt_pk_bf16(eb[2], eb[3]);
            const bf16x8 pb = __builtin_bit_cast(bf16x8, pw);
            const int ja = jt0 + 2 * p;
#pragma unroll
            for (int dt = 0; dt < 4; ++dt) {
                const u32x2 va = *(const LAS u32x2*)(Vt + (dt * 16 + fr) * 280 + ja * 16 + 4 * fq), vb = *(const LAS u32x2*)(Vt + (dt * 16 + fr) * 280 + (ja + 1) * 16 + 4 * fq);
                const u32x4 vw = (u32x4){va.x, va.y, vb.x, vb.y};
                oacc[dt] = __builtin_amdgcn_mfma_f32_16x16x32_bf16(__builtin_bit_cast(bf16x8, vw), pb, oacc[dt], 0, 0, 0);
            }
        }
#pragma unroll
        for (int dt = 0; dt < 4; ++dt) { u32x2 o; o.x = cvt_pk_bf16(oacc[dt][0], oacc[dt][1]); o.y = cvt_pk_bf16(oacc[dt][2], oacc[dt][3]); *(u32x2*)(OB1 + (size_t)row * OBS + h * 64 + dt * 16 + 4 * fq) = o; }
    }
    __syncthreads();
}

__device__ __forceinline__ void ret_u_item(int item, const bf16_t* PA, float* U, LAS unsigned char* lds) {
    const int hh = item & 3, bc = item >> 2, b = bc / NT, c = bc % NT, row0 = b * BROWS + c * 128;
    LAS bf16_t* Kt = (LAS bf16_t*)lds;
    LAS bf16_t* Vt = Kt + 64 * 136;
    const int tid = tid_opaque(), lane = tid & 63, w = tid >> 6, fr = lane & 15, fq = lane >> 4; const float l2g = log2_gamma(hh);
    {
        const int j = tid >> 2, q = tid & 3; const bf16_t* rowp = PA + (size_t)(row0 + j) * PAW;
        const u32x4* vp = (const u32x4*)(rowp + C_VR + hh * 128 + q * 32);
        u32x4 vv[4];
#pragma unroll
        for (int t = 0; t < 4; ++t) vv[t] = vp[t];
        const u32x4 k1 = *(const u32x4*)(rowp + C_KR + hh * 64 + q * 8), k2 = *(const u32x4*)(rowp + C_KR + hh * 64 + 32 + q * 8);
#pragma unroll
        for (int t = 0; t < 4; ++t) {
            const unsigned ws4[4] = {vv[t].x, vv[t].y, vv[t].z, vv[t].w};
#pragma unroll
            for (int k = 0; k < 4; ++k) { const int e = q * 32 + t * 8 + k * 2; Vt[e * 136 + j] = (bf16_t)(ws4[k] & 0xffffu); Vt[(e + 1) * 136 + j] = (bf16_t)(ws4[k] >> 16); }
        }
        const unsigned w1[4] = {k1.x, k1.y, k1.z, k1.w}, w2[4] = {k2.x, k2.y, k2.z, k2.w};
        const int pos = c * 128 + j - PADR; const float dec = exp2f((float)(127 - j) * l2g) * 0.125f;
#pragma unroll
        for (int k = 0; k < 4; ++k) {
            float sa, ca, sb, cb; sincos_rev((float)pos * rope_inv(q * 8 + 2 * k), sa, ca); sincos_rev((float)pos * rope_inv(q * 8 + 2 * k + 1), sb, cb);
            const float x1a = bflo(w1[k]), x1b = bfhi(w1[k]), x2a = bflo(w2[k]), x2b = bfhi(w2[k]);
            const int d = q * 8 + 2 * k;
            Kt[d * 136 + j] = f2bf((x1a * ca - x2a * sa) * dec); Kt[(d + 32) * 136 + j] = f2bf((x1a * sa + x2a * ca) * dec);
            Kt[(d + 1) * 136 + j] = f2bf((x1b * cb - x2b * sb) * dec); Kt[(d + 33) * 136 + j] = f2bf((x1b * sb + x2b * cb) * dec);
        }
    }
    __syncthreads();
    const int dt = w >> 1;
    f32x4 acc[4];
#pragma unroll
    for (int t = 0; t < 4; ++t) acc[t] = (f32x4){0.f, 0.f, 0.f, 0.f};
#pragma unroll
    for (int ks = 0; ks < 4; ++ks) {
        const bf16x8 kf = *(const LAS bf16x8*)(Kt + (dt * 16 + fr) * 136 + 32 * ks + 8 * fq);
#pragma unroll
        for (int t = 0; t < 4; ++t) { const bf16x8 vf = *(const LAS bf16x8*)(Vt + ((4 * (w & 1) + t) * 16 + fr) * 136 + 32 * ks + 8 * fq); acc[t] = __builtin_amdgcn_mfma_f32_16x16x32_bf16(vf, kf, acc[t], 0, 0, 0); }
    }
#pragma unroll
    for (int t = 0; t < 4; ++t)
#pragma unroll
        for (int i = 0; i < 4; ++i) U[(size_t)item * 8192 + ((4 * (w & 1) + t) * 16 + 4 * fq + i) * 64 + dt * 16 + fr] = acc[t][i];
    __syncthreads();
}
__device__ __forceinline__ void ret_out_item(CArgs* a, int l, int item, const bf16_t* PA, const bf16_t* ST, bf16_t* OB2, LAS unsigned char* lds) {
    const int hh = item & 3, bc = item >> 2, b = bc / NT, c = bc % NT, row0 = b * BROWS + c * 128;
    LAS bf16_t* Kr = (LAS bf16_t*)lds;
    LAS bf16_t* Vt = Kr + 128 * 72;
    const int tid = tid_opaque(), lane = tid & 63, w = tid >> 6, fr = lane & 15, fq = lane >> 4; const float l2g = log2_gamma(hh);
    {
        const int j = tid >> 2, q = tid & 3; const bf16_t* rowp = PA + (size_t)(row0 + j) * PAW;
        const u32x4* vp = (const u32x4*)(rowp + C_VR + hh * 128 + q * 32);
        u32x4 vv[4];
#pragma unroll
        for (int t = 0; t < 4; ++t) vv[t] = vp[t];
        const u32x4 k1 = *(const u32x4*)(rowp + C_KR + hh * 64 + q * 8), k2 = *(const u32x4*)(rowp + C_KR + hh * 64 + 32 + q * 8);
#pragma unroll
        for (int t = 0; t < 4; ++t) {
            const unsigned ws4[4] = {vv[t].x, vv[t].y, vv[t].z, vv[t].w};
#pragma unroll
            for (int k = 0; k < 4; ++k) { const int e = q * 32 + t * 8 + k * 2; Vt[e * 136 + j] = (bf16_t)(ws4[k] & 0xffffu); Vt[(e + 1) * 136 + j] = (bf16_t)(ws4[k] >> 16); }
        }
        const unsigned w1[4] = {k1.x, k1.y, k1.z, k1.w}, w2[4] = {k2.x, k2.y, k2.z, k2.w};
        const int pos = c * 128 + j - PADR; unsigned o1[4], o2[4];
#pragma unroll
        for (int k = 0; k < 4; ++k) {
            float sa, ca, sb, cb; sincos_rev((float)pos * rope_inv(q * 8 + 2 * k), sa, ca); sincos_rev((float)pos * rope_inv(q * 8 + 2 * k + 1), sb, cb);
            const float x1a = bflo(w1[k]), x1b = bfhi(w1[k]), x2a = bflo(w2[k]), x2b = bfhi(w2[k]);
            o1[k] = cvt_pk_bf16((x1a * ca - x2a * sa) * 0.125f, (x1b * cb - x2b * sb) * 0.125f); o2[k] = cvt_pk_bf16((x1a * sa + x2a * ca) * 0.125f, (x1b * sb + x2b * cb) * 0.125f);
        }
        *(LAS u32x4*)(Kr + j * 72 + q * 8) = (u32x4){o1[0], o1[1], o1[2], o1[3]}; *(LAS u32x4*)(Kr + j * 72 + 32 + q * 8) = (u32x4){o2[0], o2[1], o2[2], o2[3]};
    }
    __syncthreads();
    const int il = 16 * w + fr, row = row0 + il, pos = c * 128 + il - PADR;
    bf16x8 qf[2], qs[2];
    {
        const u32x4 q1 = *(const u32x4*)(PA + (size_t)row * PAW + C_QR + hh * 64 + fq * 8), q2 = *(const u32x4*)(PA + (size_t)row * PAW + C_QR + hh * 64 + 32 + fq * 8);
        const unsigned w1[4] = {q1.x, q1.y, q1.z, q1.w}, w2[4] = {q2.x, q2.y, q2.z, q2.w};
        const float dsc = exp2f((float)(il + 1) * l2g);
        u32x4 o1, o2, s1, s2; unsigned r1[4], r2[4], t1[4], t2[4];
#pragma unroll
        for (int k = 0; k < 4; ++k) {
            float sa, ca, sb, cb; sincos_rev((float)pos * rope_inv(fq * 8 + 2 * k), sa, ca); sincos_rev((float)pos * rope_inv(fq * 8 + 2 * k + 1), sb, cb);
            const float x1a = bflo(w1[k]), x1b = bfhi(w1[k]), x2a = bflo(w2[k]), x2b = bfhi(w2[k]);
            const float y1a = x1a * ca - x2a * sa, y2a = x1a * sa + x2a * ca, y1b = x1b * cb - x2b * sb, y2b = x1b * sb + x2b * cb;
            r1[k] = cvt_pk_bf16(y1a, y1b); r2[k] = cvt_pk_bf16(y2a, y2b); t1[k] = cvt_pk_bf16(y1a * dsc, y1b * dsc); t2[k] = cvt_pk_bf16(y2a * dsc, y2b * dsc);
        }
        o1 = (u32x4){r1[0], r1[1], r1[2], r1[3]}; o2 = (u32x4){r2[0], r2[1], r2[2], r2[3]}; s1 = (u32x4){t1[0], t1[1], t1[2], t1[3]}; s2 = (u32x4){t2[0], t2[1], t2[2], t2[3]};
        qf[0] = __builtin_bit_cast(bf16x8, o1); qf[1] = __builtin_bit_cast(bf16x8, o2); qs[0] = __builtin_bit_cast(bf16x8, s1); qs[1] = __builtin_bit_cast(bf16x8, s2);
    }
    f32x4 sacc[8];
#pragma unroll
    for (int jt = 0; jt < 8; ++jt) {
        sacc[jt] = (f32x4){0.f, 0.f, 0.f, 0.f};
        if (jt <= w) {
#pragma unroll
            for (int ks = 0; ks < 2; ++ks) { const bf16x8 kf = *(const LAS bf16x8*)(Kr + (jt * 16 + fr) * 72 + ks * 32 + fq * 8); sacc[jt] = __builtin_amdgcn_mfma_f32_16x16x32_bf16(kf, qf[ks], sacc[jt], 0, 0, 0); }
        }
#pragma unroll
        for (int i = 0; i < 4; ++i) { const int dl = il - (jt * 16 + 4 * fq + i); sacc[jt][i] = (dl >= 0) ? sacc[jt][i] * exp2f((float)dl * l2g) : 0.f; }
    }
    f32x4 oacc[8];
#pragma unroll
    for (int et = 0; et < 8; ++et) oacc[et] = (f32x4){0.f, 0.f, 0.f, 0.f};
#pragma unroll
    for (int p = 0; p < 4; ++p) {
        if (2 * p <= w) {
            u32x4 pw; pw.x = cvt_pk_bf16(sacc[2 * p][0], sacc[2 * p][1]); pw.y = cvt_pk_bf16(sacc[2 * p][2], sacc[2 * p][3]); pw.z = cvt_pk_bf16(sacc[2 * p + 1][0], sacc[2 * p + 1][1]); pw.w = cvt_pk_bf16(sacc[2 * p + 1][2], sacc[2 * p + 1][3]);
            const bf16x8 pb = __builtin_bit_cast(bf16x8, pw);
#pragma unroll
            for (int et = 0; et < 8; ++et) {
                const u32x2 va = *(const LAS u32x2*)(Vt + (et * 16 + fr) * 136 + 32 * p + 4 * fq), vb = *(const LAS u32x2*)(Vt + (et * 16 + fr) * 136 + 32 * p + 16 + 4 * fq);
                const u32x4 vw = (u32x4){va.x, va.y, vb.x, vb.y};
                oacc[et] = __builtin_amdgcn_mfma_f32_16x16x32_bf16(__builtin_bit_cast(bf16x8, vw), pb, oacc[et], 0, 0, 0);
            }
        }
    }
    {
        const bf16_t* sb = ST + (size_t)item * 8192;
#pragma unroll
        for (int et = 0; et < 8; ++et)
#pragma unroll
            for (int ks = 0; ks < 2; ++ks) { const bf16x8 sf = *(const bf16x8*)(sb + (et * 16 + fr) * 64 + ks * 32 + fq * 8); oacc[et] = __builtin_amdgcn_mfma_f32_16x16x32_bf16(sf, qs[ks], oacc[et], 0, 0, 0); }
    }
    float sm = 0.f;
#pragma unroll
    for (int et = 0; et < 8; ++et) sm += (oacc[et][0] + oacc[et][1]) + (oacc[et][2] + oacc[et][3]);
    sm += __shfl_xor(sm, 16); sm += __shfl_xor(sm, 32);
    const float mu = sm * (1.0f / 128.0f); float vr = 0.f;
#pragma unroll
    for (int et = 0; et < 8; ++et) { const f32x4 d = oacc[et] - mu; vr += (d[0] * d[0] + d[1] * d[1]) + (d[2] * d[2] + d[3] * d[3]); }
    vr += __shfl_xor(vr, 16); vr += __shfl_xor(vr, 32);
    const float rstd = 1.0f / sqrtf(vr * (1.0f / 128.0f) + 1e-5f);
#pragma unroll
    for (int et = 0; et < 8; ++et) {
        const int e = et * 16 + 4 * fq; const f32x4 gn = *(const f32x4*)(a->in[I_RETN] + l * 512 + hh * 128 + e);
        const u32x2 gr = *(const u32x2*)(PA + (size_t)row * PAW + C_GR + hh * 128 + e);
        const f32x4 y = (oacc[et] - mu) * rstd * gn;
        u32x2 o; o.x = cvt_pk_bf16(y[0] * fsilu(bflo(gr.x)), y[1] * fsilu(bfhi(gr.x))); o.y = cvt_pk_bf16(y[2] * fsilu(bflo(gr.y)), y[3] * fsilu(bfhi(gr.y)));
        *(u32x2*)(OB2 + (size_t)row * OBS + hh * 128 + e) = o;
    }
    __syncthreads();
}


enum { TM_SWIGLU = 0, TM_RESID = 1, TM_PROJ = 2, TM_BRANCH = 3 };
constexpr int TROW0 = 16384;
struct TailArgs { const bf16_t* A; const bf16_t* Bt; int K, N; bf16_t* O1; bf16_t* O2; float* X; const float* ss; float* ssn; const bf16_t* GT; float scale; };
template <int MODE> __device__ __forceinline__ void tail_gemm(const TailArgs& t, int u0, int G, LAS unsigned char* lds) {
    const int tid = tid_opaque(), lane = tid & 63, w = __builtin_amdgcn_readfirstlane(tid >> 6), fr = lane & 15, fq = lane >> 4;
    LAS float* part = (LAS float*)lds;
    const int K = t.K, nu = 8 * (t.N / 64);
    int ks0, nks;
    if (MODE == TM_BRANCH) { if (w < 6) { const int q = w % 3; ks0 = 16 * (w / 3) + (q == 0 ? 0 : (q == 1 ? 6 : 11)); nks = (q == 0) ? 6 : 5; } else { ks0 = 32 + 8 * (w - 6); nks = 8; } }
    else { nks = K / 256; ks0 = w * nks; }
    bf16x8 af[4][3], bfr[4][4];
#define TG_LOAD(uu, s0) do { const bool xm_ = (MODE != TM_PROJ) && ((t.N / 64) % 8 == 0); const int rowb_ = TROW0 + 48 * (xm_ ? (((uu) >> 3) & 7) : ((uu) & 7)), cgp_ = xm_ ? (((uu) & 7) + 8 * ((uu) >> 6)) : ((uu) >> 3); \
        _Pragma("unroll") for (int sI = 0; sI < 4; ++sI) { if ((s0) + sI < nks) { const int kk = (ks0 + (s0) + sI) * 32 + 8 * fq; \
            _Pragma("unroll") for (int rt = 0; rt < 3; ++rt) af[sI][rt] = *(const bf16x8*)(t.A + (size_t)(rowb_ + 16 * rt + fr) * K + kk); \
            _Pragma("unroll") for (int ct = 0; ct < 4; ++ct) { const int brow = (MODE == TM_SWIGLU) ? 256 * (cgp_ >> 2) + (ct >> 1) * 128 + 32 * (cgp_ & 3) + 16 * (ct & 1) : 64 * cgp_ + 16 * ct; \
                bfr[sI][ct] = *(const bf16x8*)(t.Bt + (size_t)(brow + fr) * K + kk); } } } } while (0)
#define TG_MMA(s0) do { _Pragma("unroll") for (int sI = 0; sI < 4; ++sI) { if ((s0) + sI < nks) { _Pragma("unroll") for (int rt = 0; rt < 3; ++rt) _Pragma("unroll") for (int ct = 0; ct < 4; ++ct) \
            acc[rt][ct] = __builtin_amdgcn_mfma_f32_16x16x32_bf16(af[sI][rt], bfr[sI][ct], acc[rt][ct], 0, 0, 0); } } } while (0)
#pragma unroll 1
    for (int u = u0; u < nu; u += G) {
        const bool xmap = (MODE != TM_PROJ) && ((t.N / 64) % 8 == 0);
        const int rg = xmap ? ((u >> 3) & 7) : (u & 7), cgp = xmap ? ((u & 7) + 8 * (u >> 6)) : (u >> 3), rowb0 = TROW0 + 48 * rg;
        f32x4 acc[3][4];
#pragma unroll
        for (int rt = 0; rt < 3; ++rt)
#pragma unroll
            for (int ct = 0; ct < 4; ++ct) acc[rt][ct] = (f32x4){0.f, 0.f, 0.f, 0.f};
#pragma unroll 1
        for (int s0 = 0; s0 < nks; s0 += 4) { TG_LOAD(u, s0); TG_MMA(s0); }
#pragma unroll
        for (int rt = 0; rt < 3; ++rt)
#pragma unroll
            for (int ct = 0; ct < 4; ++ct) *(LAS f32x4*)(part + ((w * 12 + rt * 4 + ct) * 64 + lane) * 4) = acc[rt][ct];
        __syncthreads();
        if (w < 3) {
            const int rowb = rowb0 + 16 * w;
            f32x4 sum[4], tot[4];
#pragma unroll
            for (int ct = 0; ct < 4; ++ct) {
                f32x4 p[8];
#pragma unroll
                for (int q = 0; q < 8; ++q) p[q] = *(const LAS f32x4*)(part + ((q * 12 + w * 4 + ct) * 64 + lane) * 4);
                if (MODE == TM_BRANCH) {
                    const f32x4 pa = (p[0] + p[1]) + p[2], pb = (p[3] + p[4]) + p[5], pc = p[6] + p[7];
#pragma unroll
                    for (int i = 0; i < 4; ++i) { const bf16_t* gp = t.GT + (size_t)(rowb + 4 * fq + i) * 3072 + 64 * cgp + 16 * ct + fr; tot[ct][i] = pa[i] * bf2f(gp[0]) + pb[i] * bf2f(gp[1024]) + pc[i] * bf2f(gp[2048]); }
                } else sum[ct] = ((p[0] + p[1]) + (p[2] + p[3])) + ((p[4] + p[5]) + (p[6] + p[7]));
            }
            (void)sum; (void)tot;
            if (MODE == TM_SWIGLU) {
#pragma unroll
                for (int i = 0; i < 4; ++i) {
                    const int row = rowb + 4 * fq + i; const float rs = t.ss[row];
#pragma unroll
                    for (int c2 = 0; c2 < 2; ++c2) t.O1[(size_t)row * 2048 + 128 * (cgp >> 2) + 32 * (cgp & 3) + 16 * c2 + fr] = f2bf(fsilu(sum[c2][i] * rs) * (sum[2 + c2][i] * rs));
                }
            } else if (MODE == TM_RESID) {
#pragma unroll
                for (int i = 0; i < 4; ++i) {
                    const int row = rowb + 4 * fq + i; float sq = 0.f;
#pragma unroll
                    for (int ct = 0; ct < 4; ++ct) {
                        const size_t off = (size_t)row * 1024 + 64 * cgp + 16 * ct + fr;
                        const float x = t.X[off] + sum[ct][i] * t.scale; t.X[off] = x; t.O1[off] = f2bf(x); sq += x * x;
                    }
                    sq += __shfl_xor(sq, 1); sq += __shfl_xor(sq, 2); sq += __shfl_xor(sq, 4); sq += __shfl_xor(sq, 8);
                    if (fr == 0) t.ssn[(size_t)row * 16 + cgp] = sq;
                }
            } else if (MODE == TM_PROJ) {
                const bool gate = 64 * cgp >= PAW;
#pragma unroll
                for (int i = 0; i < 4; ++i) {
                    const int row = rowb + 4 * fq + i; const float rs = t.ss[row];
#pragma unroll
                    for (int ct = 0; ct < 4; ++ct) {
                        const int col = 64 * cgp + 16 * ct + fr; const float v = sum[ct][i] * rs;
                        if (gate) t.O2[(size_t)row * GTW + (col - PAW)] = f2bf(fsigmoid(v)); else t.O1[(size_t)row * PAW + col] = f2bf(v);
                    }
                }
            } else {
#pragma unroll
                for (int i = 0; i < 4; ++i)
#pragma unroll
                    for (int ct = 0; ct < 4; ++ct) t.O1[(size_t)(rowb + 4 * fq + i) * 1024 + 64 * cgp + 16 * ct + fr] = f2bf(tot[ct][i]);
            }
        }
        __syncthreads();
    }
#undef TG_LOAD
#undef TG_MMA
}

__device__ __forceinline__ void carry_item(CArgs* a, int l, int it, const float* LSUM, float* LCAR, const float* U, bf16_t* ST) {
    const int tid = tid_opaque();
    if (it < 2) {
        const int b = it, ch = tid; float h = 0.f;
#pragma unroll 1
        for (int n0 = 0; n0 < NT; n0 += 13) {
            float p[13], q[13];
#pragma unroll
            for (int k = 0; k < 13; ++k) { const size_t o = (size_t)(b * NT + n0 + k) * 512 + ch; p[k] = LSUM[o * 2]; q[k] = LSUM[o * 2 + 1]; }
#pragma unroll
            for (int k = 0; k < 13; ++k) { LCAR[(size_t)(b * NT + n0 + k) * 512 + ch] = h; h = p[k] * h + q[k]; }
        }
        a->out[O_PL + (l * 2 + b) * 512 + ch] = h;
    } else {
        const int eid = (it - 2) * 512 + tid; const int b = eid >> 15, hh = (eid >> 13) & 3, de = eid & 8191, e = de >> 6, d = de & 63;
        const float g128 = exp2f(128.0f * log2_gamma(hh)); float s = 0.f;
#pragma unroll 1
        for (int c0 = 0; c0 < NT; c0 += 13) {
            float u[13];
#pragma unroll
            for (int k = 0; k < 13; ++k) u[k] = U[(size_t)((b * NT + c0 + k) * 4 + hh) * 8192 + de];
#pragma unroll
            for (int k = 0; k < 13; ++k) { ST[(size_t)((b * NT + c0 + k) * 4 + hh) * 8192 + de] = f2bf(s); s = g128 * s + u[k]; }
        }
        a->out[O_PR + ((size_t)(l * 2 + b) * 4 + hh) * 8192 + d * 128 + e] = s;
    }
}

__device__ __forceinline__ void sample_item(CArgs* a, int l, int j, const bf16_t* PA, bf16_t* OB1, bf16_t* OB2, LAS unsigned char* lds) {
    const int tid = tid_opaque(), lane = tid & 63, w = tid >> 6; const int row = SROW0 + j;
    LAS float* q_s = (LAS float*)lds;
    LAS float* p_s = q_s + 512;
    LAS float* rq_s = p_s + 8 * 132;
    LAS float* rk_s = rq_s + 256;
    LAS float* red_s = rk_s + 256;
    const float* ck = a->in[I_CK] + (size_t)(l * 128 + j) * 16384; const float* cv = a->in[I_CV] + (size_t)(l * 128 + j) * 16384;
    const bf16_t* pr = PA + (size_t)row * PAW;
    q_s[tid] = bf2f(pr[C_QS + tid]);
    if (tid < 128) {
        const int hh = tid >> 5, i = tid & 31; float s, co; sincos_rev(8192.0f * rope_inv(i), s, co);
        const float q1 = bf2f(pr[C_QR + hh * 64 + i]), q2 = bf2f(pr[C_QR + hh * 64 + i + 32]), k1 = bf2f(pr[C_KR + hh * 64 + i]), k2 = bf2f(pr[C_KR + hh * 64 + i + 32]);
        rq_s[hh * 64 + i] = q1 * co - q2 * s; rq_s[hh * 64 + i + 32] = q1 * s + q2 * co;
        rk_s[hh * 64 + i] = (k1 * co - k2 * s) * 0.125f; rk_s[hh * 64 + i + 32] = (k1 * s + k2 * co) * 0.125f;
    }
    {
        float* ok = a->out + O_SK + (size_t)(l * 128 + j) * 16384; float* ov = a->out + O_SV + (size_t)(l * 128 + j) * 16384;
        f32x4 ckv[8], cvv[8];
#pragma unroll
        for (int k = 0; k < 8; ++k) { const int i = tid + k * NTHR; if (i < 127 * 32) { ckv[k] = __builtin_nontemporal_load((const f32x4*)ck + 32 + i); cvv[k] = __builtin_nontemporal_load((const f32x4*)cv + 32 + i); } }
#pragma unroll
        for (int k = 0; k < 8; ++k) { const int i = tid + k * NTHR; if (i < 127 * 32) { __builtin_nontemporal_store(ckv[k], (f32x4*)ok + i); __builtin_nontemporal_store(cvv[k], (f32x4*)ov + i); } }
        if (tid < 128) { ok[127 * 128 + tid] = bf2f(pr[C_KS + tid]); ov[127 * 128 + tid] = bf2f(pr[C_VS + tid]); }
    }
    __syncthreads();
    {
        const int h = w, kvh = h >> 2; const float sink = a->in[I_SINK][l * 8 + h];
        float sc[3]; sc[2] = -INFINITY;
#pragma unroll
        for (int t = 0; t < 2; ++t) {
            const int s = lane + 64 * t; const f32x4* kp = (const f32x4*)(ck + (size_t)s * 128 + kvh * 64); float d = 0.f;
#pragma unroll
            for (int q = 0; q < 16; ++q) { const f32x4 k = kp[q]; const f32x4 qq = *(const LAS f32x4*)(q_s + h * 64 + q * 4); d += (k[0] * qq[0] + k[1] * qq[1]) + (k[2] * qq[2] + k[3] * qq[3]); }
            sc[t] = (s == 0) ? -INFINITY : d * 0.125f;
        }
        {
            sc[2] = wave_sum(bf2f(pr[C_KS + kvh * 64 + lane]) * q_s[h * 64 + lane]) * 0.125f;
        }
        float mx = fmaxf(fmaxf(sc[0], sc[1]), sc[2]);
#pragma unroll
        for (int o = 1; o < 64; o <<= 1) mx = fmaxf(mx, __shfl_xor(mx, o));
        const float mm = fmaxf(mx, sink);
        const float e0 = __expf(sc[0] - mm), e1 = __expf(sc[1] - mm), e2 = __expf(sc[2] - mm);
        const float sum = wave_sum(e0 + e1) + e2; const float inv = 1.0f / (sum + __expf(sink - mm));
        p_s[h * 132 + lane] = e0 * inv; p_s[h * 132 + 64 + lane] = e1 * inv; if (lane == 0) p_s[h * 132 + 128] = e2 * inv;
        LDSW();
        float o = p_s[h * 132 + 128] * bf2f(pr[C_VS + kvh * 64 + lane]);
#pragma unroll 32
        for (int s = 0; s < 128; ++s) o += p_s[h * 132 + s] * cv[(size_t)s * 128 + kvh * 64 + lane];
        OB1[(size_t)row * OBS + h * 64 + lane] = f2bf(o);
    }
    {
        const int hh = tid >> 7, e = tid & 127; const float gam = 1.0f - exp2f(-5.0f - (float)hh);
        const float* S = a->in[I_SRET] + ((size_t)(l * 128 + j) * 4 + hh) * 8192; float* So = a->out + O_SR + ((size_t)(l * 128 + j) * 4 + hh) * 8192;
        const float v = bf2f(pr[C_VR + hh * 128 + e]); float acc = 0.f, qk = 0.f;
#pragma unroll 32
        for (int d = 0; d < 64; ++d) { const float s = __builtin_nontemporal_load(&S[d * 128 + e]); const float q = rq_s[hh * 64 + d], k = rk_s[hh * 64 + d]; acc += q * s; qk += q * k; __builtin_nontemporal_store(gam * s + k * v, &So[d * 128 + e]); }
        const float o = qk * v + gam * acc;
        float sm = wave_sum(o); if (lane == 0) red_s[w * 2] = sm;
        __syncthreads();
        const float mu = (red_s[(w & ~1) * 2] + red_s[(w | 1) * 2]) * (1.0f / 128.0f); const float dv = o - mu;
        float vs = wave_sum(dv * dv); if (lane == 0) red_s[w * 2 + 1] = vs;
        __syncthreads();
        const float var = (red_s[(w & ~1) * 2 + 1] + red_s[(w | 1) * 2 + 1]) * (1.0f / 128.0f);
        const float y = dv * (1.0f / sqrtf(var + 1e-5f)) * a->in[I_RETN][l * 512 + hh * 128 + e] * fsilu(bf2f(pr[C_GR + hh * 128 + e]));
        OB2[(size_t)row * OBS + hh * 128 + e] = f2bf(y);
    }
    __syncthreads();
}

#define GAS __attribute__((address_space(1)))
#define XB_TMO      128
#define XB_XCNT(j)  (256  + 64 * (j))
#define XB_XSUB(j)  (1280 + 64 * (j))
#define XB_XGEN(j)  (2304 + 64 * (j))
#define XB_TOP      3328
#define XB_TOPGEN   3392
#define XCD_BAR_WORDS 3456
#define XB_SPIN_CAP (1u << 18)

__device__ __forceinline__ unsigned xb_ld(unsigned* p)              { return __hip_atomic_load(p, __ATOMIC_RELAXED, __HIP_MEMORY_SCOPE_AGENT); }
__device__ __forceinline__ unsigned xb_add(unsigned* p, unsigned v) { return __hip_atomic_fetch_add(p, v, __ATOMIC_RELAXED, __HIP_MEMORY_SCOPE_AGENT); }
__device__ __forceinline__ unsigned xb_xcc_id() { return (unsigned)__builtin_amdgcn_s_getreg((3 << 11) | 20) & 0xFu; }
#define XB_SPIN(cond, bar) do { unsigned _sp = 0; while (cond) { __builtin_amdgcn_s_sleep(1); \
    if ((++_sp & 255u) == 0u) { if (xb_ld(&(bar)[XB_TMO])) break; if (_sp > XB_SPIN_CAP) { atomicAdd(&(bar)[XB_TMO], 1u); break; } } } } while (0)

struct XcdBarrier {
    unsigned* bar; unsigned x;
    volatile LAS unsigned* st;
};

__device__ __forceinline__ XcdBarrier xcd_barrier_post(unsigned* bar, volatile LAS unsigned* st) {
    XcdBarrier b; b.bar = bar; b.x = xb_xcc_id(); b.st = st;
    if (threadIdx.x == 0) (void)xb_add(&bar[XB_XCNT(b.x)], 1u);
    return b;
}
__device__ __forceinline__ void xcd_barrier_complete(unsigned* bar, unsigned x, unsigned& nloc, unsigned& nx) {
    const unsigned G = gridDim.x * gridDim.y * gridDim.z;
    unsigned sum, cnt, mine, sp = 0u;
    for (;;) {
        sum = 0u; cnt = 0u; mine = 0u;
#pragma unroll
        for (unsigned j = 0; j < 16; ++j) { const unsigned c = xb_ld(&bar[XB_XCNT(j)]); sum += c; cnt += (c > 0u) ? 1u : 0u; mine = (j == x) ? c : mine; }
        if (sum == G) break;
        __builtin_amdgcn_s_sleep(1);
        if ((++sp & 255u) == 0u) { if (xb_ld(&bar[XB_TMO])) break; if (sp > XB_SPIN_CAP) { atomicAdd(&bar[XB_TMO], 1u); break; } }
    }
    nloc = mine > 0u ? mine : 1u; nx = cnt > 0u ? cnt : 1u;
}

__device__ __forceinline__ void xcd_barrier(const XcdBarrier& b) {
    asm volatile("s_waitcnt vmcnt(0)" ::: "memory");
    __syncthreads();
    if (threadIdx.x == 0) {
        unsigned* bar = b.bar;
        __builtin_amdgcn_s_waitcnt(0);
        unsigned nloc = b.st[0], nx = b.st[1];
        if (nloc == 0u) { xcd_barrier_complete(bar, b.x, nloc, nx); b.st[0] = nloc; b.st[1] = nx; }
        const unsigned old = xb_add(&bar[XB_XSUB(b.x)], 1u);
        const unsigned gen = old / nloc;
        if (old + 1u == (gen + 1u) * nloc) {
            __builtin_amdgcn_fence(__ATOMIC_RELEASE, "agent");
            asm volatile("s_waitcnt vmcnt(0)" ::: "memory");
            const unsigned og = xb_add(&bar[XB_TOP], 1u);
            const unsigned tg = og / nx;
            if (og + 1u == (tg + 1u) * nx) xb_add(&bar[XB_TOPGEN], 1u);
            else XB_SPIN(xb_ld(&bar[XB_TOPGEN]) == tg, bar);
            __builtin_amdgcn_fence(__ATOMIC_ACQUIRE, "agent");
            xb_add(&bar[XB_XGEN(b.x)], 1u);
            asm volatile("s_waitcnt vmcnt(0)" ::: "memory");
        } else {
            XB_SPIN(xb_ld(&bar[XB_XGEN(b.x)]) == gen, bar);
            __builtin_amdgcn_fence(__ATOMIC_ACQUIRE, "agent");
            asm volatile("s_waitcnt vmcnt(0)" ::: "memory");
        }
    }
    __syncthreads();
}


template <class Sched> __device__ __forceinline__ void rs_prestep(const Sched& S, const float* ss, float* rs) {
    const int tid = tid_opaque();
    int pmv[8];
#pragma unroll
    for (int i = 0; i < 8; ++i) { pg8::Unit u; pmv[i] = S.next(i, u) ? u.pm : -1; }
    const int r0 = (tid < 256) ? tid : TROW0 + (tid - 256);
    float v[9];
#pragma unroll
    for (int i = 0; i < 8; ++i) { v[i] = 0.f; if (tid < 256 && pmv[i] >= 0) v[i] = pg8::row_ss(ss, pmv[i] * 256 + tid); }
    v[8] = 0.f; if (tid >= 256) v[8] = pg8::row_ss(ss, r0);
    float v9 = 0.f; if (tid < 128) v9 = pg8::row_ss(ss, TROW0 + 256 + tid);
#pragma unroll
    for (int i = 0; i < 8; ++i) if (tid < 256 && pmv[i] >= 0) rs[pmv[i] * 256 + tid] = __builtin_amdgcn_rsqf(v[i] * (1.0f / 1024.0f) + 1e-6f);
    if (tid >= 256) rs[r0] = __builtin_amdgcn_rsqf(v[8] * (1.0f / 1024.0f) + 1e-6f);
    if (tid < 128) rs[TROW0 + 256 + tid] = __builtin_amdgcn_rsqf(v9 * (1.0f / 1024.0f) + 1e-6f);
    asm volatile("s_waitcnt vmcnt(0)" ::: "memory");
    __syncthreads();
}

#define R_GU 1
#define R_WIN 1
#define R_MIX1 1
#define R_CARRY 1
#define R_MIX2 1
#define R_XSYNC 0
__global__ void __launch_bounds__(NTHR, 2) mk_fwd(Args a_unused) {
    extern __shared__ __attribute__((aligned(16))) unsigned char lds_raw[];
    LAS unsigned char* lds = (LAS unsigned char*)lds_raw;
    cg::grid_group grid = cg::this_grid();
    CArgs* kp0 = (CArgs*)__builtin_amdgcn_kernarg_segment_ptr();
    if (threadIdx.x < 64) ((LAS unsigned*)(lds + 131072))[threadIdx.x] = 0u;
    __syncthreads();
    XcdBarrier xbar; xbar.bar = (unsigned*)(kp0->ws + WS_BAR); xbar.x = 0; xbar.st = (volatile LAS unsigned*)(lds + 131072);
    const int lo = kp0->ph_lo, hi = kp0->ph_hi; int ph = 0;
#define PH_PTRS int tid = threadIdx.x; asm volatile("" : "+v"(tid)); const int lane = tid & 63, wave = __builtin_amdgcn_readfirstlane(tid >> 6); \
    int bid_ = blockIdx.x; asm volatile("" : "+s"(bid_)); const int G = gridDim.x, bid = bid_, gw = bid * 8 + wave, ngw = G * 8; (void)lane; (void)gw; (void)ngw; CArgs* a = kp0; asm volatile("" : "+s"(a)); unsigned char* ws = a->ws; \
    float* SS = (float*)(ws + WS_SS16); float* LSUM = (float*)(ws + WS_LSUM); float* LCAR = (float*)(ws + WS_LCAR); \
    float* X = (float*)(ws + WS_X); bf16_t* XB = (bf16_t*)(ws + WS_XB); bf16_t* PA = (bf16_t*)(ws + WS_PA); bf16_t* HB = PA; bf16_t* MB = (bf16_t*)(ws + WS_PA); \
    bf16_t* GT = (bf16_t*)(ws + WS_GT); bf16_t* OB = (bf16_t*)(ws + WS_OB); float* U = (float*)(ws + WS_U); float* AG = (float*)(ws + WS_XB); float* BG = (float*)(ws + WS_BG); (void)AG; (void)BG; bf16_t* ST = (bf16_t*)(ws + WS_ST); \
    unsigned char* wb = ws + WS_W0 + (size_t)(l & 1) * WSZ; \
    float* RS = (float*)(ws + WS_RS); const float* rs0 = RS + (size_t)(3 * l) * MP; float* rs1 = RS + (size_t)(3 * l + 1) * MP; float* rs2 = RS + (size_t)(3 * l + 2) * MP; float* rs3 = RS + (size_t)(3 * l + 3) * MP; (void)rs0; (void)rs1; (void)rs2; (void)rs3; \
    const float* ss0 = SS + (size_t)(3 * l) * MP * 16; float* ss1 = SS + (size_t)(3 * l + 1) * MP * 16; float* ss2 = SS + (size_t)(3 * l + 2) * MP * 16; float* ss3 = SS + (size_t)(3 * l + 3) * MP * 16; \
    (void)SS; (void)LSUM; (void)LCAR; (void)X; (void)XB; (void)PA; (void)HB; (void)MB; (void)GT; (void)OB; (void)U; (void)ST; (void)wb; (void)ss0; (void)ss1; (void)ss2; (void)ss3;
#define PH_BEGIN(n) if (ph >= lo && ph < hi) { PH_PTRS for (int rep_ = 0; rep_ < (n); ++rep_) {
#define PH_END if (ph + 1 < hi) { if (ph == 0) { asm volatile("s_waitcnt vmcnt(0)" ::: "memory"); grid.sync(); xbar = xcd_barrier_post((unsigned*)(kp0->ws + WS_BAR), (volatile LAS unsigned*)(lds + 131072)); } else xcd_barrier(xbar); } } } ++ph;

    { const int l = 0;
    PH_BEGIN(1)
        if (bid == 0) { for (int i = tid; i < XCD_BAR_WORDS; i += NTHR) ((unsigned*)(ws + WS_BAR))[i] = 0u; }
        if (bid == 0) ((unsigned*)(ws + WS_BAR + 16384))[tid] = 0u;
        init_rows(a, X, XB, SS, RS, OB, gw, ngw, lane);
        convert_layer(a, 0, ws + WS_W0, lds, gw, ngw, wave, lane);
    PH_END
    }

#pragma unroll 1
    for (int l = 0; l < DEPTH; ++l) {
        PH_BEGIN(R_GU)
            pg8::Gemm g{XB, (const bf16_t*)(wb + W_GU1), TROW0, 4096, DM, 1, 0}; pg8::StaticOrder S; S.init(TROW0, 4096, G, bid);
            rs_prestep(S, ss0, RS + (size_t)(3 * l) * MP);
            pg8::EpiSwiGLU E{HB, rs0}; pg8::gemm_phase<pg8::EpiSwiGLU, pg8::StaticOrder, true, true>(lds, g, S, E);
            { const TailArgs ta{XB, (const bf16_t*)(wb + W_GU1), DM, 4096, HB, nullptr, nullptr, rs0, nullptr, nullptr, 0.f}; tail_gemm<TM_SWIGLU>(ta, bid, G, lds); }
        PH_END
        PH_BEGIN(1)
            pg8::Gemm g{HB, (const bf16_t*)(wb + W_D1), TROW0, DM, FF, 1, 0}; pg8::StaticOrder S; S.init(TROW0, DM, G, bid);
            pg8::EpiResid E{X, XB, ss1, 0.5f}; pg8::gemm_phase<pg8::EpiResid, pg8::StaticOrder, true, true>(lds, g, S, E);
            { const TailArgs ta{HB, (const bf16_t*)(wb + W_D1), FF, DM, XB, nullptr, X, nullptr, ss1, nullptr, 0.5f}; tail_gemm<TM_RESID>(ta, bid, G, lds); }
        PH_END
        PH_BEGIN(R_WIN)
            pg8::Gemm g{XB, (const bf16_t*)(wb + W_IN), TROW0, NIN, DM, 1, 0}; pg8::StaticOrder S; S.init(TROW0, NIN, G, bid);
            rs_prestep(S, ss1, rs1);
            pg8::EpiProj E{PA, GT, rs1}; pg8::gemm_phase<pg8::EpiProj, pg8::StaticOrder, true, true>(lds, g, S, E);
            { const TailArgs ta{XB, (const bf16_t*)(wb + W_IN), DM, NIN, PA, GT, nullptr, rs1, nullptr, nullptr, 0.f}; if (G == 256) { if (bid >= 64) tail_gemm<TM_PROJ>(ta, bid - 64, 192, lds); } else tail_gemm<TM_PROJ>(ta, bid, G, lds); }
        PH_END
        PH_BEGIN(R_MIX1)
            {
                volatile LAS int* qs = (volatile LAS int*)(lds + 131072 + 128);
                unsigned* qc = (unsigned*)(ws + WS_BAR + 16384) + (2 * l) * 64;
                int it = bid;
                while (it < 1048 + 260 + 520) {
                    int nxt = 0;
                    if (tid == 0) nxt = G + (int)__hip_atomic_fetch_add(qc, 1u, __ATOMIC_RELAXED, __HIP_MEMORY_SCOPE_AGENT);
                    if (it < 1048) { const int q = 1047 - it; lru1_item(a, l, q >> 3, q & 7, PA, OB, LSUM, AG, BG, lds); }
                    else if (it < 1048 + 260) swa_item(a, l, it - 1048, PA, OB + 512, lds);
                    else ret_u_item(it - (1048 + 260), PA, U, lds);
                    if (tid == 0) *qs = nxt;
                    __syncthreads();
                    it = *qs;
                }
            }
        PH_END
        PH_BEGIN(R_CARRY)
            for (int it = bid; it < 130; it += G) carry_item(a, l, it, LSUM, LCAR, U, ST);
            if (G == 256) { if (bid >= 128) sample_item(a, l, bid - 128, PA, OB + 512, OB + 1024, lds); } else { for (int it = bid; it < 128; it += G) sample_item(a, l, it, PA, OB + 512, OB + 1024, lds); }
            if (l + 1 < DEPTH) {
                __syncthreads();
                const int nsh = (G == 256) ? (bid < 128 ? 3 : 1) : 1, sh0 = (G == 256) ? (bid < 128 ? bid * 3 : 384 + (bid - 128)) : bid, nshares = (G == 256) ? 512 : G;
#pragma unroll 1
                for (int v = 0; v < nsh; ++v) convert_layer(a, l + 1, ws + WS_W0 + (size_t)((l + 1) & 1) * WSZ, lds, (sh0 + v) * 8 + wave, nshares * 8, wave, lane);
            }
        PH_END
        PH_BEGIN(R_MIX2)
            {
                volatile LAS int* qs = (volatile LAS int*)(lds + 131072 + 128);
                unsigned* qc = (unsigned*)(ws + WS_BAR + 16384) + (2 * l + 1) * 64;
                int it = bid;
                while (it < 520 + 1040) {
                    int nxt = 0;
                    if (tid == 0) nxt = G + (int)__hip_atomic_fetch_add(qc, 1u, __ATOMIC_RELAXED, __HIP_MEMORY_SCOPE_AGENT);
                    if (it < 520) ret_out_item(a, l, it, PA, ST, OB + 1024, lds);
                    else { const int q = it - 520; lru2_item(q >> 3, q & 7, PA, OB, LCAR, AG, BG, lds); }
                    if (tid == 0) *qs = nxt;
                    __syncthreads();
                    it = *qs;
                }
            }
        PH_END
        PH_BEGIN(1)
            pg8::Gemm g{OB, (const bf16_t*)(wb + W_BR), TROW0, DM, OBS, 1, 0}; pg8::StaticOrder S; S.init(TROW0, DM, G, bid);
            pg8::EpiBranch E{MB, GT}; pg8::gemm_phase<pg8::EpiBranch, pg8::StaticOrder, true, true>(lds, g, S, E);
            { const TailArgs ta{OB, (const bf16_t*)(wb + W_BR), OBS, DM, MB, nullptr, nullptr, nullptr, nullptr, GT, 0.f}; tail_gemm<TM_BRANCH>(ta, bid, G, lds); }
        PH_END
        PH_BEGIN(1)
            pg8::Gemm g{MB, (const bf16_t*)(wb + W_OUT), TROW0, DM, DM, 1, 0}; pg8::StaticOrder S; S.init(TROW0, DM, G, bid);
            pg8::EpiResid E{X, XB, ss2, 1.0f}; pg8::gemm_phase<pg8::EpiResid, pg8::StaticOrder, true, true>(lds, g, S, E);
            { const TailArgs ta{MB, (const bf16_t*)(wb + W_OUT), DM, DM, XB, nullptr, X, nullptr, ss2, nullptr, 1.0f}; tail_gemm<TM_RESID>(ta, bid, G, lds); }
        PH_END
        PH_BEGIN(1)
            for (int xs_ = 0; xs_ < R_XSYNC; ++xs_) grid.sync();
            pg8::Gemm g{XB, (const bf16_t*)(wb + W_GU2), TROW0, 4096, DM, 1, 0}; pg8::StaticOrder S; S.init(TROW0, 4096, G, bid);
            rs_prestep(S, ss2, rs2);
            pg8::EpiSwiGLU E{HB, rs2}; pg8::gemm_phase<pg8::EpiSwiGLU, pg8::StaticOrder, true, true>(lds, g, S, E);
            { const TailArgs ta{XB, (const bf16_t*)(wb + W_GU2), DM, 4096, HB, nullptr, nullptr, rs2, nullptr, nullptr, 0.f}; tail_gemm<TM_SWIGLU>(ta, bid, G, lds); }
        PH_END
        PH_BEGIN(1)
            pg8::Gemm g{HB, (const bf16_t*)(wb + W_D2), TROW0, DM, FF, 1, 0}; pg8::StaticOrder S; S.init(TROW0, DM, G, bid);
            pg8::EpiResid E{X, XB, ss3, 0.5f}; pg8::gemm_phase<pg8::EpiResid, pg8::StaticOrder, true, true>(lds, g, S, E);
            { const TailArgs ta{HB, (const bf16_t*)(wb + W_D2), FF, DM, XB, nullptr, X, nullptr, ss3, nullptr, 0.5f}; tail_gemm<TM_RESID>(ta, bid, G, lds); }
        PH_END
    }
    { const int l = 0;
    PH_BEGIN(1)
        const float* ssf = SS + (size_t)12 * MP * 16; const float* gf = a->in[I_FINN];
        for (int r = gw; r < MREAL; r += ngw) {
            float* dst = nullptr;
            if (r < 2 * BROWS) { const int b = r / BROWS, pr = r % BROWS; if (pr >= PADR + 16) dst = a->out + O_YP + ((size_t)b * 8192 + (pr - PADR - 16)) * DM; }
            else dst = a->out + O_YS + (size_t)(r - SROW0) * DM;
            if (dst) {
                const float rs = __builtin_amdgcn_rsqf(pg8::row_ss(ssf, r) * (1.0f / 1024.0f) + 1e-6f);
#pragma unroll
                for (int j = 0; j < 4; ++j) { const f32x4 v = *((const f32x4*)(X + (size_t)r * DM) + lane + 64 * j); const f32x4 gg = *((const f32x4*)gf + lane + 64 * j); __builtin_nontemporal_store(v * rs * gg, (f32x4*)dst + lane + 64 * j); }
            }
        }
    PH_END
    }
#undef PH_BEGIN
#undef PH_END
}
constexpr int NPHASES = 2 + 10 * DEPTH;

#ifndef MK_MULTI
#define MK_MULTI 0
#endif
extern "C" void kernel_launch(void* const* d_in, const int* in_sizes, int n_in, void* d_out, int out_size, void* d_ws, size_t ws_size, hipStream_t stream) {
    static int grid = 0;
    if (grid == 0) {
        if (n_in != 30 || ws_size < WS_END) { fprintf(stderr, "kernel_launch: unexpected inputs (n_in %d, ws %zu < %zu)\n", n_in, ws_size, (size_t)WS_END); grid = -1; return; }
        int dev = 0, cus = 0, per_cu = 0;
        (void)hipGetDevice(&dev); (void)hipDeviceGetAttribute(&cus, hipDeviceAttributeMultiprocessorCount, dev);
        if (hipFuncSetAttribute((const void*)mk_fwd, hipFuncAttributeMaxDynamicSharedMemorySize, LDS_BYTES) != hipSuccess) { fprintf(stderr, "kernel_launch: hipFuncSetAttribute failed\n"); grid = -1; return; }
        if (hipOccupancyMaxActiveBlocksPerMultiprocessor(&per_cu, (const void*)mk_fwd, NTHR, LDS_BYTES) != hipSuccess || per_cu < 1) { fprintf(stderr, "kernel_launch: occupancy query says %d\n", per_cu); per_cu = 1; }
        (void)hipGetLastError();
        grid = cus * 1;
        if (grid <= 0) grid = 256;
    }
    if (grid < 0) return;
    Args a{};
    for (int i = 0; i < 30; ++i) a.in[i] = (const float*)d_in[i];
    a.out = (float*)d_out; a.ws = (unsigned char*)d_ws;
#if MK_MULTI
    for (int p = 0; p < NPHASES; ++p) { a.ph_lo = p; a.ph_hi = p + 1; hipLaunchKernelGGL(mk_fwd, dim3(grid), dim3(NTHR), LDS_BYTES, stream, a); }
#else
    a.ph_lo = 0; a.ph_hi = NPHASES;
    void* args[] = {&a};
    hipError_t e = hipLaunchCooperativeKernel((const void*)mk_fwd, dim3(grid), dim3(NTHR), args, LDS_BYTES, stream);
    if (e != hipSuccess) fprintf(stderr, "cooperative launch failed: %s (grid %d)\n", hipGetErrorString(e), grid);
#endif
}
```

```cpp
#include <hip/hip_runtime.h>
#include <hip/hip_cooperative_groups.h>
#include <cstdio>
#include <cstdint>
#include <cmath>
namespace cg = cooperative_groups;

namespace pg8 {
#define PG8_LAS __attribute__((address_space(3)))
typedef unsigned short bf16_t;
typedef short bf16x8 __attribute__((ext_vector_type(8)));
typedef float f32x4 __attribute__((ext_vector_type(4)));
typedef unsigned u32x4 __attribute__((ext_vector_type(4)));
constexpr int BM = 256, BK = 64, HALF = 128, HTB = HALF * BK * 2  , STAGE_BYTES = 8 * HTB, NXCD = 8, WGM = 8;

__host__ __device__ __forceinline__ int lds_byte(int r, int c) { const int st = (r >> 4) * 2 + (c >> 5), rr = r & 15, cc = c & 31, ob = rr * 64 + cc * 2; return st * 1024 + (ob ^ (((ob >> 9) & 1) << 5)); }
__host__ __device__ __forceinline__ void stage_rc(int b, int& R, int& C) { const int st = b / 1024, sb = b % 1024, swz = sb ^ (((sb >> 9) & 1) << 5); R = (st >> 1) * 16 + swz / 64; C = (st & 1) * 32 + (swz % 64) / 2; }
__host__ __device__ __forceinline__ int perm32(int rho) { const int n = rho >> 4, i = rho & 15; return 8 * (i >> 2) + 4 * n + (i & 3); }

struct Unit { int pm, pn; };
struct Gemm { const bf16_t* A; const bf16_t* Bt; int M, N, K; int agdiv; size_t agstride; };

struct StaticOrder {
    int nM, nN, nwg, G, c;
    __host__ __device__ void init(int M, int N, int G_, int c_) { nM = M / BM; nN = N / BM; nwg = nM * nN; G = G_; c = c_; }
    __host__ __device__ bool next(int i, Unit& u) const {
        const long L = (long)i * G + c; if (L >= nwg) return false;
        int wgid = (int)L; { const int q = nwg / NXCD, r = nwg % NXCD, xcd = wgid % NXCD, off = wgid / NXCD; wgid = (xcd < r ? xcd * (q + 1) : r * (q + 1) + (xcd - r) * q) + off; }
        const int nig = WGM * nN, gid = wgid / nig, fm = gid * WGM, gsz = (nM - fm) < WGM ? (nM - fm) : WGM;
        u.pm = fm + ((wgid % nig) % gsz); u.pn = (wgid % nig) / gsz; return true;
    }
    __device__ __forceinline__ void a_ready(const Unit&) const {}
    __device__ __forceinline__ void done(const Unit&) const {}
};

__device__ __forceinline__ unsigned cvt_pk_bf16(float lo, float hi) { unsigned r; asm volatile("v_cvt_pk_bf16_f32 %0, %1, %2" : "=v"(r) : "v"(lo), "v"(hi)); return r; }
typedef unsigned u32x2 __attribute__((ext_vector_type(2)));
__device__ __forceinline__ float fsigmoid(float x) { return __builtin_amdgcn_rcpf(1.0f + __expf(-x)); }
__device__ __forceinline__ float fsilu(float x) { return x * fsigmoid(x); }
__device__ __forceinline__ float bflo(unsigned w) { return __uint_as_float(w << 16); }
__device__ __forceinline__ float bfhi(unsigned w) { return __uint_as_float(w & 0xffff0000u); }

__device__ __forceinline__ float row_ss(const float* ss, int row) {
    const f32x4* p = (const f32x4*)(ss + (size_t)row * 16); const f32x4 a = p[0], b = p[1], c = p[2], d = p[3];
    return (((a[0] + a[1]) + (a[2] + a[3])) + ((b[0] + b[1]) + (b[2] + b[3]))) + (((c[0] + c[1]) + (c[2] + c[3])) + ((d[0] + d[1]) + (d[2] + d[3])));
}
struct EpiSwiGLU {
    static constexpr bool PERM = true, AFTER_DRAIN = false, HAS_MID = false, HAS_PRE = true;
    bf16_t* H; const float* ss;
    __device__ __forceinline__ void pre(float (&rsv)[8], const Unit& u, int wr, int fr) const {
#pragma unroll
        for (int q = 0; q < 8; ++q) rsv[q] = ss[u.pm * BM + wr * 64 + fr + (q >> 2) * HALF + (q & 3) * 16];
    }
    __device__ __forceinline__ void operator()(const f32x4 (&acc)[2][2][4][2], const Unit& u, int wr, int wc, int fr, int fq, const float (&rsv)[8]) const {
        const int row0 = u.pm * BM + wr * 64 + fr, col0 = u.pn * 128 + wc * 32 + 8 * fq;
#pragma unroll
        for (int ai = 0; ai < 2; ++ai)
#pragma unroll
            for (int m = 0; m < 4; ++m) {
                const int row = row0 + ai * HALF + m * 16;
                const float rs = rsv[ai * 4 + m];
                const f32x4 g0 = acc[ai][0][m][0] * rs, g1 = acc[ai][0][m][1] * rs, u0 = acc[ai][1][m][0] * rs, u1 = acc[ai][1][m][1] * rs;
                u32x4 w;
                w.x = cvt_pk_bf16(fsilu(g0[0]) * u0[0], fsilu(g0[1]) * u0[1]); w.y = cvt_pk_bf16(fsilu(g0[2]) * u0[2], fsilu(g0[3]) * u0[3]);
                w.z = cvt_pk_bf16(fsilu(g1[0]) * u1[0], fsilu(g1[1]) * u1[1]); w.w = cvt_pk_bf16(fsilu(g1[2]) * u1[2], fsilu(g1[3]) * u1[3]);
                *(u32x4*)(H + (size_t)row * 2048 + col0) = w;
            }
    }
};
struct EpiResid {
    static constexpr bool PERM = false, AFTER_DRAIN = false, HAS_MID = false, HAS_PRE = false;
    float* X; bf16_t* XB; float* ssn; float scale;
    __device__ __forceinline__ void operator()(const f32x4 (&acc)[2][2][4][2], const Unit& u, int wr, int wc, int fr, int fq, const float (&)[8]) const {
        const int row0 = u.pm * BM + wr * 64 + fr, col0 = u.pn * BM + wc * 32 + 4 * fq;
#pragma unroll
        for (int ai = 0; ai < 2; ++ai)
#pragma unroll
            for (int m = 0; m < 4; ++m) {
                const int row = row0 + ai * HALF + m * 16; float sq = 0.f;
#pragma unroll
                for (int bj = 0; bj < 2; ++bj)
#pragma unroll
                    for (int n = 0; n < 2; ++n) {
                        const size_t off = (size_t)row * 1024 + col0 + bj * HALF + n * 16;
                        f32x4 x = *(const f32x4*)(X + off); x = x + acc[ai][bj][m][n] * scale; *(f32x4*)(X + off) = x;
                        u32x2 w; w.x = cvt_pk_bf16(x[0], x[1]); w.y = cvt_pk_bf16(x[2], x[3]); *(u32x2*)(XB + off) = w;
                        sq += (x[0] * x[0] + x[1] * x[1]) + (x[2] * x[2] + x[3] * x[3]);
                    }
                sq += __shfl_xor(sq, 16); sq += __shfl_xor(sq, 32);
                if (fq == 0) ssn[(size_t)row * 16 + u.pn * 4 + wc] = sq;
            }
    }
};
struct EpiProj {
    static constexpr bool PERM = true, AFTER_DRAIN = false, HAS_MID = false, HAS_PRE = true;
    bf16_t* PA; bf16_t* GT; const float* ss;
    __device__ __forceinline__ void pre(float (&rsv)[8], const Unit& u, int wr, int fr) const {
#pragma unroll
        for (int q = 0; q < 8; ++q) rsv[q] = ss[u.pm * BM + wr * 64 + fr + (q >> 2) * HALF + (q & 3) * 16];
    }
    __device__ __forceinline__ void operator()(const f32x4 (&acc)[2][2][4][2], const Unit& u, int wr, int wc, int fr, int fq, const float (&rsv)[8]) const {
        const int row0 = u.pm * BM + wr * 64 + fr; const bool gate = u.pn >= 13;
        const int col0 = (gate ? (u.pn - 13) : u.pn) * BM + wc * 32 + 8 * fq;
        bf16_t* base = gate ? GT : PA; const int ld = gate ? 3072 : 3328;
#pragma unroll
        for (int ai = 0; ai < 2; ++ai)
#pragma unroll
            for (int m = 0; m < 4; ++m) {
                const int row = row0 + ai * HALF + m * 16;
                const float rs = rsv[ai * 4 + m];
#pragma unroll
                for (int bj = 0; bj < 2; ++bj) {
                    f32x4 v0 = acc[ai][bj][m][0] * rs, v1 = acc[ai][bj][m][1] * rs;
                    if (gate) {
#pragma unroll
                        for (int k = 0; k < 4; ++k) { v0[k] = fsigmoid(v0[k]); v1[k] = fsigmoid(v1[k]); }
                    }
                    u32x4 w; w.x = cvt_pk_bf16(v0[0], v0[1]); w.y = cvt_pk_bf16(v0[2], v0[3]); w.z = cvt_pk_bf16(v1[0], v1[1]); w.w = cvt_pk_bf16(v1[2], v1[3]);
                    *(u32x4*)(base + (size_t)row * ld + col0 + bj * HALF) = w;
                }
            }
    }
};
struct EpiBranch {
    static constexpr bool PERM = true, AFTER_DRAIN = false, HAS_MID = true, HAS_PRE = false;
    bf16_t* MB; const bf16_t* GT;
    __device__ __forceinline__ void mid(f32x4 (&acc)[2][2][4][2], const Unit& u, int seg, int wr, int wc, int fr, int fq) const {
        int fr_ = fr; asm volatile("" : "+v"(fr_));
        const int row0 = u.pm * BM + wr * 64 + fr_, col0 = u.pn * BM + wc * 32 + 8 * fq;
#pragma unroll
        for (int ai = 0; ai < 2; ++ai)
#pragma unroll
            for (int m = 0; m < 4; ++m) {
                const int row = row0 + ai * HALF + m * 16;
#pragma unroll
                for (int bj = 0; bj < 2; ++bj) {
                    const bf16_t* gp = GT + (size_t)row * 3072 + (seg - 1) * 1024 + col0 + bj * HALF;
                    const u32x4 g0 = *(const u32x4*)gp, g1 = *(const u32x4*)(gp + 1024);
                    f32x4 r0, r1;
                    r0[0] = bflo(g0.x) * __builtin_amdgcn_rcpf(fmaxf(bflo(g1.x), 1e-30f)); r0[1] = bfhi(g0.x) * __builtin_amdgcn_rcpf(fmaxf(bfhi(g1.x), 1e-30f));
                    r0[2] = bflo(g0.y) * __builtin_amdgcn_rcpf(fmaxf(bflo(g1.y), 1e-30f)); r0[3] = bfhi(g0.y) * __builtin_amdgcn_rcpf(fmaxf(bfhi(g1.y), 1e-30f));
                    r1[0] = bflo(g0.z) * __builtin_amdgcn_rcpf(fmaxf(bflo(g1.z), 1e-30f)); r1[1] = bfhi(g0.z) * __builtin_amdgcn_rcpf(fmaxf(bfhi(g1.z), 1e-30f));
                    r1[2] = bflo(g0.w) * __builtin_amdgcn_rcpf(fmaxf(bflo(g1.w), 1e-30f)); r1[3] = bfhi(g0.w) * __builtin_amdgcn_rcpf(fmaxf(bfhi(g1.w), 1e-30f));
                    acc[ai][bj][m][0] = acc[ai][bj][m][0] * r0; acc[ai][bj][m][1] = acc[ai][bj][m][1] * r1;
                }
                if (m == 3) asm volatile("" ::: "memory");
            }
    }
    __device__ __forceinline__ void operator()(const f32x4 (&acc)[2][2][4][2], const Unit& u, int wr, int wc, int fr, int fq, const float (&)[8]) const {
        const int row0 = u.pm * BM + wr * 64 + fr, col0 = u.pn * BM + wc * 32 + 8 * fq;
#pragma unroll
        for (int ai = 0; ai < 2; ++ai)
#pragma unroll
            for (int m = 0; m < 4; ++m) {
                const int row = row0 + ai * HALF + m * 16;
#pragma unroll
                for (int bj = 0; bj < 2; ++bj) {
                    const u32x4 gt = *(const u32x4*)(GT + (size_t)row * 3072 + 2048 + col0 + bj * HALF);
                    const f32x4 v0 = acc[ai][bj][m][0], v1 = acc[ai][bj][m][1];
                    u32x4 w;
                    w.x = cvt_pk_bf16(v0[0] * bflo(gt.x), v0[1] * bfhi(gt.x)); w.y = cvt_pk_bf16(v0[2] * bflo(gt.y), v0[3] * bfhi(gt.y));
                    w.z = cvt_pk_bf16(v1[0] * bflo(gt.z), v1[1] * bfhi(gt.z)); w.w = cvt_pk_bf16(v1[2] * bflo(gt.w), v1[3] * bfhi(gt.w));
                    *(u32x4*)(MB + (size_t)row * 1024 + col0 + bj * HALF) = w;
                }
            }
    }
};


template <class Epi, class Sched, bool ALIGN_EPI = false, bool SP2 = false>
__device__ __forceinline__ void gemm_phase(PG8_LAS unsigned char* lds, const Gemm g, const Sched& S, const Epi& E) {
    int tid_ = threadIdx.x; asm volatile("" : "+v"(tid_));
    const int tid = tid_, wid = __builtin_amdgcn_readfirstlane(tid >> 6), lane = tid & 63, wr = wid >> 2, wc = wid & 3, fr = lane & 15, fq = lane >> 4;
    const int K = g.K, nt = K / BK;
    unsigned voffA[2], voffB[2];
#pragma unroll
    for (int i = 0; i < 2; ++i) { int R, C; stage_rc(tid * 16 + i * 8192, R, C); const int Rb = Epi::PERM ? ((R & ~31) + perm32(R & 31)) : R;
        voffA[i] = (unsigned)(R * K + C) * 2u; voffB[i] = (unsigned)(Rb * K + C) * 2u; }
    const size_t kstep = (size_t)(BK * 2);
    const size_t hstep = (size_t)HALF * K * 2;
    const size_t tstep = 2 * hstep;
    const unsigned ldsw = (unsigned)wid * 1024u;
    const int aoff = lds_byte(wr * 64 + fr, fq * 8), boff = lds_byte(wc * 32 + fr, fq * 8);
#define PG8_SA(b, h) (((b) * 2 + (h)) * HTB)
#define PG8_SB(b, h) ((4 + (b) * 2 + (h)) * HTB)
#define PG8_STAGE(bufoff, gbase, voff) do { _Pragma("unroll") for (int _i = 0; _i < 2; ++_i) \
        __builtin_amdgcn_global_load_lds((const unsigned*)((const char*)(gbase) + (voff)[_i]), (PG8_LAS unsigned*)(lds + (bufoff) + ldsw + _i * 8192), 16, 0, 0); } while (0)
#define PG8_LDA(dst, b, h) do { _Pragma("unroll") for (int m = 0; m < 4; ++m) _Pragma("unroll") for (int k = 0; k < 2; ++k) dst[m][k] = *(const PG8_LAS bf16x8*)(lds + PG8_SA(b, h) + aoff + m * 2048 + k * 1024); } while (0)
#define PG8_LDB(dst, b, h) do { _Pragma("unroll") for (int n = 0; n < 2; ++n) _Pragma("unroll") for (int k = 0; k < 2; ++k) dst[n][k] = *(const PG8_LAS bf16x8*)(lds + PG8_SB(b, h) + boff + n * 2048 + k * 1024); } while (0)
#define PG8_MMA(ai, bj, At, Bt) do { __builtin_amdgcn_s_setprio(1); _Pragma("unroll") for (int m = 0; m < 4; ++m) _Pragma("unroll") for (int n = 0; n < 2; ++n) _Pragma("unroll") for (int k = 0; k < 2; ++k) \
        acc[ai][bj][m][n] = __builtin_amdgcn_mfma_f32_16x16x32_bf16(Bt[n][k], At[m][k], acc[ai][bj][m][n], 0, 0, 0); __builtin_amdgcn_s_setprio(0); } while (0)
#define PG8_WAIT_V(n) asm volatile("s_waitcnt vmcnt(" #n ")" ::: "memory")
#define PG8_WAIT_L(n) asm volatile("s_waitcnt lgkmcnt(" #n ")" ::: "memory")
#define PG8_BAR __builtin_amdgcn_s_barrier()
#define PG8_SCHED __builtin_amdgcn_sched_barrier(0)
    Unit cur, nxt; int ui = 0;
    if (!S.next(0, cur)) return;
    float rsv[8] = {0.f, 0.f, 0.f, 0.f, 0.f, 0.f, 0.f, 0.f};
    f32x4 acc[2][2][4][2];
#pragma unroll
    for (int a = 0; a < 2; ++a)
#pragma unroll
        for (int b = 0; b < 2; ++b)
#pragma unroll
            for (int m = 0; m < 4; ++m)
#pragma unroll
                for (int n = 0; n < 2; ++n) acc[a][b][m][n] = (f32x4){0.f, 0.f, 0.f, 0.f};
    bf16x8 At[4][2], B0[2][2], B1[2][2];
    const char* cA = (const char*)g.A + (size_t)cur.pm * tstep + (size_t)(cur.pn / g.agdiv) * g.agstride; const char* cB = (const char*)g.Bt + (size_t)cur.pn * tstep;
    S.a_ready(cur);
    if constexpr (SP2) {
        PG8_STAGE(PG8_SB(0, 0), cB, voffB); PG8_STAGE(PG8_SB(0, 1), cB + hstep, voffB); PG8_STAGE(PG8_SA(0, 0), cA, voffA); PG8_STAGE(PG8_SA(0, 1), cA + hstep, voffA);
        if (wr == 1) PG8_BAR;
        PG8_WAIT_V(2); PG8_BAR;
        PG8_STAGE(PG8_SB(1, 0), cB + kstep, voffB); PG8_STAGE(PG8_SA(1, 0), cA + kstep, voffA); PG8_STAGE(PG8_SB(1, 1), cB + hstep + kstep, voffB);
        PG8_WAIT_V(6); PG8_BAR;
    } else {
        PG8_STAGE(PG8_SB(0, 0), cB, voffB); PG8_STAGE(PG8_SA(0, 0), cA, voffA); PG8_STAGE(PG8_SB(0, 1), cB + hstep, voffB); PG8_STAGE(PG8_SA(0, 1), cA + hstep, voffA);
        if (wr == 1) PG8_BAR;
        PG8_WAIT_V(4); PG8_BAR;
        PG8_STAGE(PG8_SB(1, 0), cB + kstep, voffB); PG8_STAGE(PG8_SA(1, 0), cA + kstep, voffA); PG8_STAGE(PG8_SB(1, 1), cB + hstep + kstep, voffB);
        PG8_WAIT_V(6); PG8_BAR;
    }
    for (;;) {
        const bool has_next = S.next(ui + 1, nxt);
        const char* nA = has_next ? (const char*)g.A + (size_t)nxt.pm * tstep + (size_t)(nxt.pn / g.agdiv) * g.agstride : cA; const char* nB = has_next ? (const char*)g.Bt + (size_t)nxt.pn * tstep : cB;
        for (int t = 0; t < nt; t += 2) {
            if constexpr (Epi::HAS_MID) { if (t == 8 || t == 16) E.mid(acc, cur, t >> 3, wr, wc, fr, fq); }
            const bool last = (t == nt - 2);
            const char* a1 = cA + (size_t)(t + 1) * kstep;
            const char* a2 = last ? nA : cA + (size_t)(t + 2) * kstep; const char* b2 = last ? nB : cB + (size_t)(t + 2) * kstep;
            const char* a3 = a2 + kstep; const char* b3 = b2 + kstep;
            if (last && has_next) S.a_ready(nxt);
            if constexpr (Epi::HAS_PRE) { if (last) E.pre(rsv, cur, wr, fr); }
            if constexpr (SP2) {
            PG8_LDB(B0, 0, 0); PG8_LDB(B1, 0, 1); PG8_SCHED; PG8_LDA(At, 0, 0); PG8_STAGE(PG8_SA(1, 1), a1 + hstep, voffA);
            PG8_WAIT_V(8); PG8_WAIT_L(0); PG8_BAR; PG8_MMA(0, 0, At, B0); PG8_MMA(0, 1, At, B1); PG8_BAR; PG8_SCHED;
            PG8_LDA(At, 0, 1); PG8_STAGE(PG8_SB(0, 0), b2, voffB); PG8_STAGE(PG8_SB(0, 1), b2 + hstep, voffB); PG8_STAGE(PG8_SA(0, 0), a2, voffA);
            PG8_WAIT_V(8); PG8_WAIT_L(0); PG8_BAR; PG8_MMA(1, 0, At, B0); PG8_MMA(1, 1, At, B1); PG8_BAR; PG8_SCHED;
            PG8_LDB(B0, 1, 0); PG8_LDB(B1, 1, 1); PG8_SCHED; PG8_LDA(At, 1, 0); PG8_STAGE(PG8_SA(0, 1), a2 + hstep, voffA);
            PG8_WAIT_V(8); PG8_WAIT_L(0); PG8_BAR; PG8_MMA(0, 0, At, B0); PG8_MMA(0, 1, At, B1); PG8_BAR; PG8_SCHED;
            PG8_LDA(At, 1, 1); PG8_STAGE(PG8_SB(1, 0), b3, voffB); PG8_STAGE(PG8_SB(1, 1), b3 + hstep, voffB); PG8_STAGE(PG8_SA(1, 0), a3, voffA);
            PG8_WAIT_V(8); PG8_WAIT_L(0); PG8_BAR; PG8_MMA(1, 0, At, B0); PG8_MMA(1, 1, At, B1); PG8_BAR; PG8_SCHED;
            } else {
            PG8_LDB(B0, 0, 0); PG8_SCHED; PG8_LDA(At, 0, 0); PG8_STAGE(PG8_SA(1, 1), a1 + hstep, voffA);
            PG8_WAIT_L(8); PG8_BAR; PG8_WAIT_L(0); PG8_MMA(0, 0, At, B0); PG8_BAR; PG8_SCHED;
            PG8_LDB(B1, 0, 1); PG8_STAGE(PG8_SB(0, 0), b2, voffB);
            PG8_BAR; PG8_WAIT_L(0); PG8_MMA(0, 1, At, B1); PG8_BAR;
            PG8_LDA(At, 0, 1); PG8_STAGE(PG8_SA(0, 0), a2, voffA);
            PG8_BAR; PG8_WAIT_L(0); PG8_MMA(1, 0, At, B0); PG8_BAR; PG8_SCHED;
            PG8_STAGE(PG8_SB(0, 1), b2 + hstep, voffB);
            PG8_WAIT_V(6); PG8_BAR; PG8_MMA(1, 1, At, B1); PG8_BAR;
            PG8_LDB(B0, 1, 0); PG8_SCHED; PG8_LDA(At, 1, 0); PG8_STAGE(PG8_SA(0, 1), a2 + hstep, voffA);
            PG8_WAIT_L(8); PG8_BAR; PG8_WAIT_L(0); PG8_MMA(0, 0, At, B0); PG8_BAR; PG8_SCHED;
            PG8_LDB(B1, 1, 1); PG8_STAGE(PG8_SB(1, 0), b3, voffB);
            PG8_BAR; PG8_WAIT_L(0); PG8_MMA(0, 1, At, B1); PG8_BAR;
            PG8_LDA(At, 1, 1); PG8_STAGE(PG8_SA(1, 0), a3, voffA);
            PG8_BAR; PG8_WAIT_L(0); PG8_MMA(1, 0, At, B0); PG8_BAR; PG8_SCHED;
            PG8_STAGE(PG8_SB(1, 1), b3 + hstep, voffB);
            PG8_WAIT_V(6); PG8_BAR; PG8_MMA(1, 1, At, B1); PG8_BAR;
            }
        }
        if constexpr (ALIGN_EPI) { if (wr == 0) PG8_BAR; }
        if constexpr (!Epi::AFTER_DRAIN) { E(acc, cur, wr, wc, fr, fq, rsv); S.done(cur); }
        if (!has_next) break;
#pragma unroll
        for (int a = 0; a < 2; ++a)
#pragma unroll
            for (int b = 0; b < 2; ++b)
#pragma unroll
                for (int m = 0; m < 4; ++m)
#pragma unroll
                    for (int n = 0; n < 2; ++n) acc[a][b][m][n] = (f32x4){0.f, 0.f, 0.f, 0.f};
        cur = nxt; cA = nA; cB = nB; ++ui;
        if constexpr (ALIGN_EPI) { if (wr == 1) PG8_BAR; }
    }
    PG8_WAIT_V(0);
    if constexpr (!ALIGN_EPI) { if (wr == 0) PG8_BAR; }
    PG8_BAR;
    if constexpr (Epi::AFTER_DRAIN) { E.fused(acc, cur, wr, wc, fr, fq, lds, wid, lane); S.done(cur); }
#undef PG8_SA
#undef PG8_SB
#undef PG8_STAGE
#undef PG8_LDA
#undef PG8_LDB
#undef PG8_MMA
#undef PG8_WAIT_V
#undef PG8_WAIT_L
#undef PG8_BAR
#undef PG8_SCHED
}
}

#define LAS __attribute__((address_space(3)))
typedef unsigned short bf16_t;
typedef short bf16x8 __attribute__((ext_vector_type(8)));
typedef short s16x4 __attribute__((ext_vector_type(4)));
typedef float f32x4 __attribute__((ext_vector_type(4)));
typedef unsigned u32x4 __attribute__((ext_vector_type(4)));
typedef unsigned u32x2 __attribute__((ext_vector_type(2)));
using pg8::cvt_pk_bf16; using pg8::fsigmoid; using pg8::fsilu; using pg8::bflo; using pg8::bfhi;

constexpr int DM = 1024, FF = 2048, NIN = 6400, DEPTH = 4;
constexpr int MP = 16896;
constexpr int BROWS = 8320;
constexpr int PADR = 112, TPB = 8208, NT = 65;
constexpr int SROW0 = 16640;
constexpr int MREAL = 16768;
constexpr int PAW = 3328, GTW = 3072;
constexpr int C_XA = 0, C_YA = 512, C_QS = 1024, C_KS = 1536, C_VS = 1664, C_QR = 1792, C_KR = 2048, C_VR = 2304, C_GR = 2816;
constexpr int NTHR = 512;
constexpr int OBS = 1536;
constexpr int LDS_BYTES = 131072 + 256;

constexpr size_t MiB = 1u << 20;
constexpr size_t WS_BAR = 0;
constexpr size_t WS_LSUM = 1 * MiB;
constexpr size_t WS_LCAR = WS_LSUM + 1 * MiB;
constexpr size_t WS_W0 = 3 * MiB;
constexpr size_t WSZ = 46 * MiB;
constexpr size_t W_GU1 = 0, W_D1 = 8 * MiB, W_IN = 12 * MiB, W_BR = 25 * MiB, W_OUT = 28 * MiB, W_GU2 = 34 * MiB, W_D2 = 42 * MiB;
constexpr size_t WS_X = WS_W0 + 2 * WSZ;
constexpr size_t WS_XB = WS_X + 66 * MiB;
constexpr size_t WS_PA = WS_XB + 33 * MiB;
constexpr size_t WS_GT = WS_PA + 108 * MiB;
constexpr size_t WS_OB = WS_GT + 99 * MiB;
constexpr size_t WS_U = WS_OB + 50 * MiB;
constexpr size_t WS_ST = WS_U + 17 * MiB;
constexpr size_t WS_SS16 = WS_ST + 9 * MiB;
constexpr size_t WS_BG = WS_SS16 + 14 * MiB;
constexpr size_t WS_RS = WS_BG + 33 * MiB;
constexpr size_t WS_END = WS_RS + 1 * MiB;

constexpr int O_YP = 0, O_YS = 16777216, O_PK = 16908288, O_PV = 17039360, O_PC = 17170432, O_PL = 17182720, O_PR = 17186816,
              O_SK = 17448960, O_SV = 25837568, O_SC = 34226176, O_SL = 35012608, O_SR = 35274752;

enum { I_XP = 0, I_XS, I_CK, I_CV, I_SCONV, I_SLRU, I_SRET, I_META, I_F1N, I_F1GU, I_F1D, I_MIXN, I_WIN, I_CONVW, I_CONVB, I_LWA, I_LBA, I_LWX, I_LBX, I_LAM,
       I_SINK, I_RETN, I_WBA, I_WBB, I_WBC, I_WOUT, I_F2N, I_F2GU, I_F2D, I_FINN };

struct Args { const float* in[30]; float* out; unsigned char* ws; int ph_lo, ph_hi; };
typedef const __attribute__((address_space(4))) Args CArgs;

__device__ __forceinline__ float bf2f(bf16_t v) { return __uint_as_float((unsigned)v << 16); }
__device__ __forceinline__ bf16_t f2bf(float f) { return (bf16_t)(cvt_pk_bf16(f, 0.f) & 0xffffu); }
__device__ __forceinline__ float gelu_tanh(float x) { const float t = 0.7978845608028654f * (x + 0.044715f * x * x * x); const float e = __expf(2.0f * t); const float th = 1.0f - 2.0f * __builtin_amdgcn_rcpf(e + 1.0f); return 0.5f * x * (1.0f + th); }
__device__ __forceinline__ void sincos_rev(float ang, float& s, float& c) {
    const double rv = (double)ang * 0.15915494309189535; const float fr = (float)(rv - __builtin_rint(rv));
    s = __builtin_amdgcn_sinf(fr); c = __builtin_amdgcn_cosf(fr);
}
__device__ __forceinline__ float rope_inv(int i) { return exp2f(-(float)i * (13.287712379549449f / 32.0f)); }
__device__ __forceinline__ float log2_gamma(int h) { return log2f(1.0f - exp2f(-5.0f - (float)h)); }
__device__ __forceinline__ int tid_opaque() { int t = threadIdx.x; asm volatile("" : "+v"(t)); return t; }
#define LDSW() asm volatile("s_waitcnt lgkmcnt(0)" ::: "memory")

__device__ __forceinline__ void cvt_item(const float* W, int K, int N, bf16_t* WT, int ldk, int rep, const float* g, int mode, LAS float* scr, int item, int lane) {
    const int nblk = N / 32, kb = item / nblk, nb = item % nblk, k0 = 64 * kb, n0 = 32 * nb;
    float wv[32];
#pragma unroll
    for (int i = 0; i < 32; ++i) { const int kk = 2 * i + (lane >> 5); wv[i] = __builtin_nontemporal_load(&W[(size_t)(k0 + kk) * N + n0 + (lane & 31)]); }
#pragma unroll
    for (int i = 0; i < 32; ++i) { const int kk = 2 * i + (lane >> 5); float w = wv[i]; if (g) w *= g[k0 + kk]; scr[kk * 33 + (lane & 31)] = w; }
    LDSW();
    const int c = lane & 7;
#pragma unroll
    for (int j = 0; j < 4; ++j) {
        const int n = (lane >> 3) + 8 * j; const LAS float* s = scr + (8 * c) * 33 + n;
        u32x4 o; o.x = cvt_pk_bf16(s[0 * 33], s[1 * 33]); o.y = cvt_pk_bf16(s[2 * 33], s[3 * 33]); o.z = cvt_pk_bf16(s[4 * 33], s[5 * 33]); o.w = cvt_pk_bf16(s[6 * 33], s[7 * 33]);
        const int nn = n0 + n; const int drow = mode ? (256 * ((nn & 2047) >> 7) + 128 * (nn >> 11) + (nn & 127)) : nn;
        for (int r = 0; r < rep; ++r) *(u32x4*)(WT + (size_t)drow * ldk + r * K + k0 + 8 * c) = o;
    }
    LDSW();
}
__device__ __forceinline__ void convert_layer(CArgs* a, int l, unsigned char* wbuf, LAS unsigned char* lds, int gw, int ngw, int wave, int lane) {
    LAS float* scr = (LAS float*)(lds + wave * 8448);
    constexpr int I_GU = 16 * 128, I_D = 32 * 32, I_W = 16 * 200, I_B = 8 * 32, I_O = 16 * 32;
    constexpr int NITEMS = 2 * I_GU + 2 * I_D + I_W + 3 * I_B + I_O;
    for (int it = gw; it < NITEMS; it += ngw) {
        int r = it;
        if (r < I_GU) { cvt_item(a->in[I_F1GU] + (size_t)l * DM * 4096, DM, 4096, (bf16_t*)(wbuf + W_GU1), DM, 1, a->in[I_F1N] + l * DM, 1, scr, r, lane); continue; } r -= I_GU;
        if (r < I_GU) { cvt_item(a->in[I_F2GU] + (size_t)l * DM * 4096, DM, 4096, (bf16_t*)(wbuf + W_GU2), DM, 1, a->in[I_F2N] + l * DM, 1, scr, r, lane); continue; } r -= I_GU;
        if (r < I_D) { cvt_item(a->in[I_F1D] + (size_t)l * FF * DM, FF, DM, (bf16_t*)(wbuf + W_D1), FF, 1, nullptr, 0, scr, r, lane); continue; } r -= I_D;
        if (r < I_D) { cvt_item(a->in[I_F2D] + (size_t)l * FF * DM, FF, DM, (bf16_t*)(wbuf + W_D2), FF, 1, nullptr, 0, scr, r, lane); continue; } r -= I_D;
        if (r < I_W) { cvt_item(a->in[I_WIN] + (size_t)l * DM * NIN, DM, NIN, (bf16_t*)(wbuf + W_IN), DM, 1, a->in[I_MIXN] + l * DM, 0, scr, r, lane); continue; } r -= I_W;
        if (r < 3 * I_B) { const int br = r / I_B; cvt_item((br == 0 ? a->in[I_WBA] : (br == 1 ? a->in[I_WBB] : a->in[I_WBC])) + (size_t)l * 512 * DM, 512, DM, (bf16_t*)(wbuf + W_BR) + br * 512, OBS, 1, nullptr, 0, scr, r % I_B, lane); continue; } r -= 3 * I_B;
        cvt_item(a->in[I_WOUT] + (size_t)l * DM * DM, DM, DM, (bf16_t*)(wbuf + W_OUT), DM, 1, nullptr, 0, scr, r, lane);
    }
}

__device__ __forceinline__ float wave_sum(float v) {
#pragma unroll
    for (int o = 1; o < 64; o <<= 1) v += __shfl_xor(v, o);
    return v;
}
__device__ __forceinline__ void init_rows(CArgs* a, float* X, bf16_t* XB, float* SS, float* RS0, bf16_t* OB, int gw, int ngw, int lane) {
    for (int r = gw; r < MP; r += ngw) {
        const float* src = nullptr;
        if (r < 2 * BROWS) { const int b = r / BROWS, pr = r % BROWS; if (pr >= PADR) { const int t = pr - PADR; src = (t < 16) ? a->in[I_META] + (size_t)t * DM : a->in[I_XP] + ((size_t)b * 8192 + (t - 16)) * DM; } }
        else if (r < MREAL) src = a->in[I_XS] + (size_t)(r - SROW0) * DM;
        float sq = 0.f;
#pragma unroll
        for (int j = 0; j < 4; ++j) {
            f32x4 v = (f32x4){0.f, 0.f, 0.f, 0.f};
            if (src) v = __builtin_nontemporal_load((const f32x4*)src + lane + 64 * j);
            *((f32x4*)(X + (size_t)r * DM) + lane + 64 * j) = v;
            u32x2 w; w.x = cvt_pk_bf16(v[0], v[1]); w.y = cvt_pk_bf16(v[2], v[3]); *((u32x2*)(XB + (size_t)r * DM) + lane + 64 * j) = w;
            sq += (v[0] * v[0] + v[1] * v[1]) + (v[2] * v[2] + v[3] * v[3]);
        }
        sq = wave_sum(sq);
        if (lane < 16) SS[(size_t)r * 16 + lane] = (lane == 0) ? sq : 0.f;
        if (lane == 0) RS0[r] = __builtin_amdgcn_rsqf(sq * (1.0f / 1024.0f) + 1e-6f);
        if (r >= MREAL) {
#pragma unroll
            for (int br = 0; br < 3; ++br) *((u32x4*)(OB + (size_t)r * OBS + br * 512) + lane) = (u32x4){0u, 0u, 0u, 0u};
        }
    }
}

__device__ __forceinline__ void lru1_item(CArgs* a, int l, int tt, int chblk, const bf16_t* PA, bf16_t* OB0, float* LSUM, float* AG, float* BG, LAS unsigned char* lds) {
    LAS float* xa_s = (LAS float*)lds;
    LAS float* xc_s = xa_s + 131 * 64;
    LAS bf16_t* wt_s = (LAS bf16_t*)(xc_s + 128 * 64);
    LAS float* seg_s = (LAS float*)(wt_s + 128 * 72);
    const int tid = tid_opaque(), lane = tid & 63, w = tid >> 6, fr = lane & 15, fq = lane >> 4;
    const int ch0 = chblk * 64, ch = ch0 + lane;
    const bool sample = (tt == 130);
    const int b = tt / NT, n = tt % NT;
    const int row0 = sample ? SROW0 : b * BROWS + n * 128;
    {
        const float* wa = a->in[I_LWA] + ((size_t)l * 8 + chblk) * 4096; const float* wx = a->in[I_LWX] + ((size_t)l * 8 + chblk) * 4096;
        float wv[16];
#pragma unroll
        for (int k = 0; k < 16; ++k) { const int i = tid + k * NTHR; wv[k] = (i < 4096) ? wa[i] : wx[i - 4096]; }
#pragma unroll
        for (int k = 0; k < 16; ++k) { const int i = tid + k * NTHR; const int m = i >> 12, c = (i >> 6) & 63, d = i & 63; wt_s[(m * 64 + d) * 72 + c] = f2bf(wv[k]); }
    }
    const float cw0 = a->in[I_CONVW][(l * 4 + 0) * 512 + ch], cw1 = a->in[I_CONVW][(l * 4 + 1) * 512 + ch], cw2 = a->in[I_CONVW][(l * 4 + 2) * 512 + ch], cw3 = a->in[I_CONVW][(l * 4 + 3) * 512 + ch];
    const float cb = a->in[I_CONVB][l * 512 + ch];
    if (!sample) {
        float xv[17];
#pragma unroll
        for (int k = 0; k < 17; ++k) {
            const int rr = w + 8 * k; const int grow = row0 - 3 + rr; xv[k] = 0.f;
            if (rr < 131 && !(n == 0 && rr < 3)) xv[k] = bf2f(PA[(size_t)grow * PAW + C_XA + ch]);
        }
#pragma unroll
        for (int k = 0; k < 17; ++k) { const int rr = w + 8 * k; if (rr < 131) xa_s[rr * 64 + lane] = xv[k]; }
        __syncthreads();
#pragma unroll 4
        for (int r = w; r < 128; r += 8) xc_s[r * 64 + lane] = cb + cw0 * xa_s[r * 64 + lane] + cw1 * xa_s[(r + 1) * 64 + lane] + cw2 * xa_s[(r + 2) * 64 + lane] + cw3 * xa_s[(r + 3) * 64 + lane];
        if (n == NT - 1 && w < 3) a->out[O_PC + ((l * 2 + b) * 3 + w) * 512 + ch] = xa_s[(128 + w) * 64 + lane];
    } else {
#pragma unroll
        for (int k = 0; k < 16; ++k) { const int r = w + 8 * k;
            const float* sc = a->in[I_SCONV] + ((size_t)(l * 128 + r) * 3) * 512 + ch; const float s0 = sc[0], s1 = sc[512], s2 = sc[1024];
            const float xa = bf2f(PA[(size_t)(SROW0 + r) * PAW + C_XA + ch]);
            xc_s[r * 64 + lane] = cb + cw0 * s0 + cw1 * s1 + cw2 * s2 + cw3 * xa;
            float* oc = a->out + O_SC + ((size_t)(l * 128 + r) * 3) * 512 + ch; oc[0] = s1; oc[512] = s2; oc[1024] = xa;
        }
    }
    __syncthreads();
    f32x4 acc[8];
    {
        bf16x8 af[2];
#pragma unroll
        for (int ks = 0; ks < 2; ++ks) {
            const f32x4 x0 = *(const LAS f32x4*)(xc_s + (16 * w + fr) * 64 + 32 * ks + 8 * fq), x1 = *(const LAS f32x4*)(xc_s + (16 * w + fr) * 64 + 32 * ks + 8 * fq + 4);
            u32x4 p; p.x = cvt_pk_bf16(x0[0], x0[1]); p.y = cvt_pk_bf16(x0[2], x0[3]); p.z = cvt_pk_bf16(x1[0], x1[1]); p.w = cvt_pk_bf16(x1[2], x1[3]); af[ks] = __builtin_bit_cast(bf16x8, p);
        }
#pragma unroll
        for (int t = 0; t < 8; ++t) {
            acc[t] = (f32x4){0.f, 0.f, 0.f, 0.f};
#pragma unroll
            for (int ks = 0; ks < 2; ++ks) { const bf16x8 bfr = *(const LAS bf16x8*)(wt_s + (t * 16 + fr) * 72 + 32 * ks + 8 * fq); acc[t] = __builtin_amdgcn_mfma_f32_16x16x32_bf16(af[ks], bfr, acc[t], 0, 0, 0); }
        }
    }
    LAS float* a_s = xa_s;
#pragma unroll
    for (int dt = 0; dt < 4; ++dt) {
        const int d = 16 * dt + fr, cch = ch0 + d;
        const float ba = a->in[I_LBA][l * 512 + cch], bx = a->in[I_LBX][l * 512 + cch];
        const float sp = log1pf(__expf(-a->in[I_LAM][l * 512 + cch]));
#pragma unroll
        for (int i = 0; i < 4; ++i) {
            const int r = 16 * w + 4 * fq + i;
            const float rg = fsigmoid(acc[dt][i] + ba), ig = fsigmoid(acc[4 + dt][i] + bx);
            const float la = -8.0f * rg * sp; float av = __expf(la);
            const float t2 = 2.0f * la;
            const float om = (t2 > -0.0625f) ? -t2 * (1.0f + t2 * (0.5f + t2 * (0.16666667f + t2 * (0.041666667f + t2 * 0.0083333333f)))) : 1.0f - av * av;
            float bv = __builtin_amdgcn_sqrtf(om) * (ig * xc_s[r * 64 + d]);
            if (!sample && n == 0 && r < PADR) { av = 1.0f; bv = 0.0f; }
            a_s[r * 64 + d] = av; xc_s[r * 64 + d] = bv;
        }
    }
    __syncthreads();
    if (sample) {
#pragma unroll
        for (int i = 0; i < 16; ++i) {
            const int r = w * 16 + i;
            const float hs = a_s[r * 64 + lane] * a->in[I_SLRU][(size_t)(l * 128 + r) * 512 + ch] + xc_s[r * 64 + lane];
            a->out[O_SL + (size_t)(l * 128 + r) * 512 + ch] = hs;
            const float ya = bf2f(PA[(size_t)(SROW0 + r) * PAW + C_YA + ch]);
            OB0[(size_t)(SROW0 + r) * OBS + ch] = f2bf(hs * gelu_tanh(ya));
        }
        __syncthreads();
        return;
    }
    float P = 1.0f, h = 0.0f;
#pragma unroll 4
    for (int i = 0; i < 16; ++i) {
        const int r = w * 16 + i; const float av = a_s[r * 64 + lane], bv = xc_s[r * 64 + lane];
        AG[(size_t)(row0 + r) * 512 + ch] = av; BG[(size_t)(row0 + r) * 512 + ch] = bv;
        h = av * h + bv; P *= av;
    }
    seg_s[(w * 64 + lane) * 2] = P; seg_s[(w * 64 + lane) * 2 + 1] = h;
    __syncthreads();
    if (w == 0) {
        float Pt = 1.0f, ht = 0.0f;
#pragma unroll
        for (int q = 0; q < 8; ++q) { const float p = seg_s[(q * 64 + lane) * 2], hh = seg_s[(q * 64 + lane) * 2 + 1]; ht = p * ht + hh; Pt *= p; }
        LSUM[((size_t)tt * 512 + ch) * 2] = Pt; LSUM[((size_t)tt * 512 + ch) * 2 + 1] = ht;
    }
    __syncthreads();
}
__device__ __forceinline__ void lru2_item(int tt, int chblk, const bf16_t* PA, bf16_t* OB0, const float* LCAR, const float* AG, const float* BG, LAS unsigned char* lds) {
    LAS float* seg_s = (LAS float*)lds;
    const int tid = tid_opaque(), lane = tid & 63, w = tid >> 6; const int ch = chblk * 64 + lane;
    const int b = tt / NT, n = tt % NT, row0 = b * BROWS + n * 128 + w * 16;
    float av[16], bv[16], yv[16];
#pragma unroll
    for (int i = 0; i < 16; ++i) { av[i] = AG[(size_t)(row0 + i) * 512 + ch]; bv[i] = BG[(size_t)(row0 + i) * 512 + ch]; yv[i] = bf2f(PA[(size_t)(row0 + i) * PAW + C_YA + ch]); }
    float hc = LCAR[(size_t)tt * 512 + ch];
    float P = 1.0f, h = 0.0f;
#pragma unroll
    for (int i = 0; i < 16; ++i) { h = av[i] * h + bv[i]; P *= av[i]; }
    seg_s[(w * 64 + lane) * 2] = P; seg_s[(w * 64 + lane) * 2 + 1] = h;
    __syncthreads();
    for (int q = 0; q < w; ++q) { const float p = seg_s[(q * 64 + lane) * 2], hh = seg_s[(q * 64 + lane) * 2 + 1]; hc = p * hc + hh; }
#pragma unroll
    for (int i = 0; i < 16; ++i) { hc = av[i] * hc + bv[i]; OB0[(size_t)(row0 + i) * OBS + ch] = f2bf(hc * gelu_tanh(yv[i])); }
    __syncthreads();
}

__device__ __forceinline__ void swa_item(CArgs* a, int l, int item, const bf16_t* PA, bf16_t* OB1, LAS unsigned char* lds) {
    const int kvh = item & 1, bn = item >> 1, b = bn / NT, n = bn % NT, row0 = b * BROWS + n * 128;
    LAS bf16_t* Ks = (LAS bf16_t*)lds;
    LAS bf16_t* Vt = Ks + 256 * 72;
    const int tid = tid_opaque(), lane = tid & 63, w = tid >> 6, fr = lane & 15, fq = lane >> 4;
    const int g = w >> 1, h = kvh * 4 + g;
    const float sink = a->in[I_SINK][l * 8 + h];
    bf16x8 qfa[4][2];
#pragma unroll
    for (int qb = 0; qb < 4; ++qb) { const int row = row0 + (w & 1) * 64 + qb * 16 + fr; qfa[qb][0] = *(const bf16x8*)(PA + (size_t)row * PAW + C_QS + h * 64 + fq * 8); qfa[qb][1] = *(const bf16x8*)(PA + (size_t)row * PAW + C_QS + h * 64 + 32 + fq * 8); }
    {
        const int key = tid >> 1, hf = tid & 1; const int grow = row0 - 128 + key; const bool valid = (n > 0) || (key >= 128);
        u32x4 kk[4], vv[4];
#pragma unroll
        for (int j = 0; j < 4; ++j) { kk[j] = (u32x4){0u, 0u, 0u, 0u}; vv[j] = (u32x4){0u, 0u, 0u, 0u}; }
        if (valid) {
            const u32x4* kp = (const u32x4*)(PA + (size_t)grow * PAW + C_KS + kvh * 64 + hf * 32); const u32x4* vp = (const u32x4*)(PA + (size_t)grow * PAW + C_VS + kvh * 64 + hf * 32);
#pragma unroll
            for (int j = 0; j < 4; ++j) { kk[j] = kp[j]; vv[j] = vp[j]; }
        }
#pragma unroll
        for (int j = 0; j < 4; ++j) *(LAS u32x4*)(Ks + key * 72 + hf * 32 + j * 8) = kk[j];
#pragma unroll
        for (int j = 0; j < 4; ++j) {
            const unsigned ws4[4] = {vv[j].x, vv[j].y, vv[j].z, vv[j].w};
#pragma unroll
            for (int q = 0; q < 4; ++q) { const int d = hf * 32 + j * 8 + q * 2; Vt[d * 280 + key] = (bf16_t)(ws4[q] & 0xffffu); Vt[(d + 1) * 280 + key] = (bf16_t)(ws4[q] >> 16); }
        }
        if (tid < 64) {
#pragma unroll
            for (int e = 256; e < 280; ++e) Vt[tid * 280 + e] = 0;
        }
        if (n == NT - 1 && key >= 128) {
            float* ok = a->out + O_PK + ((size_t)(l * 2 + b) * 128 + (key - 128)) * 128 + kvh * 64 + hf * 32; float* ov = a->out + O_PV + ((size_t)(l * 2 + b) * 128 + (key - 128)) * 128 + kvh * 64 + hf * 32;
#pragma unroll
            for (int j = 0; j < 4; ++j) {
                *(f32x4*)(ok + j * 8) = (f32x4){bflo(kk[j].x), bfhi(kk[j].x), bflo(kk[j].y), bfhi(kk[j].y)}; *(f32x4*)(ok + j * 8 + 4) = (f32x4){bflo(kk[j].z), bfhi(kk[j].z), bflo(kk[j].w), bfhi(kk[j].w)};
                *(f32x4*)(ov + j * 8) = (f32x4){bflo(vv[j].x), bfhi(vv[j].x), bflo(vv[j].y), bfhi(vv[j].y)}; *(f32x4*)(ov + j * 8 + 4) = (f32x4){bflo(vv[j].z), bfhi(vv[j].z), bflo(vv[j].w), bfhi(vv[j].w)};
            }
        }
    }
    __syncthreads();
#pragma unroll
    for (int qb = 0; qb < 4; ++qb) {
        const int r0 = (w & 1) * 64 + qb * 16, jt0 = r0 >> 4, r = r0 + fr, row = row0 + r;
        const bf16x8 qf[2] = {qfa[qb][0], qfa[qb][1]};
        f32x4 sacc[10];
#pragma unroll
        for (int t = 0; t < 9; ++t) {
            sacc[t] = (f32x4){0.f, 0.f, 0.f, 0.f};
#pragma unroll
            for (int ks = 0; ks < 2; ++ks) { const bf16x8 kf = *(const LAS bf16x8*)(Ks + ((jt0 + t) * 16 + fr) * 72 + ks * 32 + fq * 8); sacc[t] = __builtin_amdgcn_mfma_f32_16x16x32_bf16(kf, qf[ks], sacc[t], 0, 0, 0); }
        }
        sacc[9] = (f32x4){0.f, 0.f, 0.f, 0.f};
        float mx = -INFINITY;
#pragma unroll
        for (int t = 0; t < 9; ++t)
#pragma unroll
            for (int i = 0; i < 4; ++i) {
                const int kj = (jt0 + t) * 16 + 4 * fq + i;
                const bool valid = (kj > r) && (kj <= r + 128) && (n * 128 - 128 + kj >= PADR);
                const float s = valid ? sacc[t][i] * 0.125f : -INFINITY; sacc[t][i] = s; mx = fmaxf(mx, s);
            }
        mx = fmaxf(mx, __shfl_xor(mx, 16)); mx = fmaxf(mx, __shfl_xor(mx, 32));
        const float mm = fmaxf(mx, sink);
        float sum = 0.f;
#pragma unroll
        for (int t = 0; t < 9; ++t)
#pragma unroll
            for (int i = 0; i < 4; ++i) { const float e = __expf(sacc[t][i] - mm); sacc[t][i] = e; sum += e; }
        sum += __shfl_xor(sum, 16); sum += __shfl_xor(sum, 32);
        const float inv = 1.0f / (sum + __expf(sink - mm));
        f32x4 oacc[4];
#pragma unroll
        for (int dt = 0; dt < 4; ++dt) oacc[dt] = (f32x4){0.f, 0.f, 0.f, 0.f};
#pragma unroll
        for (int p = 0; p < 5; ++p) {
            const f32x4 ea = sacc[2 * p] * inv, eb = sacc[2 * p + 1] * inv;
            u32x4 pw; pw.x = cvt_pk_bf16(ea[0], ea[1]); pw.y = cvt_pk_bf16(ea[2], ea[3]); pw.z = cvt_pk_bf16(eb[0], eb[1]); pw.w = cvt_pk_bf16(eb[2], eb[3]);
            const bf16x8 pb = __builtin_bit_cast(bf16x8, pw);
            const int ja = jt0 + 2 * p;
#pragma unroll
            for (int dt = 0; dt < 4; ++dt) {
                const u32x2 va = *(const LAS u32x2*)(Vt + (dt * 16 + fr) * 280 + ja * 16 + 4 * fq), vb = *(const LAS u32x2*)(Vt + (dt * 16 + fr) * 280 + (ja + 1) * 16 + 4 * fq);
                const u32x4 vw = (u32x4){va.x, va.y, vb.x, vb.y};
                oacc[dt] = __builtin_amdgcn_mfma_f32_16x16x32_bf16(__builtin_bit_cast(bf16x8, vw), pb, oacc[dt], 0, 0, 0);
            }
        }
#pragma unroll
        for (int dt = 0; dt < 4; ++dt) { u32x2 o; o.x = cvt_pk_bf16(oacc[dt][0], oacc[dt][1]); o.y = cvt_pk_bf16(oacc[dt][2], oacc[dt][3]); *(u32x2*)(OB1 + (size_t)row * OBS + h * 64 + dt * 16 + 4 * fq) = o; }
    }
    __syncthreads();
}

__device__ __forceinline__ void ret_u_item(int item, const bf16_t* PA, float* U, LAS unsigned char* lds) {
    const int hh = item & 3, bc = item >> 2, b = bc / NT, c = bc % NT, row0 = b * BROWS + c * 128;
    LAS bf16_t* Kt = (LAS bf16_t*)lds;
    LAS bf16_t* Vt = Kt + 64 * 136;
    const int tid = tid_opaque(), lane = tid & 63, w = tid >> 6, fr = lane & 15, fq = lane >> 4; const float l2g = log2_gamma(hh);
    {
        const int j = tid >> 2, q = tid & 3; const bf16_t* rowp = PA + (size_t)(row0 + j) * PAW;
        const u32x4* vp = (const u32x4*)(rowp + C_VR + hh * 128 + q * 32);
        u32x4 vv[4];
#pragma unroll
        for (int t = 0; t < 4; ++t) vv[t] = vp[t];
        const u32x4 k1 = *(const u32x4*)(rowp + C_KR + hh * 64 + q * 8), k2 = *(const u32x4*)(rowp + C_KR + hh * 64 + 32 + q * 8);
#pragma unroll
        for (int t = 0; t < 4; ++t) {
            const unsigned ws4[4] = {vv[t].x, vv[t].y, vv[t].z, vv[t].w};
#pragma unroll
            for (int k = 0; k < 4; ++k) { const int e = q * 32 + t * 8 + k * 2; Vt[e * 136 + j] = (bf16_t)(ws4[k] & 0xffffu); Vt[(e + 1) * 136 + j] = (bf16_t)(ws4[k] >> 16); }
        }
        const unsigned w1[4] = {k1.x, k1.y, k1.z, k1.w}, w2[4] = {k2.x, k2.y, k2.z, k2.w};
        const int pos = c * 128 + j - PADR; const float dec = exp2f((float)(127 - j) * l2g) * 0.125f;
#pragma unroll
        for (int k = 0; k < 4; ++k) {
            float sa, ca, sb, cb; sincos_rev((float)pos * rope_inv(q * 8 + 2 * k), sa, ca); sincos_rev((float)pos * rope_inv(q * 8 + 2 * k + 1), sb, cb);
            const float x1a = bflo(w1[k]), x1b = bfhi(w1[k]), x2a = bflo(w2[k]), x2b = bfhi(w2[k]);
            const int d = q * 8 + 2 * k;
            Kt[d * 136 + j] = f2bf((x1a * ca - x2a * sa) * dec); Kt[(d + 32) * 136 + j] = f2bf((x1a * sa + x2a * ca) * dec);
            Kt[(d + 1) * 136 + j] = f2bf((x1b * cb - x2b * sb) * dec); Kt[(d + 33) * 136 + j] = f2bf((x1b * sb + x2b * cb) * dec);
        }
    }
    __syncthreads();
    const int dt = w >> 1;
    f32x4 acc[4];
#pragma unroll
    for (int t = 0; t < 4; ++t) acc[t] = (f32x4){0.f, 0.f, 0.f, 0.f};
#pragma unroll
    for (int ks = 0; ks < 4; ++ks) {
        const bf16x8 kf = *(const LAS bf16x8*)(Kt + (dt * 16 + fr) * 136 + 32 * ks + 8 * fq);
#pragma unroll
        for (int t = 0; t < 4; ++t) { const bf16x8 vf = *(const LAS bf16x8*)(Vt + ((4 * (w & 1) + t) * 16 + fr) * 136 + 32 * ks + 8 * fq); acc[t] = __builtin_amdgcn_mfma_f32_16x16x32_bf16(vf, kf, acc[t], 0, 0, 0); }
    }
#pragma unroll
    for (int t = 0; t < 4; ++t)
#pragma unroll
        for (int i = 0; i < 4; ++i) U[(size_t)item * 8192 + ((4 * (w & 1) + t) * 16 + 4 * fq + i) * 64 + dt * 16 + fr] = acc[t][i];
    __syncthreads();
}
__device__ __forceinline__ void ret_out_item(CArgs* a, int l, int item, const bf16_t* PA, const bf16_t* ST, bf16_t* OB2, LAS unsigned char* lds) {
    const int hh = item & 3, bc = item >> 2, b = bc / NT, c = bc % NT, row0 = b * BROWS + c * 128;
    LAS bf16_t* Kr = (LAS bf16_t*)lds;
    LAS bf16_t* Vt = Kr + 128 * 72;
    const int tid = tid_opaque(), lane = tid & 63, w = tid >> 6, fr = lane & 15, fq = lane >> 4; const float l2g = log2_gamma(hh);
    {
        const int j = tid >> 2, q = tid & 3; const bf16_t* rowp = PA + (size_t)(row0 + j) * PAW;
        const u32x4* vp = (const u32x4*)(rowp + C_VR + hh * 128 + q * 32);
        u32x4 vv[4];
#pragma unroll
        for (int t = 0; t < 4; ++t) vv[t] = vp[t];
        const u32x4 k1 = *(const u32x4*)(rowp + C_KR + hh * 64 + q * 8), k2 = *(const u32x4*)(rowp + C_KR + hh * 64 + 32 + q * 8);
#pragma unroll
        for (int t = 0; t < 4; ++t) {
            const unsigned ws4[4] = {vv[t].x, vv[t].y, vv[t].z, vv[t].w};
#pragma unroll
            for (int k = 0; k < 4; ++k) { const int e = q * 32 + t * 8 + k * 2; Vt[e * 136 + j] = (bf16_t)(ws4[k] & 0xffffu); Vt[(e + 1) * 136 + j] = (bf16_t)(ws4[k] >> 16); }
        }
        const unsigned w1[4] = {k1.x, k1.y, k1.z, k1.w}, w2[4] = {k2.x, k2.y, k2.z, k2.w};
        const int pos = c * 128 + j - PADR; unsigned o1[4], o2[4];
#pragma unroll
        for (int k = 0; k < 4; ++k) {
            float sa, ca, sb, cb; sincos_rev((float)pos * rope_inv(q * 8 + 2 * k), sa, ca); sincos_rev((float)pos * rope_inv(q * 8 + 2 * k + 1), sb, cb);
            const float x1a = bflo(w1[k]), x1b = bfhi(w1[k]), x2a = bflo(w2[k]), x2b = bfhi(w2[k]);
            o1[k] = cvt_pk_bf16((x1a * ca - x2a * sa) * 0.125f, (x1b * cb - x2b * sb) * 0.125f); o2[k] = cvt_pk_bf16((x1a * sa + x2a * ca) * 0.125f, (x1b * sb + x2b * cb) * 0.125f);
        }
        *(LAS u32x4*)(Kr + j * 72 + q * 8) = (u32x4){o1[0], o1[1], o1[2], o1[3]}; *(LAS u32x4*)(Kr + j * 72 + 32 + q * 8) = (u32x4){o2[0], o2[1], o2[2], o2[3]};
    }
    __syncthreads();
    const int il = 16 * w + fr, row = row0 + il, pos = c * 128 + il - PADR;
    bf16x8 qf[2], qs[2];
    {
        const u32x4 q1 = *(const u32x4*)(PA + (size_t)row * PAW + C_QR + hh * 64 + fq * 8), q2 = *(const u32x4*)(PA + (size_t)row * PAW + C_QR + hh * 64 + 32 + fq * 8);
        const unsigned w1[4] = {q1.x, q1.y, q1.z, q1.w}, w2[4] = {q2.x, q2.y, q2.z, q2.w};
        const float dsc = exp2f((float)(il + 1) * l2g);
        u32x4 o1, o2, s1, s2; unsigned r1[4], r2[4], t1[4], t2[4];
#pragma unroll
        for (int k = 0; k < 4; ++k) {
            float sa, ca, sb, cb; sincos_rev((float)pos * rope_inv(fq * 8 + 2 * k), sa, ca); sincos_rev((float)pos * rope_inv(fq * 8 + 2 * k + 1), sb, cb);
            const float x1a = bflo(w1[k]), x1b = bfhi(w1[k]), x2a = bflo(w2[k]), x2b = bfhi(w2[k]);
            const float y1a = x1a * ca - x2a * sa, y2a = x1a * sa + x2a * ca, y1b = x1b * cb - x2b * sb, y2b = x1b * sb + x2b * cb;
            r1[k] = cvt_pk_bf16(y1a, y1b); r2[k] = cvt_pk_bf16(y2a, y2b); t1[k] = cvt_pk_bf16(y1a * dsc, y1b * dsc); t2[k] = cvt_pk_bf16(y2a * dsc, y2b * dsc);
        }
        o1 = (u32x4){r1[0], r1[1], r1[2], r1[3]}; o2 = (u32x4){r2[0], r2[1], r2[2], r2[3]}; s1 = (u32x4){t1[0], t1[1], t1[2], t1[3]}; s2 = (u32x4){t2[0], t2[1], t2[2], t2[3]};
        qf[0] = __builtin_bit_cast(bf16x8, o1); qf[1] = __builtin_bit_cast(bf16x8, o2); qs[0] = __builtin_bit_cast(bf16x8, s1); qs[1] = __builtin_bit_cast(bf16x8, s2);
    }
    f32x4 sacc[8];
#pragma unroll
    for (int jt = 0; jt < 8; ++jt) {
        sacc[jt] = (f32x4){0.f, 0.f, 0.f, 0.f};
        if (jt <= w) {
#pragma unroll
            for (int ks = 0; ks < 2; ++ks) { const bf16x8 kf = *(const LAS bf16x8*)(Kr + (jt * 16 + fr) * 72 + ks * 32 + fq * 8); sacc[jt] = __builtin_amdgcn_mfma_f32_16x16x32_bf16(kf, qf[ks], sacc[jt], 0, 0, 0); }
        }
#pragma unroll
        for (int i = 0; i < 4; ++i) { const int dl = il - (jt * 16 + 4 * fq + i); sacc[jt][i] = (dl >= 0) ? sacc[jt][i] * exp2f((float)dl * l2g) : 0.f; }
    }
    f32x4 oacc[8];
#pragma unroll
    for (int et = 0; et < 8; ++et) oacc[et] = (f32x4){0.f, 0.f, 0.f, 0.f};
#pragma unroll
    for (int p = 0; p < 4; ++p) {
        if (2 * p <= w) {
            u32x4 pw; pw.x = cvt_pk_bf16(sacc[2 * p][0], sacc[2 * p][1]); pw.y = cvt_pk_bf16(sacc[2 * p][2], sacc[2 * p][3]); pw.z = cvt_pk_bf16(sacc[2 * p + 1][0], sacc[2 * p + 1][1]); pw.w = cvt_pk_bf16(sacc[2 * p + 1][2], sacc[2 * p + 1][3]);
            const bf16x8 pb = __builtin_bit_cast(bf16x8, pw);
#pragma unroll
            for (int et = 0; et < 8; ++et) {
                const u32x2 va = *(const LAS u32x2*)(Vt + (et * 16 + fr) * 136 + 32 * p + 4 * fq), vb = *(const LAS u32x2*)(Vt + (et * 16 + fr) * 136 + 32 * p + 16 + 4 * fq);
                const u32x4 vw = (u32x4){va.x, va.y, vb.x, vb.y};
                oacc[et] = __builtin_amdgcn_mfma_f32_16x16x32_bf16(__builtin_bit_cast(bf16x8, vw), pb, oacc[et], 0, 0, 0);
            }
        }
    }
    {
        const bf16_t* sb = ST + (size_t)item * 8192;
#pragma unroll
        for (int et = 0; et < 8; ++et)
#pragma unroll
            for (int ks = 0; ks < 2; ++ks) { const bf16x8 sf = *(const bf16x8*)(sb + (et * 16 + fr) * 64 + ks * 32 + fq * 8); oacc[et] = __builtin_amdgcn_mfma_f32_16x16x32_bf16(sf, qs[ks], oacc[et], 0, 0, 0); }
    }
    float sm = 0.f;
#pragma unroll
    for (int et = 0; et < 8; ++et) sm += (oacc[et][0] + oacc[et][1]) + (oacc[et][2] + oacc[et][3]);
    sm += __shfl_xor(sm, 16); sm += __shfl_xor(sm, 32);
    const float mu = sm * (1.0f / 128.0f); float vr = 0.f;
#pragma unroll
    for (int et = 0; et < 8; ++et) { const f32x4 d = oacc[et] - mu; vr += (d[0] * d[0] + d[1] * d[1]) + (d[2] * d[2] + d[3] * d[3]); }
    vr += __shfl_xor(vr, 16); vr += __shfl_xor(vr, 32);
    const float rstd = 1.0f / sqrtf(vr * (1.0f / 128.0f) + 1e-5f);
#pragma unroll
    for (int et = 0; et < 8; ++et) {
        const int e = et * 16 + 4 * fq; const f32x4 gn = *(const f32x4*)(a->in[I_RETN] + l * 512 + hh * 128 + e);
        const u32x2 gr = *(const u32x2*)(PA + (size_t)row * PAW + C_GR + hh * 128 + e);
        const f32x4 y = (oacc[et] - mu) * rstd * gn;
        u32x2 o; o.x = cvt_pk_bf16(y[0] * fsilu(bflo(gr.x)), y[1] * fsilu(bfhi(gr.x))); o.y = cvt_pk_bf16(y[2] * fsilu(bflo(gr.y)), y[3] * fsilu(bfhi(gr.y)));
        *(u32x2*)(OB2 + (size_t)row * OBS + hh * 128 + e) = o;
    }
    __syncthreads();
}


enum { TM_SWIGLU = 0, TM_RESID = 1, TM_PROJ = 2, TM_BRANCH = 3 };
constexpr int TROW0 = 16384;
struct TailArgs { const bf16_t* A; const bf16_t* Bt; int K, N; bf16_t* O1; bf16_t* O2; float* X; const float* ss; float* ssn; const bf16_t* GT; float scale; };
template <int MODE> __device__ __forceinline__ void tail_gemm(const TailArgs& t, int u0, int G, LAS unsigned char* lds) {
    const int tid = tid_opaque(), lane = tid & 63, w = __builtin_amdgcn_readfirstlane(tid >> 6), fr = lane & 15, fq = lane >> 4;
    LAS float* part = (LAS float*)lds;
    const int K = t.K, nu = 8 * (t.N / 64);
    int ks0, nks;
    if (MODE == TM_BRANCH) { if (w < 6) { const int q = w % 3; ks0 = 16 * (w / 3) + (q == 0 ? 0 : (q == 1 ? 6 : 11)); nks = (q == 0) ? 6 : 5; } else { ks0 = 32 + 8 * (w - 6); nks = 8; } }
    else { nks = K / 256; ks0 = w * nks; }
    bf16x8 af[4][3], bfr[4][4];
#define TG_LOAD(uu, s0) do { const bool xm_ = (MODE != TM_PROJ) && ((t.N / 64) % 8 == 0); const int rowb_ = TROW0 + 48 * (xm_ ? (((uu) >> 3) & 7) : ((uu) & 7)), cgp_ = xm_ ? (((uu) & 7) + 8 * ((uu) >> 6)) : ((uu) >> 3); \
        _Pragma("unroll") for (int sI = 0; sI < 4; ++sI) { if ((s0) + sI < nks) { const int kk = (ks0 + (s0) + sI) * 32 + 8 * fq; \
            _Pragma("unroll") for (int rt = 0; rt < 3; ++rt) af[sI][rt] = *(const bf16x8*)(t.A + (size_t)(rowb_ + 16 * rt + fr) * K + kk); \
            _Pragma("unroll") for (int ct = 0; ct < 4; ++ct) { const int brow = (MODE == TM_SWIGLU) ? 256 * (cgp_ >> 2) + (ct >> 1) * 128 + 32 * (cgp_ & 3) + 16 * (ct & 1) : 64 * cgp_ + 16 * ct; \
                bfr[sI][ct] = *(const bf16x8*)(t.Bt + (size_t)(brow + fr) * K + kk); } } } } while (0)
#define TG_MMA(s0) do { _Pragma("unroll") for (int sI = 0; sI < 4; ++sI) { if ((s0) + sI < nks) { _Pragma("unroll") for (int rt = 0; rt < 3; ++rt) _Pragma("unroll") for (int ct = 0; ct < 4; ++ct) \
            acc[rt][ct] = __builtin_amdgcn_mfma_f32_16x16x32_bf16(af[sI][rt], bfr[sI][ct], acc[rt][ct], 0, 0, 0); } } } while (0)
#pragma unroll 1
    for (int u = u0; u < nu; u += G) {
        const bool xmap = (MODE != TM_PROJ) && ((t.N / 64) % 8 == 0);
        const int rg = xmap ? ((u >> 3) & 7) : (u & 7), cgp = xmap ? ((u & 7) + 8 * (u >> 6)) : (u >> 3), rowb0 = TROW0 + 48 * rg;
        f32x4 acc[3][4];
#pragma unroll
        for (int rt = 0; rt < 3; ++rt)
#pragma unroll
            for (int ct = 0; ct < 4; ++ct) acc[rt][ct] = (f32x4){0.f, 0.f, 0.f, 0.f};
#pragma unroll 1
        for (int s0 = 0; s0 < nks; s0 += 4) { TG_LOAD(u, s0); TG_MMA(s0); }
#pragma unroll
        for (int rt = 0; rt < 3; ++rt)
#pragma unroll
            for (int ct = 0; ct < 4; ++ct) *(LAS f32x4*)(part + ((w * 12 + rt * 4 + ct) * 64 + lane) * 4) = acc[rt][ct];
        __syncthreads();
        if (w < 3) {
            const int rowb = rowb0 + 16 * w;
            f32x4 sum[4], tot[4];
#pragma unroll
            for (int ct = 0; ct < 4; ++ct) {
                f32x4 p[8];
#pragma unroll
                for (int q = 0; q < 8; ++q) p[q] = *(const LAS f32x4*)(part + ((q * 12 + w * 4 + ct) * 64 + lane) * 4);
                if (MODE == TM_BRANCH) {
                    const f32x4 pa = (p[0] + p[1]) + p[2], pb = (p[3] + p[4]) + p[5], pc = p[6] + p[7];
#pragma unroll
                    for (int i = 0; i < 4; ++i) { const bf16_t* gp = t.GT + (size_t)(rowb + 4 * fq + i) * 3072 + 64 * cgp + 16 * ct + fr; tot[ct][i] = pa[i] * bf2f(gp[0]) + pb[i] * bf2f(gp[1024]) + pc[i] * bf2f(gp[2048]); }
                } else sum[ct] = ((p[0] + p[1]) + (p[2] + p[3])) + ((p[4] + p[5]) + (p[6] + p[7]));
            }
            (void)sum; (void)tot;
            if (MODE == TM_SWIGLU) {
#pragma unroll
                for (int i = 0; i < 4; ++i) {
                    const int row = rowb + 4 * fq + i; const float rs = t.ss[row];
#pragma unroll
                    for (int c2 = 0; c2 < 2; ++c2) t.O1[(size_t)row * 2048 + 128 * (cgp >> 2) + 32 * (cgp & 3) + 16 * c2 + fr] = f2bf(fsilu(sum[c2][i] * rs) * (sum[2 + c2][i] * rs));
                }
            } else if (MODE == TM_RESID) {
#pragma unroll
                for (int i = 0; i < 4; ++i) {
                    const int row = rowb + 4 * fq + i; float sq = 0.f;
#pragma unroll
                    for (int ct = 0; ct < 4; ++ct) {
                        const size_t off = (size_t)row * 1024 + 64 * cgp + 16 * ct + fr;
                        const float x = t.X[off] + sum[ct][i] * t.scale; t.X[off] = x; t.O1[off] = f2bf(x); sq += x * x;
                    }
                    sq += __shfl_xor(sq, 1); sq += __shfl_xor(sq, 2); sq += __shfl_xor(sq, 4); sq += __shfl_xor(sq, 8);
                    if (fr == 0) t.ssn[(size_t)row * 16 + cgp] = sq;
                }
            } else if (MODE == TM_PROJ) {
                const bool gate = 64 * cgp >= PAW;
#pragma unroll
                for (int i = 0; i < 4; ++i) {
                    const int row = rowb + 4 * fq + i; const float rs = t.ss[row];
#pragma unroll
                    for (int ct = 0; ct < 4; ++ct) {
                        const int col = 64 * cgp + 16 * ct + fr; const float v = sum[ct][i] * rs;
                        if (gate) t.O2[(size_t)row * GTW + (col - PAW)] = f2bf(fsigmoid(v)); else t.O1[(size_t)row * PAW + col] = f2bf(v);
                    }
                }
            } else {
#pragma unroll
                for (int i = 0; i < 4; ++i)
#pragma unroll
                    for (int ct = 0; ct < 4; ++ct) t.O1[(size_t)(rowb + 4 * fq + i) * 1024 + 64 * cgp + 16 * ct + fr] = f2bf(tot[ct][i]);
            }
        }
        __syncthreads();
    }
#undef TG_LOAD
#undef TG_MMA
}

__device__ __forceinline__ void carry_item(CArgs* a, int l, int it, const float* LSUM, float* LCAR, const float* U, bf16_t* ST) {
    const int tid = tid_opaque();
    if (it < 2) {
        const int b = it, ch = tid; float h = 0.f;
#pragma unroll 1
        for (int n0 = 0; n0 < NT; n0 += 13) {
            float p[13], q[13];
#pragma unroll
            for (int k = 0; k < 13; ++k) { const size_t o = (size_t)(b * NT + n0 + k) * 512 + ch; p[k] = LSUM[o * 2]; q[k] = LSUM[o * 2 + 1]; }
#pragma unroll
            for (int k = 0; k < 13; ++k) { LCAR[(size_t)(b * NT + n0 + k) * 512 + ch] = h; h = p[k] * h + q[k]; }
        }
        a->out[O_PL + (l * 2 + b) * 512 + ch] = h;
    } else {
        const int eid = (it - 2) * 512 + tid; const int b = eid >> 15, hh = (eid >> 13) & 3, de = eid & 8191, e = de >> 6, d = de & 63;
        const float g128 = exp2f(128.0f * log2_gamma(hh)); float s = 0.f;
#pragma unroll 1
        for (int c0 = 0; c0 < NT; c0 += 13) {
            float u[13];
#pragma unroll
            for (int k = 0; k < 13; ++k) u[k] = U[(size_t)((b * NT + c0 + k) * 4 + hh) * 8192 + de];
#pragma unroll
            for (int k = 0; k < 13; ++k) { ST[(size_t)((b * NT + c0 + k) * 4 + hh) * 8192 + de] = f2bf(s); s = g128 * s + u[k]; }
        }
        a->out[O_PR + ((size_t)(l * 2 + b) * 4 + hh) * 8192 + d * 128 + e] = s;
    }
}

__device__ __forceinline__ void sample_item(CArgs* a, int l, int j, const bf16_t* PA, bf16_t* OB1, bf16_t* OB2, LAS unsigned char* lds) {
    const int tid = tid_opaque(), lane = tid & 63, w = tid >> 6; const int row = SROW0 + j;
    LAS float* q_s = (LAS float*)lds;
    LAS float* p_s = q_s + 512;
    LAS float* rq_s = p_s + 8 * 132;
    LAS float* rk_s = rq_s + 256;
    LAS float* red_s = rk_s + 256;
    const float* ck = a->in[I_CK] + (size_t)(l * 128 + j) * 16384; const float* cv = a->in[I_CV] + (size_t)(l * 128 + j) * 16384;
    const bf16_t* pr = PA + (size_t)row * PAW;
    q_s[tid] = bf2f(pr[C_QS + tid]);
    if (tid < 128) {
        const int hh = tid >> 5, i = tid & 31; float s, co; sincos_rev(8192.0f * rope_inv(i), s, co);
        const float q1 = bf2f(pr[C_QR + hh * 64 + i]), q2 = bf2f(pr[C_QR + hh * 64 + i + 32]), k1 = bf2f(pr[C_KR + hh * 64 + i]), k2 = bf2f(pr[C_KR + hh * 64 + i + 32]);
        rq_s[hh * 64 + i] = q1 * co - q2 * s; rq_s[hh * 64 + i + 32] = q1 * s + q2 * co;
        rk_s[hh * 64 + i] = (k1 * co - k2 * s) * 0.125f; rk_s[hh * 64 + i + 32] = (k1 * s + k2 * co) * 0.125f;
    }
    {
        float* ok = a->out + O_SK + (size_t)(l * 128 + j) * 16384; float* ov = a->out + O_SV + (size_t)(l * 128 + j) * 16384;
        f32x4 ckv[8], cvv[8];
#pragma unroll
        for (int k = 0; k < 8; ++k) { const int i = tid + k * NTHR; if (i < 127 * 32) { ckv[k] = __builtin_nontemporal_load((const f32x4*)ck + 32 + i); cvv[k] = __builtin_nontemporal_load((const f32x4*)cv + 32 + i); } }
#pragma unroll
        for (int k = 0; k < 8; ++k) { const int i = tid + k * NTHR; if (i < 127 * 32) { __builtin_nontemporal_store(ckv[k], (f32x4*)ok + i); __builtin_nontemporal_store(cvv[k], (f32x4*)ov + i); } }
        if (tid < 128) { ok[127 * 128 + tid] = bf2f(pr[C_KS + tid]); ov[127 * 128 + tid] = bf2f(pr[C_VS + tid]); }
    }
    __syncthreads();
    {
        const int h = w, kvh = h >> 2; const float sink = a->in[I_SINK][l * 8 + h];
        float sc[3]; sc[2] = -INFINITY;
#pragma unroll
        for (int t = 0; t < 2; ++t) {
            const int s = lane + 64 * t; const f32x4* kp = (const f32x4*)(ck + (size_t)s * 128 + kvh * 64); float d = 0.f;
#pragma unroll
            for (int q = 0; q < 16; ++q) { const f32x4 k = kp[q]; const f32x4 qq = *(const LAS f32x4*)(q_s + h * 64 + q * 4); d += (k[0] * qq[0] + k[1] * qq[1]) + (k[2] * qq[2] + k[3] * qq[3]); }
            sc[t] = (s == 0) ? -INFINITY : d * 0.125f;
        }
        {
            sc[2] = wave_sum(bf2f(pr[C_KS + kvh * 64 + lane]) * q_s[h * 64 + lane]) * 0.125f;
        }
        float mx = fmaxf(fmaxf(sc[0], sc[1]), sc[2]);
#pragma unroll
        for (int o = 1; o < 64; o <<= 1) mx = fmaxf(mx, __shfl_xor(mx, o));
        const float mm = fmaxf(mx, sink);
        const float e0 = __expf(sc[0] - mm), e1 = __expf(sc[1] - mm), e2 = __expf(sc[2] - mm);
        const float sum = wave_sum(e0 + e1) + e2; const float inv = 1.0f / (sum + __expf(sink - mm));
        p_s[h * 132 + lane] = e0 * inv; p_s[h * 132 + 64 + lane] = e1 * inv; if (lane == 0) p_s[h * 132 + 128] = e2 * inv;
        LDSW();
        float o = p_s[h * 132 + 128] * bf2f(pr[C_VS + kvh * 64 + lane]);
#pragma unroll 32
        for (int s = 0; s < 128; ++s) o += p_s[h * 132 + s] * cv[(size_t)s * 128 + kvh * 64 + lane];
        OB1[(size_t)row * OBS + h * 64 + lane] = f2bf(o);
    }
    {
        const int hh = tid >> 7, e = tid & 127; const float gam = 1.0f - exp2f(-5.0f - (float)hh);
        const float* S = a->in[I_SRET] + ((size_t)(l * 128 + j) * 4 + hh) * 8192; float* So = a->out + O_SR + ((size_t)(l * 128 + j) * 4 + hh) * 8192;
        const float v = bf2f(pr[C_VR + hh * 128 + e]); float acc = 0.f, qk = 0.f;
#pragma unroll 32
        for (int d = 0; d < 64; ++d) { const float s = __builtin_nontemporal_load(&S[d * 128 + e]); const float q = rq_s[hh * 64 + d], k = rk_s[hh * 64 + d]; acc += q * s; qk += q * k; __builtin_nontemporal_store(gam * s + k * v, &So[d * 128 + e]); }
        const float o = qk * v + gam * acc;
        float sm = wave_sum(o); if (lane == 0) red_s[w * 2] = sm;
        __syncthreads();
        const float mu = (red_s[(w & ~1) * 2] + red_s[(w | 1) * 2]) * (1.0f / 128.0f); const float dv = o - mu;
        float vs = wave_sum(dv * dv); if (lane == 0) red_s[w * 2 + 1] = vs;
        __syncthreads();
        const float var = (red_s[(w & ~1) * 2 + 1] + red_s[(w | 1) * 2 + 1]) * (1.0f / 128.0f);
        const float y = dv * (1.0f / sqrtf(var + 1e-5f)) * a->in[I_RETN][l * 512 + hh * 128 + e] * fsilu(bf2f(pr[C_GR + hh * 128 + e]));
        OB2[(size_t)row * OBS + hh * 128 + e] = f2bf(y);
    }
    __syncthreads();
}

#define GAS __attribute__((address_space(1)))
#define XB_TMO      128
#define XB_XCNT(j)  (256  + 64 * (j))
#define XB_XSUB(j)  (1280 + 64 * (j))
#define XB_XGEN(j)  (2304 + 64 * (j))
#define XB_TOP      3328
#define XB_TOPGEN   3392
#define XCD_BAR_WORDS 3456
#define XB_SPIN_CAP (1u << 18)

__device__ __forceinline__ unsigned xb_ld(unsigned* p)              { return __hip_atomic_load(p, __ATOMIC_RELAXED, __HIP_MEMORY_SCOPE_AGENT); }
__device__ __forceinline__ unsigned xb_add(unsigned* p, unsigned v) { return __hip_atomic_fetch_add(p, v, __ATOMIC_RELAXED, __HIP_MEMORY_SCOPE_AGENT); }
__device__ __forceinline__ unsigned xb_xcc_id() { return (unsigned)__builtin_amdgcn_s_getreg((3 << 11) | 20) & 0xFu; }
#define XB_SPIN(cond, bar) do { unsigned _sp = 0; while (cond) { __builtin_amdgcn_s_sleep(1); \
    if ((++_sp & 255u) == 0u) { if (xb_ld(&(bar)[XB_TMO])) break; if (_sp > XB_SPIN_CAP) { atomicAdd(&(bar)[XB_TMO], 1u); break; } } } } while (0)

struct XcdBarrier {
    unsigned* bar; unsigned x;
    volatile LAS unsigned* st;
};

__device__ __forceinline__ XcdBarrier xcd_barrier_post(unsigned* bar, volatile LAS unsigned* st) {
    XcdBarrier b; b.bar = bar; b.x = xb_xcc_id(); b.st = st;
    if (threadIdx.x == 0) (void)xb_add(&bar[XB_XCNT(b.x)], 1u);
    return b;
}
__device__ __forceinline__ void xcd_barrier_complete(unsigned* bar, unsigned x, unsigned& nloc, unsigned& nx) {
    const unsigned G = gridDim.x * gridDim.y * gridDim.z;
    unsigned sum, cnt, mine, sp = 0u;
    for (;;) {
        sum = 0u; cnt = 0u; mine = 0u;
#pragma unroll
        for (unsigned j = 0; j < 16; ++j) { const unsigned c = xb_ld(&bar[XB_XCNT(j)]); sum += c; cnt += (c > 0u) ? 1u : 0u; mine = (j == x) ? c : mine; }
        if (sum == G) break;
        __builtin_amdgcn_s_sleep(1);
        if ((++sp & 255u) == 0u) { if (xb_ld(&bar[XB_TMO])) break; if (sp > XB_SPIN_CAP) { atomicAdd(&bar[XB_TMO], 1u); break; } }
    }
    nloc = mine > 0u ? mine : 1u; nx = cnt > 0u ? cnt : 1u;
}

__device__ __forceinline__ void xcd_barrier(const XcdBarrier& b) {
    asm volatile("s_waitcnt vmcnt(0)" ::: "memory");
    __syncthreads();
    if (threadIdx.x == 0) {
        unsigned* bar = b.bar;
        __builtin_amdgcn_s_waitcnt(0);
        unsigned nloc = b.st[0], nx = b.st[1];
        if (nloc == 0u) { xcd_barrier_complete(bar, b.x, nloc, nx); b.st[0] = nloc; b.st[1] = nx; }
        const unsigned old = xb_add(&bar[XB_XSUB(b.x)], 1u);
        const unsigned gen = old / nloc;
        if (old + 1u == (gen + 1u) * nloc) {
            __builtin_amdgcn_fence(__ATOMIC_RELEASE, "agent");
            asm volatile("s_waitcnt vmcnt(0)" ::: "memory");
            const unsigned og = xb_add(&bar[XB_TOP], 1u);
            const unsigned tg = og / nx;
            if (og + 1u == (tg + 1u) * nx) xb_add(&bar[XB_TOPGEN], 1u);
            else XB_SPIN(xb_ld(&bar[XB_TOPGEN]) == tg, bar);
            __builtin_amdgcn_fence(__ATOMIC_ACQUIRE, "agent");
            xb_add(&bar[XB_XGEN(b.x)], 1u);
            asm volatile("s_waitcnt vmcnt(0)" ::: "memory");
        } else {
            XB_SPIN(xb_ld(&bar[XB_XGEN(b.x)]) == gen, bar);
            __builtin_amdgcn_fence(__ATOMIC_ACQUIRE, "agent");
            asm volatile("s_waitcnt vmcnt(0)" ::: "memory");
        }
    }
    __syncthreads();
}


template <class Sched> __device__ __forceinline__ void rs_prestep(const Sched& S, const float* ss, float* rs) {
    const int tid = tid_opaque();
    int pmv[8];
#pragma unroll
    for (int i = 0; i < 8; ++i) { pg8::Unit u; pmv[i] = S.next(i, u) ? u.pm : -1; }
    const int r0 = (tid < 256) ? tid : TROW0 + (tid - 256);
    float v[9];
#pragma unroll
    for (int i = 0; i < 8; ++i) { v[i] = 0.f; if (tid < 256 && pmv[i] >= 0) v[i] = pg8::row_ss(ss, pmv[i] * 256 + tid); }
    v[8] = 0.f; if (tid >= 256) v[8] = pg8::row_ss(ss, r0);
    float v9 = 0.f; if (tid < 128) v9 = pg8::row_ss(ss, TROW0 + 256 + tid);
#pragma unroll
    for (int i = 0; i < 8; ++i) if (tid < 256 && pmv[i] >= 0) rs[pmv[i] * 256 + tid] = __builtin_amdgcn_rsqf(v[i] * (1.0f / 1024.0f) + 1e-6f);
    if (tid >= 256) rs[r0] = __builtin_amdgcn_rsqf(v[8] * (1.0f / 1024.0f) + 1e-6f);
    if (tid < 128) rs[TROW0 + 256 + tid] = __builtin_amdgcn_rsqf(v9 * (1.0f / 1024.0f) + 1e-6f);
    asm volatile("s_waitcnt vmcnt(0)" ::: "memory");
    __syncthreads();
}

#define R_GU 1
#define R_WIN 1
#define R_MIX1 1
#define R_CARRY 1
#define R_MIX2 1
#define R_XSYNC 0
__global__ void __launch_bounds__(NTHR, 2) mk_fwd(Args a_unused) {
    extern __shared__ __attribute__((aligned(16))) unsigned char lds_raw[];
    LAS unsigned char* lds = (LAS unsigned char*)lds_raw;
    cg::grid_group grid = cg::this_grid();
    CArgs* kp0 = (CArgs*)__builtin_amdgcn_kernarg_segment_ptr();
    if (threadIdx.x < 64) ((LAS unsigned*)(lds + 131072))[threadIdx.x] = 0u;
    __syncthreads();
    XcdBarrier xbar; xbar.bar = (unsigned*)(kp0->ws + WS_BAR); xbar.x = 0; xbar.st = (volatile LAS unsigned*)(lds + 131072);
    const int lo = kp0->ph_lo, hi = kp0->ph_hi; int ph = 0;
#define PH_PTRS int tid = threadIdx.x; asm volatile("" : "+v"(tid)); const int lane = tid & 63, wave = __builtin_amdgcn_readfirstlane(tid >> 6); \
    int bid_ = blockIdx.x; asm volatile("" : "+s"(bid_)); const int G = gridDim.x, bid = bid_, gw = bid * 8 + wave, ngw = G * 8; (void)lane; (void)gw; (void)ngw; CArgs* a = kp0; asm volatile("" : "+s"(a)); unsigned char* ws = a->ws; \
    float* SS = (float*)(ws + WS_SS16); float* LSUM = (float*)(ws + WS_LSUM); float* LCAR = (float*)(ws + WS_LCAR); \
    float* X = (float*)(ws + WS_X); bf16_t* XB = (bf16_t*)(ws + WS_XB); bf16_t* PA = (bf16_t*)(ws + WS_PA); bf16_t* HB = PA; bf16_t* MB = (bf16_t*)(ws + WS_PA); \
    bf16_t* GT = (bf16_t*)(ws + WS_GT); bf16_t* OB = (bf16_t*)(ws + WS_OB); float* U = (float*)(ws + WS_U); float* AG = (float*)(ws + WS_XB); float* BG = (float*)(ws + WS_BG); (void)AG; (void)BG; bf16_t* ST = (bf16_t*)(ws + WS_ST); \
    unsigned char* wb = ws + WS_W0 + (size_t)(l & 1) * WSZ; \
    float* RS = (float*)(ws + WS_RS); const float* rs0 = RS + (size_t)(3 * l) * MP; float* rs1 = RS + (size_t)(3 * l + 1) * MP; float* rs2 = RS + (size_t)(3 * l + 2) * MP; float* rs3 = RS + (size_t)(3 * l + 3) * MP; (void)rs0; (void)rs1; (void)rs2; (void)rs3; \
    const float* ss0 = SS + (size_t)(3 * l) * MP * 16; float* ss1 = SS + (size_t)(3 * l + 1) * MP * 16; float* ss2 = SS + (size_t)(3 * l + 2) * MP * 16; float* ss3 = SS + (size_t)(3 * l + 3) * MP * 16; \
    (void)SS; (void)LSUM; (void)LCAR; (void)X; (void)XB; (void)PA; (void)HB; (void)MB; (void)GT; (void)OB; (void)U; (void)ST; (void)wb; (void)ss0; (void)ss1; (void)ss2; (void)ss3;
#define PH_BEGIN(n) if (ph >= lo && ph < hi) { PH_PTRS for (int rep_ = 0; rep_ < (n); ++rep_) {
#define PH_END if (ph + 1 < hi) { if (ph == 0) { asm volatile("s_waitcnt vmcnt(0)" ::: "memory"); grid.sync(); xbar = xcd_barrier_post((unsigned*)(kp0->ws + WS_BAR), (volatile LAS unsigned*)(lds + 131072)); } else xcd_barrier(xbar); } } } ++ph;

    { const int l = 0;
    PH_BEGIN(1)
        if (bid == 0) { for (int i = tid; i < XCD_BAR_WORDS; i += NTHR) ((unsigned*)(ws + WS_BAR))[i] = 0u; }
        if (bid == 0) { ((unsigned*)(ws + WS_BAR + 16384))[tid] = 0u; ((unsigned*)(ws + WS_BAR + 16384))[tid + NTHR] = 0u; }
        init_rows(a, X, XB, SS, RS, OB, gw, ngw, lane);
        convert_layer(a, 0, ws + WS_W0, lds, gw, ngw, wave, lane);
    PH_END
    }

#pragma unroll 1
    for (int l = 0; l < DEPTH; ++l) {
        PH_BEGIN(R_GU)
            pg8::Gemm g{XB, (const bf16_t*)(wb + W_GU1), TROW0, 4096, DM, 1, 0}; pg8::StaticOrder S; S.init(TROW0, 4096, G, bid);
            rs_prestep(S, ss0, RS + (size_t)(3 * l) * MP);
            pg8::EpiSwiGLU E{HB, rs0}; pg8::gemm_phase<pg8::EpiSwiGLU, pg8::StaticOrder, true, true>(lds, g, S, E);
            { const TailArgs ta{XB, (const bf16_t*)(wb + W_GU1), DM, 4096, HB, nullptr, nullptr, rs0, nullptr, nullptr, 0.f}; tail_gemm<TM_SWIGLU>(ta, bid, G, lds); }
        PH_END
        PH_BEGIN(1)
            pg8::Gemm g{HB, (const bf16_t*)(wb + W_D1), TROW0, DM, FF, 1, 0}; pg8::StaticOrder S; S.init(TROW0, DM, G, bid);
            pg8::EpiResid E{X, XB, ss1, 0.5f}; pg8::gemm_phase<pg8::EpiResid, pg8::StaticOrder, true, true>(lds, g, S, E);
            { const TailArgs ta{HB, (const bf16_t*)(wb + W_D1), FF, DM, XB, nullptr, X, nullptr, ss1, nullptr, 0.5f}; tail_gemm<TM_RESID>(ta, bid, G, lds); }
        PH_END
        PH_BEGIN(R_WIN)
            pg8::Gemm g{XB, (const bf16_t*)(wb + W_IN), TROW0, NIN, DM, 1, 0}; pg8::StaticOrder S; S.init(TROW0, NIN, G, bid);
            rs_prestep(S, ss1, rs1);
            pg8::EpiProj E{PA, GT, rs1}; pg8::gemm_phase<pg8::EpiProj, pg8::StaticOrder, true, true>(lds, g, S, E);
            { const TailArgs ta{XB, (const bf16_t*)(wb + W_IN), DM, NIN, PA, GT, nullptr, rs1, nullptr, nullptr, 0.f}; if (G == 256) { if (bid >= 64) tail_gemm<TM_PROJ>(ta, bid - 64, 192, lds); } else tail_gemm<TM_PROJ>(ta, bid, G, lds); }
        PH_END
        PH_BEGIN(R_MIX1)
            {
                volatile LAS int* qs = (volatile LAS int*)(lds + 131072 + 128);
                unsigned* qc = (unsigned*)(ws + WS_BAR + 16384) + (2 * l) * 64;
                int it = bid;
                while (it < 1048 + 260 + 520) {
                    int nxt = 0;
                    if (tid == 0) nxt = G + (int)__hip_atomic_fetch_add(qc, 1u, __ATOMIC_RELAXED, __HIP_MEMORY_SCOPE_AGENT);
                    if (it < 1048) { const int q = 1047 - it; lru1_item(a, l, q >> 3, q & 7, PA, OB, LSUM, AG, BG, lds); }
                    else if (it < 1048 + 260) swa_item(a, l, it - 1048, PA, OB + 512, lds);
                    else ret_u_item(it - (1048 + 260), PA, U, lds);
                    if (tid == 0) *qs = nxt;
                    __syncthreads();
                    it = *qs;
                }
            }
        PH_END
        PH_BEGIN(R_CARRY)
            {
                volatile LAS int* qs = (volatile LAS int*)(lds + 131072 + 128);
                unsigned* qc = (unsigned*)(ws + WS_BAR + 16384) + (8 + l) * 64;
                const int nitems = 128 + 130 + ((l + 1 < DEPTH) ? 512 : 0);
                unsigned char* wn = ws + WS_W0 + (size_t)((l + 1) & 1) * WSZ;
                int it = bid;
                while (it < nitems) {
                    int nxt = 0;
                    if (tid == 0) nxt = G + (int)__hip_atomic_fetch_add(qc, 1u, __ATOMIC_RELAXED, __HIP_MEMORY_SCOPE_AGENT);
                    if (it < 128) sample_item(a, l, it, PA, OB + 512, OB + 1024, lds);
                    else if (it < 258) carry_item(a, l, it - 128, LSUM, LCAR, U, ST);
                    else convert_layer(a, l + 1, wn, lds, (it - 258) * 8 + wave, 512 * 8, wave, lane);
                    if (tid == 0) *qs = nxt;
                    __syncthreads();
                    it = *qs;
                    __syncthreads();
                }
            }
        PH_END
        PH_BEGIN(R_MIX2)
            {
                volatile LAS int* qs = (volatile LAS int*)(lds + 131072 + 128);
                unsigned* qc = (unsigned*)(ws + WS_BAR + 16384) + (2 * l + 1) * 64;
                int it = bid;
                while (it < 520 + 1040) {
                    int nxt = 0;
                    if (tid == 0) nxt = G + (int)__hip_atomic_fetch_add(qc, 1u, __ATOMIC_RELAXED, __HIP_MEMORY_SCOPE_AGENT);
                    if (it < 520) ret_out_item(a, l, it, PA, ST, OB + 1024, lds);
                    else { const int q = it - 520; lru2_item(q >> 3, q & 7, PA, OB, LCAR, AG, BG, lds); }
                    if (tid == 0) *qs = nxt;
                    __syncthreads();
                    it = *qs;
                }
            }
        PH_END
        PH_BEGIN(1)
            pg8::Gemm g{OB, (const bf16_t*)(wb + W_BR), TROW0, DM, OBS, 1, 0}; pg8::StaticOrder S; S.init(TROW0, DM, G, bid);
            pg8::EpiBranch E{MB, GT}; pg8::gemm_phase<pg8::EpiBranch, pg8::StaticOrder, true, true>(lds, g, S, E);
            { const TailArgs ta{OB, (const bf16_t*)(wb + W_BR), OBS, DM, MB, nullptr, nullptr, nullptr, nullptr, GT, 0.f}; tail_gemm<TM_BRANCH>(ta, bid, G, lds); }
        PH_END
        PH_BEGIN(1)
            pg8::Gemm g{MB, (const bf16_t*)(wb + W_OUT), TROW0, DM, DM, 1, 0}; pg8::StaticOrder S; S.init(TROW0, DM, G, bid);
            pg8::EpiResid E{X, XB, ss2, 1.0f}; pg8::gemm_phase<pg8::EpiResid, pg8::StaticOrder, true, true>(lds, g, S, E);
            { const TailArgs ta{MB, (const bf16_t*)(wb + W_OUT), DM, DM, XB, nullptr, X, nullptr, ss2, nullptr, 1.0f}; tail_gemm<TM_RESID>(ta, bid, G, lds); }
        PH_END
        PH_BEGIN(1)
            for (int xs_ = 0; xs_ < R_XSYNC; ++xs_) grid.sync();
            pg8::Gemm g{XB, (const bf16_t*)(wb + W_GU2), TROW0, 4096, DM, 1, 0}; pg8::StaticOrder S; S.init(TROW0, 4096, G, bid);
            rs_prestep(S, ss2, rs2);
            pg8::EpiSwiGLU E{HB, rs2}; pg8::gemm_phase<pg8::EpiSwiGLU, pg8::StaticOrder, true, true>(lds, g, S, E);
            { const TailArgs ta{XB, (const bf16_t*)(wb + W_GU2), DM, 4096, HB, nullptr, nullptr, rs2, nullptr, nullptr, 0.f}; tail_gemm<TM_SWIGLU>(ta, bid, G, lds); }
        PH_END
        PH_BEGIN(1)
            pg8::Gemm g{HB, (const bf16_t*)(wb + W_D2), TROW0, DM, FF, 1, 0}; pg8::StaticOrder S; S.init(TROW0, DM, G, bid);
            pg8::EpiResid E{X, XB, ss3, 0.5f}; pg8::gemm_phase<pg8::EpiResid, pg8::StaticOrder, true, true>(lds, g, S, E);
            { const TailArgs ta{HB, (const bf16_t*)(wb + W_D2), FF, DM, XB, nullptr, X, nullptr, ss3, nullptr, 0.5f}; tail_gemm<TM_RESID>(ta, bid, G, lds); }
        PH_END
    }
    { const int l = 0;
    PH_BEGIN(1)
        const float* ssf = SS + (size_t)12 * MP * 16; const float* gf = a->in[I_FINN];
        for (int r = gw; r < MREAL; r += ngw) {
            float* dst = nullptr;
            if (r < 2 * BROWS) { const int b = r / BROWS, pr = r % BROWS; if (pr >= PADR + 16) dst = a->out + O_YP + ((size_t)b * 8192 + (pr - PADR - 16)) * DM; }
            else dst = a->out + O_YS + (size_t)(r - SROW0) * DM;
            if (dst) {
                const float rs = __builtin_amdgcn_rsqf(pg8::row_ss(ssf, r) * (1.0f / 1024.0f) + 1e-6f);
#pragma unroll
                for (int j = 0; j < 4; ++j) { const f32x4 v = *((const f32x4*)(X + (size_t)r * DM) + lane + 64 * j); const f32x4 gg = *((const f32x4*)gf + lane + 64 * j); __builtin_nontemporal_store(v * rs * gg, (f32x4*)dst + lane + 64 * j); }
            }
        }
    PH_END
    }
#undef PH_BEGIN
#undef PH_END
}
constexpr int NPHASES = 2 + 10 * DEPTH;

#ifndef MK_MULTI
#define MK_MULTI 0
#endif
extern "C" void kernel_launch(void* const* d_in, const int* in_sizes, int n_in, void* d_out, int out_size, void* d_ws, size_t ws_size, hipStream_t stream) {
    static int grid = 0;
    if (grid == 0) {
        if (n_in != 30 || ws_size < WS_END) { fprintf(stderr, "kernel_launch: unexpected inputs (n_in %d, ws %zu < %zu)\n", n_in, ws_size, (size_t)WS_END); grid = -1; return; }
        int dev = 0, cus = 0, per_cu = 0;
        (void)hipGetDevice(&dev); (void)hipDeviceGetAttribute(&cus, hipDeviceAttributeMultiprocessorCount, dev);
        if (hipFuncSetAttribute((const void*)mk_fwd, hipFuncAttributeMaxDynamicSharedMemorySize, LDS_BYTES) != hipSuccess) { fprintf(stderr, "kernel_launch: hipFuncSetAttribute failed\n"); grid = -1; return; }
        if (hipOccupancyMaxActiveBlocksPerMultiprocessor(&per_cu, (const void*)mk_fwd, NTHR, LDS_BYTES) != hipSuccess || per_cu < 1) { fprintf(stderr, "kernel_launch: occupancy query says %d\n", per_cu); per_cu = 1; }
        (void)hipGetLastError();
        grid = cus * 1;
        if (grid <= 0) grid = 256;
    }
    if (grid < 0) return;
    Args a{};
    for (int i = 0; i < 30; ++i) a.in[i] = (const float*)d_in[i];
    a.out = (float*)d_out; a.ws = (unsigned char*)d_ws;
#if MK_MULTI
    for (int p = 0; p < NPHASES; ++p) { a.ph_lo = p; a.ph_hi = p + 1; hipLaunchKernelGGL(mk_fwd, dim3(grid), dim3(NTHR), LDS_BYTES, stream, a); }
#else
    a.ph_lo = 0; a.ph_hi = NPHASES;
    void* args[] = {&a};
    hipError_t e = hipLaunchCooperativeKernel((const void*)mk_fwd, dim3(grid), dim3(NTHR), args, LDS_BYTES, stream);
    if (e != hipSuccess) fprintf(stderr, "cooperative launch failed: %s (grid %d)\n", hipGetErrorString(e), grid);
#endif
}
```
